# Optimizing an MI355X kernel written in HIP

```python
import jax, jax.numpy as jnp
from jax import lax
import numpy as np

D_MODEL = 2048
BATCH = 1
SEQ = 8192
DEPTH = 2

PLE_DIM = 256
NORM_EPS = 1e-6
CONV_WIDTH = 4
N_BRANCH = 3
MIX_WIDTH = D_MODEL // 2
D_FF = 4 * D_MODEL

DN_HEAD_DIM = 128
DN_HEADS = MIX_WIDTH // DN_HEAD_DIM
DN_CHUNK = 64

SSM_HEAD_DIM = 64
SSM_HEADS = MIX_WIDTH // SSM_HEAD_DIM
SSM_GROUPS = 2
SSM_STATE = 128
SSM_CHUNK = 64

GLA_HEADS = 4
GLA_K_WIDTH = MIX_WIDTH // 2
GLA_K_DIM = GLA_K_WIDTH // GLA_HEADS
GLA_V_DIM = MIX_WIDTH // GLA_HEADS
GLA_GATE_RANK = 16
GLA_GATE_TEMP = 16.0
GLA_CHUNK = 16

IN_SPLITS = (
    MIX_WIDTH, MIX_WIDTH, MIX_WIDTH, DN_HEADS, DN_HEADS, MIX_WIDTH,
    MIX_WIDTH, MIX_WIDTH, SSM_GROUPS * SSM_STATE, SSM_GROUPS * SSM_STATE, SSM_HEADS,
    GLA_K_WIDTH, GLA_K_WIDTH, MIX_WIDTH, GLA_GATE_RANK, MIX_WIDTH,
    N_BRANCH * D_MODEL,
)
IN_TOTAL = sum(IN_SPLITS)

kernel_name = "hybrid_deltanet_ssd_gla_block"


def rmsnorm(x, gain):
    xf = x.astype(jnp.float32)
    y = xf * lax.rsqrt(jnp.mean(xf * xf, axis=-1, keepdims=True) + NORM_EPS)
    return (y * gain.astype(jnp.float32)).astype(x.dtype)


def l2norm(x):
    xf = x.astype(jnp.float32)
    return xf * lax.rsqrt(jnp.sum(xf * xf, axis=-1, keepdims=True) + NORM_EPS)


def causal_depthwise_conv(x, w, b=None):
    K, C = w.shape
    y = lax.conv_general_dilated(x, w[:, None, :].astype(x.dtype), window_strides=(1,),
                                 padding=[(K - 1, 0)], dimension_numbers=('NWC', 'WIO', 'NWC'),
                                 feature_group_count=C)
    if b is not None:
        y = y + b.astype(y.dtype)
    return y


def _to_chunks(t, chunk):
    Bsz, T, H = t.shape[:3]
    t = t.reshape((Bsz, T // chunk, chunk, H) + t.shape[3:])
    return jnp.moveaxis(t, 2, 3)


def _from_chunks(t):
    N, Bsz, H, C, V = t.shape
    return t.transpose(1, 0, 3, 2, 4).reshape(Bsz, N * C, H, V)


def chunk_gated_delta_rule(q, k, v, g, beta, chunk=DN_CHUNK):
    Bsz, T, H, Kd = q.shape
    Vd = v.shape[-1]
    q = _to_chunks(q * (Kd ** -0.5), chunk)
    k = _to_chunks(k, chunk)
    v = _to_chunks(v, chunk)
    beta = _to_chunks(beta, chunk)
    g = jnp.cumsum(_to_chunks(g, chunk), axis=-1)
    idx = jnp.arange(chunk)
    causal = idx[:, None] >= idx[None, :]
    strict = idx[:, None] > idx[None, :]
    decay = jnp.exp(jnp.where(causal, g[..., :, None] - g[..., None, :], -jnp.inf))
    kb = k * beta[..., None]
    m = jnp.where(strict, jnp.einsum('bnhik,bnhjk->bnhij', kb, k) * decay, 0.0)
    a = m + jnp.eye(chunk, dtype=m.dtype)
    u = lax.linalg.triangular_solve(a, v * beta[..., None], left_side=True, lower=True, unit_diagonal=True)
    w = lax.linalg.triangular_solve(a, kb * jnp.exp(g)[..., None], left_side=True, lower=True, unit_diagonal=True)
    attn = jnp.einsum('bnhik,bnhjk->bnhij', q, k) * decay
    qg = q * jnp.exp(g)[..., None]
    kd = k * jnp.exp(g[..., -1:] - g)[..., None]
    g_last = jnp.exp(g[..., -1])

    def step(S, xs):
        qg_c, kd_c, u_c, w_c, attn_c, gl_c = xs
        v_new = u_c - jnp.einsum('bhck,bhkv->bhcv', w_c, S)
        o = jnp.einsum('bhck,bhkv->bhcv', qg_c, S) + jnp.einsum('bhij,bhjv->bhiv', attn_c, v_new)
        S = S * gl_c[..., None, None] + jnp.einsum('bhck,bhcv->bhkv', kd_c, v_new)
        return S, o

    xs = tuple(jnp.moveaxis(t, 1, 0) for t in (qg, kd, u, w, attn, g_last))
    S0 = jnp.zeros((Bsz, H, Kd, Vd), jnp.float32)
    _, o = lax.scan(step, S0, xs)
    return _from_chunks(o)


def ssd_chunked(xdt, a, Bm, Cm, chunk=SSM_CHUNK):
    Bsz, T, H, P = xdt.shape
    G, N = Bm.shape[2:]
    R = H // G
    Nc = T // chunk
    xdt = xdt.reshape(Bsz, Nc, chunk, G, R, P)
    a = a.reshape(Bsz, Nc, chunk, G, R).transpose(0, 1, 3, 4, 2)
    Bm = Bm.reshape(Bsz, Nc, chunk, G, N)
    Cm = Cm.reshape(Bsz, Nc, chunk, G, N)
    acs = jnp.cumsum(a, axis=-1)
    idx = jnp.arange(chunk)
    causal = idx[:, None] >= idx[None, :]
    lmat = jnp.exp(jnp.where(causal, acs[..., :, None] - acs[..., None, :], -jnp.inf))
    cb = jnp.einsum('bclgn,bcsgn->bcgls', Cm, Bm)
    y_diag = jnp.einsum('bcgls,bcgrls,bcsgrp->bclgrp', cb, lmat, xdt)
    states = jnp.einsum('bclgn,bcgrl,bclgrp->bcgrpn', Bm, jnp.exp(acs[..., -1:] - acs), xdt)
    chunk_decay = jnp.exp(acs[..., -1])

    def step(S, inp):
        st, dec = inp
        return S * dec[..., None, None] + st, S

    S0 = jnp.zeros((Bsz, G, R, P, N), jnp.float32)
    _, s_in = lax.scan(step, S0, (jnp.moveaxis(states, 1, 0), jnp.moveaxis(chunk_decay, 1, 0)))
    s_in = jnp.moveaxis(s_in, 0, 1)
    y_off = jnp.einsum('bclgn,bcgrpn,bcgrl->bclgrp', Cm, s_in, jnp.exp(acs))
    return (y_diag + y_off).reshape(Bsz, T, H, P)


def chunk_gla(q, k, v, gk, chunk=GLA_CHUNK):
    Bsz, T, H, Kd = q.shape
    Vd = v.shape[-1]
    q = _to_chunks(q * (Kd ** -0.5), chunk)
    k = _to_chunks(k, chunk)
    v = _to_chunks(v, chunk)
    G = jnp.cumsum(_to_chunks(gk, chunk), axis=3)
    idx = jnp.arange(chunk)
    causal = (idx[:, None] >= idx[None, :])[:, :, None]
    pair = jnp.exp(jnp.where(causal, G[..., :, None, :] - G[..., None, :, :], -jnp.inf))
    attn = jnp.einsum('bnhik,bnhjk,bnhijk->bnhij', q, k, pair)
    qg = q * jnp.exp(G)
    kd = k * jnp.exp(G[..., -1:, :] - G)
    dec = jnp.exp(G[..., -1, :])

    def step(S, xs):
        qg_c, kd_c, v_c, attn_c, dec_c = xs
        o = jnp.einsum('bhck,bhkv->bhcv', qg_c, S) + jnp.einsum('bhij,bhjv->bhiv', attn_c, v_c)
        S = S * dec_c[..., None] + jnp.einsum('bhck,bhcv->bhkv', kd_c, v_c)
        return S, o

    xs = tuple(jnp.moveaxis(t, 1, 0) for t in (qg, kd, v, attn, dec))
    S0 = jnp.zeros((Bsz, H, Kd, Vd), jnp.float32)
    _, o = lax.scan(step, S0, xs)
    return _from_chunks(o)


def gated_deltanet_branch(q, k, v, beta_logit, a_logit, gate, conv_w, a_log, dt_bias, norm_w):
    dtype = q.dtype
    Bsz, T, _ = q.shape
    qkv = jax.nn.silu(causal_depthwise_conv(jnp.concatenate([q, k, v], axis=-1), conv_w))
    q, k, v = jnp.split(qkv, 3, axis=-1)
    q = l2norm(q.reshape(Bsz, T, DN_HEADS, DN_HEAD_DIM))
    k = l2norm(k.reshape(Bsz, T, DN_HEADS, DN_HEAD_DIM))
    v = v.reshape(Bsz, T, DN_HEADS, DN_HEAD_DIM).astype(jnp.float32)
    beta = jax.nn.sigmoid(beta_logit.astype(jnp.float32))
    g = -jnp.exp(a_log.astype(jnp.float32)) * jax.nn.softplus(a_logit.astype(jnp.float32) + dt_bias.astype(jnp.float32))
    o = chunk_gated_delta_rule(q, k, v, g, beta)
    o = rmsnorm(o, norm_w) * jax.nn.silu(gate.reshape(Bsz, T, DN_HEADS, DN_HEAD_DIM).astype(jnp.float32))
    return o.reshape(Bsz, T, MIX_WIDTH).astype(dtype)


def mamba2_branch(z, xs, Bm, Cm, dt_raw, conv_w, conv_b, dt_bias, a_log, d_skip, norm_w):
    dtype = xs.dtype
    Bsz, T, _ = xs.shape
    xbc = jax.nn.silu(causal_depthwise_conv(jnp.concatenate([xs, Bm, Cm], axis=-1), conv_w, conv_b))
    xs, Bm, Cm = jnp.split(xbc, [MIX_WIDTH, MIX_WIDTH + SSM_GROUPS * SSM_STATE], axis=-1)
    x = xs.reshape(Bsz, T, SSM_HEADS, SSM_HEAD_DIM).astype(jnp.float32)
    Bm = Bm.reshape(Bsz, T, SSM_GROUPS, SSM_STATE).astype(jnp.float32)
    Cm = Cm.reshape(Bsz, T, SSM_GROUPS, SSM_STATE).astype(jnp.float32)
    dt = jax.nn.softplus(dt_raw.astype(jnp.float32) + dt_bias.astype(jnp.float32))
    A = -jnp.exp(a_log.astype(jnp.float32))
    y = ssd_chunked(x * dt[..., None], dt * A, Bm, Cm)
    y = y + d_skip.astype(jnp.float32)[:, None] * x
    y = y.reshape(Bsz, T, MIX_WIDTH) * jax.nn.silu(z.astype(jnp.float32))
    y = rmsnorm(y.reshape(Bsz, T, SSM_GROUPS, MIX_WIDTH // SSM_GROUPS), norm_w.reshape(SSM_GROUPS, -1))
    return y.reshape(Bsz, T, MIX_WIDTH).astype(dtype)


def gla_branch(q, k, v, gate_lr, out_gate, w2, b2, norm_w):
    dtype = q.dtype
    Bsz, T, _ = q.shape
    q = q.reshape(Bsz, T, GLA_HEADS, GLA_K_DIM).astype(jnp.float32)
    k = k.reshape(Bsz, T, GLA_HEADS, GLA_K_DIM).astype(jnp.float32)
    v = v.reshape(Bsz, T, GLA_HEADS, GLA_V_DIM).astype(jnp.float32)
    gk = jax.nn.log_sigmoid(jnp.einsum('btr,rk->btk', gate_lr.astype(jnp.float32), w2.astype(jnp.float32))
                            + b2.astype(jnp.float32)) / GLA_GATE_TEMP
    gk = gk.reshape(Bsz, T, GLA_HEADS, GLA_K_DIM)
    o = chunk_gla(q, k, v, gk)
    o = rmsnorm(o, norm_w) * jax.nn.silu(out_gate.reshape(Bsz, T, GLA_HEADS, GLA_V_DIM).astype(jnp.float32))
    return o.reshape(Bsz, T, MIX_WIDTH).astype(dtype)


def setup_inputs(seed: int = 0) -> dict:
    key = jax.random.key(seed)
    ks = iter(jax.random.split(key, 40))

    def nrm(shape, scale):
        return jax.random.normal(next(ks), shape, jnp.float32) * scale

    def gain(shape):
        return 1.0 + nrm(shape, 0.02)

    def log_a(n):
        return jnp.log(jax.random.uniform(next(ks), (DEPTH, n), jnp.float32, 1.0, 16.0))

    def dt_bias(n):
        dt = jnp.exp(jax.random.uniform(next(ks), (DEPTH, n), jnp.float32, np.log(1e-3), np.log(1e-1)))
        return jnp.log(jnp.expm1(dt))

    return {
        "x": nrm((BATCH, SEQ, D_MODEL), 1.0),
        "p": nrm((DEPTH, BATCH, SEQ, PLE_DIM), 1.0),
        "pre_mix_norm": gain((DEPTH, D_MODEL)),
        "w_in": nrm((DEPTH, D_MODEL, IN_TOTAL), D_MODEL ** -0.5),
        "dn_conv_w": nrm((DEPTH, CONV_WIDTH, 3 * MIX_WIDTH), CONV_WIDTH ** -0.5),
        "dn_a_log": log_a(DN_HEADS),
        "dn_dt_bias": dt_bias(DN_HEADS),
        "dn_norm": gain((DEPTH, DN_HEAD_DIM)),
        "ssm_conv_w": nrm((DEPTH, CONV_WIDTH, MIX_WIDTH + 2 * SSM_GROUPS * SSM_STATE), CONV_WIDTH ** -0.5),
        "ssm_conv_b": nrm((DEPTH, MIX_WIDTH + 2 * SSM_GROUPS * SSM_STATE), 0.02),
        "ssm_dt_bias": dt_bias(SSM_HEADS),
        "ssm_a_log": log_a(SSM_HEADS),
        "ssm_d": gain((DEPTH, SSM_HEADS)),
        "ssm_norm": gain((DEPTH, MIX_WIDTH)),
        "gla_gate_w2": nrm((DEPTH, GLA_GATE_RANK, GLA_K_WIDTH), GLA_GATE_RANK ** -0.5),
        "gla_gate_b": nrm((DEPTH, GLA_K_WIDTH), 0.1),
        "gla_norm": gain((DEPTH, GLA_V_DIM)),
        "w_branch": nrm((DEPTH, N_BRANCH, MIX_WIDTH, D_MODEL), MIX_WIDTH ** -0.5),
        "w_out": nrm((DEPTH, D_MODEL, D_MODEL), D_MODEL ** -0.5),
        "post_mix_norm": gain((DEPTH, D_MODEL)),
        "pre_mlp_norm": gain((DEPTH, D_MODEL)),
        "w_up": nrm((DEPTH, D_MODEL, D_FF), D_MODEL ** -0.5),
        "w_down": nrm((DEPTH, D_FF, D_MODEL), D_FF ** -0.5),
        "post_mlp_norm": gain((DEPTH, D_MODEL)),
        "ple_pre_norm": gain((DEPTH, D_MODEL)),
        "w_ple_gate": nrm((DEPTH, D_MODEL, D_MODEL), D_MODEL ** -0.5),
        "w_ple_proj": nrm((DEPTH, PLE_DIM, D_MODEL), PLE_DIM ** -0.5),
        "ple_post_norm": gain((DEPTH, D_MODEL)),
    }


def reference(x, p, pre_mix_norm, w_in, dn_conv_w, dn_a_log, dn_dt_bias, dn_norm,
              ssm_conv_w, ssm_conv_b, ssm_dt_bias, ssm_a_log, ssm_d, ssm_norm,
              gla_gate_w2, gla_gate_b, gla_norm, w_branch, w_out, post_mix_norm,
              pre_mlp_norm, w_up, w_down, post_mlp_norm,
              ple_pre_norm, w_ple_gate, w_ple_proj, ple_post_norm):
    Bsz, T, D = x.shape
    split_idx = np.cumsum(IN_SPLITS)[:-1].tolist()
    for i in range(DEPTH):
        h = rmsnorm(x, pre_mix_norm[i])
        (dn_q, dn_k, dn_v, dn_b, dn_a, dn_g,
         s_z, s_x, s_B, s_C, s_dt,
         g_q, g_k, g_v, g_lr, g_o, br_gate) = jnp.split(h @ w_in[i], split_idx, axis=-1)
        y_dn = gated_deltanet_branch(dn_q, dn_k, dn_v, dn_b, dn_a, dn_g,
                                     dn_conv_w[i], dn_a_log[i], dn_dt_bias[i], dn_norm[i])
        y_ssm = mamba2_branch(s_z, s_x, s_B, s_C, s_dt, ssm_conv_w[i], ssm_conv_b[i],
                              ssm_dt_bias[i], ssm_a_log[i], ssm_d[i], ssm_norm[i])
        y_gla = gla_branch(g_q, g_k, g_v, g_lr, g_o, gla_gate_w2[i], gla_gate_b[i], gla_norm[i])
        branches = jnp.stack([y_dn, y_ssm, y_gla], axis=2)
        up = jnp.einsum('btnm,nmd->btnd', branches, w_branch[i])
        gates = jax.nn.sigmoid(br_gate.reshape(Bsz, T, N_BRANCH, D))
        mixed = jnp.sum(gates * up, axis=2) @ w_out[i]
        x = x + rmsnorm(mixed, post_mix_norm[i])
        h = rmsnorm(x, pre_mlp_norm[i])
        m = jnp.square(jax.nn.relu(h @ w_up[i])) @ w_down[i]
        x = x + rmsnorm(m, post_mlp_norm[i])
        ple_gate = jax.nn.sigmoid(rmsnorm(x, ple_pre_norm[i]) @ w_ple_gate[i])
        e = (p[i] @ w_ple_proj[i]) * ple_gate
        x = x + rmsnorm(e, ple_post_norm[i])
    return x
```

```cpp
#include <hip/hip_runtime.h>
#include <hip/hip_cooperative_groups.h>
#include <cstdio>
namespace cg = cooperative_groups;

#ifndef PROBE
#define PROBE 0
#endif
#ifndef SINGLE_LAUNCH
#define SINGLE_LAUNCH 1
#endif

#define LAS __attribute__((address_space(3)))
typedef unsigned short bf16_t;
typedef short bf16x8 __attribute__((ext_vector_type(8)));
typedef float f32x4 __attribute__((ext_vector_type(4)));
typedef unsigned u32x4 __attribute__((ext_vector_type(4)));
typedef unsigned u32x2 __attribute__((ext_vector_type(2)));

constexpr int T = 8192, DM = 2048, NP = 16128, INT = 15920, DFF = 8192, PLE = 256;
constexpr int NCH = 128;
constexpr float EPS = 1e-6f;
constexpr int C_DNQ = 0, C_DNB = 3072, C_DNA = 3080, C_DNG = 3088;
constexpr int C_SZ = 4112, C_SX = 5136, C_SDT = 6672;
constexpr int C_GQ = 6688, C_GK = 7200, C_GV = 7712, C_GLR = 8736, C_GO = 8752, C_BR = 9776;

constexpr size_t al256(size_t x) { return (x + 255) & ~(size_t)255; }
constexpr size_t WS_WIN = 0;
constexpr size_t WS_WBR = WS_WIN + (size_t)NP * 2048 * 2;
constexpr size_t WS_WOUT = WS_WBR + (size_t)3 * 2048 * 1024 * 2;
constexpr size_t WS_WUP = WS_WOUT + (size_t)2048 * 2048 * 2;
constexpr size_t WS_WDN = WS_WUP + (size_t)8192 * 2048 * 2;
constexpr size_t WS_WPG = WS_WDN + (size_t)2048 * 8192 * 2;
constexpr size_t WS_WPP = WS_WPG + (size_t)2048 * 2048 * 2;
constexpr size_t WS_PROJ = WS_WPP + (size_t)2048 * 256 * 2;
constexpr size_t WS_HB = WS_PROJ + (size_t)T * NP * 2;
constexpr size_t WS_PB = WS_HB + (size_t)T * 2048 * 2;
constexpr size_t WS_YBR = WS_PB + (size_t)2 * T * 256 * 2;
constexpr size_t WS_SSP = WS_YBR + (size_t)3 * T * 1024 * 2;
constexpr size_t WS_MIX = WS_SSP + (size_t)T * 32 * 4;
constexpr size_t E16 = (size_t)T * 1024 * 2;
constexpr size_t WS_DQ = WS_MIX, WS_DK = WS_DQ + E16, WS_DV = WS_DK + E16, WS_DW = WS_DV + E16, WS_DUT = WS_DW + E16, WS_DKDT = WS_DUT + E16,
                 WS_DQG = WS_DKDT + E16, WS_DATT = WS_DQG + E16, WS_DVNT = WS_DATT + E16 / 2, WS_DST = WS_DVNT + E16, WS_DGL = WS_DST + 2 * E16;
constexpr size_t WS_SX = WS_DGL + 4096, WS_SXDT = WS_SX + E16, WS_SXW = WS_SXDT + E16, WS_SB = WS_SXW + E16, WS_SC = WS_SB + E16 / 4, WS_SBT = WS_SC + E16 / 4,
                 WS_SMM = WS_SBT + E16 / 4, WS_SST = WS_SMM + E16, WS_SACS = WS_SST + 2 * E16;
constexpr size_t WS_GQG = WS_SACS + (size_t)NCH * 16 * 64 * 4, WS_GKN = WS_GQG + E16 / 2, WS_GKNT = WS_GKN + E16 / 2, WS_GVT = WS_GKNT + E16 / 2, WS_GATT = WS_GVT + E16,
                 WS_GST = WS_GATT + E16 / 4, WS_GDEC = WS_GST + 2 * E16;
constexpr size_t WS_END = WS_GDEC + (size_t)NCH * 512 * 4;
constexpr size_t WS_GOUT = WS_MIX;
constexpr size_t WS_MIXB = WS_GOUT + (size_t)T * 2048 * 4;
constexpr size_t WS_PP = WS_MIXB + (size_t)T * 2048 * 2;
constexpr size_t WS_GOUTB = WS_PP + (size_t)T * 2048 * 2;
static_assert(WS_GOUTB + (size_t)T * 2048 * 2 <= WS_END, "alias region");
constexpr size_t WS_BAR = (WS_END + 255) & ~(size_t)255;
constexpr size_t WS_CNTA = WS_BAR + 16384, WS_CNTB = WS_CNTA + 8192, WS_SLOTA = WS_CNTB + 8192, WS_SLOTB = WS_SLOTA + 262144;
constexpr size_t WS_WIN1 = WS_SLOTB + 262144;
constexpr size_t WS_TOTAL = WS_WIN1 + (size_t)NP * 2048 * 2;

struct Params {
    const float* in[28];
    float* out;
    unsigned char* ws;
};

__device__ __forceinline__ float bf2f(bf16_t b) { return __uint_as_float(((unsigned)b) << 16); }
typedef __bf16 bf16v2_t __attribute__((ext_vector_type(2)));
typedef float f32v2_t __attribute__((ext_vector_type(2)));
__device__ __forceinline__ bf16_t f2bf(float f) { const __bf16 b = (__bf16)f; return __builtin_bit_cast(unsigned short, b); }
__device__ __forceinline__ unsigned pk2(float lo, float hi) { const f32v2_t v = {lo, hi}; const bf16v2_t b = __builtin_convertvector(v, bf16v2_t); return __builtin_bit_cast(unsigned, b); }
__device__ __forceinline__ float lo16(unsigned u) { return __uint_as_float(u << 16); }
__device__ __forceinline__ float hi16(unsigned u) { return __uint_as_float(u & 0xffff0000u); }
__device__ __forceinline__ u32x2 pk4(f32x4 v) { u32x2 r; r.x = pk2(v[0], v[1]); r.y = pk2(v[2], v[3]); return r; }
__device__ __forceinline__ f32x4 up4(u32x2 u) { return (f32x4){lo16(u.x), hi16(u.x), lo16(u.y), hi16(u.y)}; }
__device__ __forceinline__ float sigmoidf_(float x) { return __builtin_amdgcn_rcpf(1.0f + __expf(-x)); }
__device__ __forceinline__ float siluf_(float x) { return x * __builtin_amdgcn_rcpf(1.0f + __expf(-x)); }
__device__ __forceinline__ float softplusf_(float x) { return fmaxf(x, 0.f) + __logf(1.0f + __expf(-fabsf(x))); }
__device__ __forceinline__ f32x4 mfma16(bf16x8 a, bf16x8 b, f32x4 c) { return __builtin_amdgcn_mfma_f32_16x16x32_bf16(a, b, c, 0, 0, 0); }
__device__ __forceinline__ bf16x8 ldfrag(const bf16_t* p) { return *(const bf16x8*)p; }
__device__ __forceinline__ unsigned cvt_pk_bf16(float lo, float hi) { return pk2(lo, hi); }


#define PIN16(a, o) asm volatile("" : "+v"(a[(o)+0]), "+v"(a[(o)+1]), "+v"(a[(o)+2]), "+v"(a[(o)+3]), "+v"(a[(o)+4]), "+v"(a[(o)+5]), "+v"(a[(o)+6]), "+v"(a[(o)+7]), \
    "+v"(a[(o)+8]), "+v"(a[(o)+9]), "+v"(a[(o)+10]), "+v"(a[(o)+11]), "+v"(a[(o)+12]), "+v"(a[(o)+13]), "+v"(a[(o)+14]), "+v"(a[(o)+15]))

#define XB_TMO      128
#define XB_XCNT(j)  (256  + 64 * (j))
#define XB_XSUB(j)  (1280 + 64 * (j))
#define XB_XGEN(j)  (2304 + 64 * (j))
#define XB_TOP      3328
#define XB_TOPGEN   3392
#define XCD_BAR_WORDS 3456
#define XB_SPIN_CAP (1u << 22)
__device__ __forceinline__ unsigned xb_ld(unsigned* p)              { return __hip_atomic_load(p, __ATOMIC_RELAXED, __HIP_MEMORY_SCOPE_AGENT); }
__device__ __forceinline__ unsigned xb_add(unsigned* p, unsigned v) { return __hip_atomic_fetch_add(p, v, __ATOMIC_RELAXED, __HIP_MEMORY_SCOPE_AGENT); }
__device__ __forceinline__ unsigned xb_xcc_id() { return (unsigned)__builtin_amdgcn_s_getreg((3 << 11) | 20) & 0xFu; }
#define XB_SPIN(cond, bar) do { unsigned _sp = 0; while (cond) { __builtin_amdgcn_s_sleep(1); \
    if ((++_sp & 255u) == 0u) { if (xb_ld(&(bar)[XB_TMO])) break; if (_sp > XB_SPIN_CAP) { atomicAdd(&(bar)[XB_TMO], 1u); break; } } } } while (0)
struct XcdBarrier { unsigned* bar; unsigned x; volatile LAS unsigned* st; };
__device__ __forceinline__ XcdBarrier xcd_barrier_post(unsigned* bar, volatile LAS unsigned* st) {
    XcdBarrier b; b.bar = bar; b.x = xb_xcc_id(); b.st = st;
    if (threadIdx.x == 0) (void)xb_add(&bar[XB_XCNT(b.x)], 1u);
    return b;
}
__device__ __forceinline__ void xcd_barrier_complete(unsigned* bar, unsigned x, unsigned& nloc, unsigned& nx) {
    const unsigned G = gridDim.x * gridDim.y * gridDim.z;
    unsigned sum, cnt, mine, sp = 0u;
    for (;;) {
        sum = 0u; cnt = 0u; mine = 0u;
#pragma unroll
        for (unsigned j = 0; j < 16; ++j) { const unsigned c = xb_ld(&bar[XB_XCNT(j)]); sum += c; cnt += (c > 0u) ? 1u : 0u; mine = (j == x) ? c : mine; }
        if (sum == G) break;
        __builtin_amdgcn_s_sleep(1);
        if ((++sp & 255u) == 0u) { if (xb_ld(&bar[XB_TMO])) break; if (sp > XB_SPIN_CAP) { atomicAdd(&bar[XB_TMO], 1u); break; } }
    }
    nloc = mine > 0u ? mine : 1u; nx = cnt > 0u ? cnt : 1u;
}
__device__ __forceinline__ void xcd_barrier(const XcdBarrier& b) {
    asm volatile("s_waitcnt vmcnt(0)" ::: "memory");
    __syncthreads();
    if (threadIdx.x == 0) {
        unsigned* bar = b.bar;
        __builtin_amdgcn_s_waitcnt(0);
        unsigned nloc = b.st[0], nx = b.st[1];
        if (nloc == 0u) { xcd_barrier_complete(bar, b.x, nloc, nx); b.st[0] = nloc; b.st[1] = nx; }
        const unsigned old = xb_add(&bar[XB_XSUB(b.x)], 1u);
        const unsigned gen = old / nloc;
        if (old + 1u == (gen + 1u) * nloc) {
            __builtin_amdgcn_fence(__ATOMIC_RELEASE, "agent");
            asm volatile("s_waitcnt vmcnt(0)" ::: "memory");
            const unsigned og = xb_add(&bar[XB_TOP], 1u);
            const unsigned tg = og / nx;
            if (og + 1u == (tg + 1u) * nx) xb_add(&bar[XB_TOPGEN], 1u);
            else XB_SPIN(xb_ld(&bar[XB_TOPGEN]) == tg, bar);
            __builtin_amdgcn_fence(__ATOMIC_ACQUIRE, "agent");
            xb_add(&bar[XB_XGEN(b.x)], 1u);
            asm volatile("s_waitcnt vmcnt(0)" ::: "memory");
        } else {
            XB_SPIN(xb_ld(&bar[XB_XGEN(b.x)]) == gen, bar);
            __builtin_amdgcn_fence(__ATOMIC_ACQUIRE, "agent");
            asm volatile("s_waitcnt vmcnt(0)" ::: "memory");
        }
    }
    __syncthreads();
}

namespace pg8 {
constexpr int BM = 256, BK = 64, HALF = 128, HTB = HALF * BK * 2, STAGE_BYTES = 8 * HTB, NXCD = 8, WGM = 8;
__device__ __forceinline__ int lds_byte(int r, int c) { const int st = (r >> 4) * 2 + (c >> 5), rr = r & 15, cc = c & 31, ob = rr * 64 + cc * 2; return st * 1024 + (ob ^ (((ob >> 9) & 1) << 5)); }
__device__ __forceinline__ void stage_rc(int b, int& R, int& C) { const int st = b / 1024, sb = b % 1024, swz = sb ^ (((sb >> 9) & 1) << 5); R = (st >> 1) * 16 + swz / 64; C = (st & 1) * 32 + (swz % 64) / 2; }
__device__ __forceinline__ int perm32(int rho) { const int n = rho >> 4, i = rho & 15; return 8 * (i >> 2) + 4 * n + (i & 3); }
struct Unit { int pm, pn, z; };
struct Gemm { const bf16_t* A; const bf16_t* Bt; int M, N, K; size_t zA, zB; };
struct StaticOrder {
    int nM, nN, nwg, G, c;
    __device__ void init(int M, int N, int G_, int c_) { nM = M / BM; nN = N / BM; nwg = nM * nN; G = G_; c = c_; }
    __device__ bool next(int i, Unit& u) const {
        const long L = (long)i * G + c; if (L >= nwg) return false;
        int wgid = (int)L; { const int q = nwg / NXCD, r = nwg % NXCD, xcd = wgid % NXCD, off = wgid / NXCD; wgid = (xcd < r ? xcd * (q + 1) : r * (q + 1) + (xcd - r) * q) + off; }
        const int nig = WGM * nN, gid = wgid / nig, fm = gid * WGM, gsz = (nM - fm) < WGM ? (nM - fm) : WGM;
        u.pm = fm + ((wgid % nig) % gsz); u.pn = (wgid % nig) / gsz; u.z = 0; return true;
    }
};
template <int NZ> struct StackOrder : StaticOrder {
    __device__ bool next(int i, Unit& u) const { if (i >= NZ) return false; const bool ok = StaticOrder::next(0, u); u.z = i; return ok; }
};
template <int ACT  > struct EpiBf16 {
    static constexpr bool PERM = true, AFTER_DRAIN = false;
    bf16_t* O; int ldc;
    __device__ __forceinline__ void operator()(const f32x4 (&acc)[2][2][4][2], const Unit& u, int wr, int wc, int fr, int fq) const {
        const int row0 = u.pm * BM + wr * 64 + fr, col0 = u.pn * BM + wc * 32 + 8 * fq;
#pragma unroll
        for (int ai = 0; ai < 2; ++ai)
#pragma unroll
            for (int m = 0; m < 4; ++m) { bf16_t* rowp = O + (size_t)(row0 + ai * HALF + m * 16) * ldc + col0;
#pragma unroll
                for (int bj = 0; bj < 2; ++bj) { f32x4 v0 = acc[ai][bj][m][0], v1 = acc[ai][bj][m][1];
                    if (ACT == 1) {
#pragma unroll
                        for (int j = 0; j < 4; ++j) { float a = fmaxf(v0[j], 0.f), b = fmaxf(v1[j], 0.f); v0[j] = a * a; v1[j] = b * b; } }
                    u32x4 w; w.x = cvt_pk_bf16(v0[0], v0[1]); w.y = cvt_pk_bf16(v0[2], v0[3]); w.z = cvt_pk_bf16(v1[0], v1[1]); w.w = cvt_pk_bf16(v1[2], v1[3]);
                    *(u32x4*)(rowp + bj * HALF) = w; } }
    }
};
struct EpiBranch {
    static constexpr bool PERM = true, AFTER_DRAIN = false;
    float* mix; bf16_t* mixb; const bf16_t* proj;
    template <int Z> __device__ __forceinline__ void run(const f32x4 (&acc)[2][2][4][2], const Unit& u, int wr, int wc, int fr, int fq) const {
        const int row0 = u.pm * BM + wr * 64 + fr, col0 = u.pn * BM + wc * 32 + 8 * fq;
#pragma unroll
        for (int ai = 0; ai < 2; ++ai)
#pragma unroll
            for (int m2 = 0; m2 < 4; m2 += 2) {
                u32x4 graw[2][2]; f32x4 old0[2][2], old1[2][2];
#pragma unroll
                for (int mm = 0; mm < 2; ++mm)
#pragma unroll
                    for (int bj = 0; bj < 2; ++bj) { const int row = row0 + ai * HALF + (m2 + mm) * 16, col = col0 + bj * HALF;
                        graw[mm][bj] = *(const u32x4*)(proj + (size_t)row * NP + C_BR + Z * 2048 + col);
                        if (Z > 0) { const float* mp = mix + (size_t)row * 2048 + col; old0[mm][bj] = *(const f32x4*)mp; old1[mm][bj] = *(const f32x4*)(mp + 4); } }
#pragma unroll
                for (int mm = 0; mm < 2; ++mm)
#pragma unroll
                    for (int bj = 0; bj < 2; ++bj) { const int row = row0 + ai * HALF + (m2 + mm) * 16, col = col0 + bj * HALF;
                        const u32x4 g = graw[mm][bj];
                        f32x4 v0 = acc[ai][bj][m2 + mm][0], v1 = acc[ai][bj][m2 + mm][1];
                        v0[0] *= sigmoidf_(lo16(g.x)); v0[1] *= sigmoidf_(hi16(g.x)); v0[2] *= sigmoidf_(lo16(g.y)); v0[3] *= sigmoidf_(hi16(g.y));
                        v1[0] *= sigmoidf_(lo16(g.z)); v1[1] *= sigmoidf_(hi16(g.z)); v1[2] *= sigmoidf_(lo16(g.w)); v1[3] *= sigmoidf_(hi16(g.w));
                        if (Z > 0) { v0 += old0[mm][bj]; v1 += old1[mm][bj]; }
                        if (Z < 2) { float* mp = mix + (size_t)row * 2048 + col; *(f32x4*)mp = v0; *(f32x4*)(mp + 4) = v1; }
                        else { u32x4 w; w.x = cvt_pk_bf16(v0[0], v0[1]); w.y = cvt_pk_bf16(v0[2], v0[3]); w.z = cvt_pk_bf16(v1[0], v1[1]); w.w = cvt_pk_bf16(v1[2], v1[3]);
                            *(u32x4*)(mixb + (size_t)row * 2048 + col) = w; } }
                asm volatile("" ::: "memory"); }
    }
    __device__ __forceinline__ void operator()(const f32x4 (&acc)[2][2][4][2], const Unit& u, int wr, int wc, int fr, int fq) const {
        if (u.z == 0) run<0>(acc, u, wr, wc, fr, fq); else if (u.z == 1) run<1>(acc, u, wr, wc, fr, fq); else run<2>(acc, u, wr, wc, fr, fq);
    }
};
template <int PLEMODE> struct EpiF32SS {
    static constexpr bool PERM = false, AFTER_DRAIN = false;
    bf16_t* C; float* ssp; const bf16_t* pp;
    __device__ __forceinline__ void operator()(const f32x4 (&acc)[2][2][4][2], const Unit& u, int wr, int wc, int fr, int fq) const {
        const int row0 = u.pm * BM + wr * 64 + fr, col0 = u.pn * BM + wc * 32 + 4 * fq;
#pragma unroll
        for (int ai = 0; ai < 2; ++ai)
#pragma unroll
            for (int m = 0; m < 4; ++m) { const int row = row0 + ai * HALF + m * 16; float s = 0.f;
#pragma unroll
                for (int bj = 0; bj < 2; ++bj)
#pragma unroll
                    for (int n = 0; n < 2; ++n) { const int col = col0 + bj * HALF + n * 16; f32x4 v = acc[ai][bj][m][n];
                        if (PLEMODE) { const f32x4 pv = up4(*(const u32x2*)(pp + (size_t)row * 2048 + col));
#pragma unroll
                            for (int j = 0; j < 4; ++j) v[j] = sigmoidf_(v[j]) * pv[j]; }
                        s += (v[0] * v[0] + v[1] * v[1]) + (v[2] * v[2] + v[3] * v[3]);
                        { u32x2 w; w.x = cvt_pk_bf16(v[0], v[1]); w.y = cvt_pk_bf16(v[2], v[3]); *(u32x2*)(C + (size_t)row * 2048 + col) = w; } }
                s += __shfl_xor(s, 16); s += __shfl_xor(s, 32);
                if (fq == 0) ssp[(size_t)row * 32 + u.pn * 4 + wc] = s; }
    }
};

struct RowStats {
    float* xbuf;
    unsigned* cnt;
    unsigned want;
    __device__ __forceinline__ void run(const f32x4 (&v)[2][2][4][2], const Unit& u, int wr, int wc, int fr, int fq, LAS unsigned char* lds, int wid, int lane) const {
        LAS float* Pt = (LAS float*)lds;
        LAS float* S = (LAS float*)(lds + 8192);
#pragma unroll
        for (int ai = 0; ai < 2; ++ai)
#pragma unroll
            for (int m = 0; m < 4; ++m) { float sq = 0.f;
#pragma unroll
                for (int bj = 0; bj < 2; ++bj)
#pragma unroll
                    for (int n = 0; n < 2; ++n) { const f32x4 x = v[ai][bj][m][n]; sq += (x[0] * x[0] + x[1] * x[1]) + (x[2] * x[2] + x[3] * x[3]); }
                sq += __shfl_xor(sq, 16); sq += __shfl_xor(sq, 32);
                if (fq == 0) Pt[(ai * HALF + wr * 64 + m * 16 + fr) * 4 + wc] = sq; }
        asm volatile("s_waitcnt lgkmcnt(0)" ::: "memory"); __builtin_amdgcn_s_barrier(); asm volatile("" ::: "memory");
        const int row = wid * 32 + (lane & 31);
        if (lane < 32) { const float a = (Pt[row * 4 + 0] + Pt[row * 4 + 1]) + (Pt[row * 4 + 2] + Pt[row * 4 + 3]);
            __hip_atomic_store(xbuf + ((size_t)(u.pm * BM + row) * 8 + u.pn), a, __ATOMIC_RELAXED, __HIP_MEMORY_SCOPE_AGENT); }
        asm volatile("s_waitcnt vmcnt(0)" ::: "memory");
        if (lane == 0) __hip_atomic_fetch_add(cnt + 64 * u.pm, 1u, __ATOMIC_RELAXED, __HIP_MEMORY_SCOPE_AGENT);
        if (wid == 0) { unsigned sp = 0;
            while ((unsigned)__builtin_amdgcn_readfirstlane(__hip_atomic_load(cnt + 64 * u.pm, __ATOMIC_RELAXED, __HIP_MEMORY_SCOPE_AGENT)) < want) { __builtin_amdgcn_s_sleep(2); if (++sp > (1u << 24)) break; }
            __builtin_amdgcn_fence(__ATOMIC_ACQUIRE, "agent"); }
        asm volatile("s_waitcnt vmcnt(0) lgkmcnt(0)" ::: "memory"); __builtin_amdgcn_s_barrier(); asm volatile("" ::: "memory");
        if (lane < 32) { const float* slot = xbuf + (size_t)(u.pm * BM + row) * 8; float sum = 0.f;
#pragma unroll
            for (int t = 0; t < 8; ++t) sum += __hip_atomic_load(slot + t, __ATOMIC_RELAXED, __HIP_MEMORY_SCOPE_AGENT);
            S[row] = rsqrtf(sum * (1.0f / 2048.0f) + EPS); }
        asm volatile("s_waitcnt lgkmcnt(0)" ::: "memory"); __builtin_amdgcn_s_barrier(); asm volatile("" ::: "memory");
    }
};
template <int PLEMODE, int HASNEXT> struct EpiRowFused {
    static constexpr bool PERM = false, AFTER_DRAIN = true;
    const float* xsrc; float* x; bf16_t* hb; const bf16_t* pp; const float* gpost; const float* gnext; RowStats st1, st2;
    __device__ __forceinline__ void fused(f32x4 (&acc)[2][2][4][2], const Unit& u, int wr, int wc, int fr, int fq, LAS unsigned char* lds, int wid, int lane) const {
        const LAS float* S = (const LAS float*)(lds + 8192);
        const int col0 = u.pn * BM + wc * 32 + 4 * fq;
        if (PLEMODE) {
#pragma unroll
            for (int ai = 0; ai < 2; ++ai)
#pragma unroll
                for (int m2 = 0; m2 < 4; m2 += 2) { u32x2 praw[2][2][2];
#pragma unroll
                    for (int mm = 0; mm < 2; ++mm)
#pragma unroll
                        for (int bj = 0; bj < 2; ++bj)
#pragma unroll
                            for (int n = 0; n < 2; ++n) { const int r = ai * HALF + wr * 64 + (m2 + mm) * 16 + fr; praw[mm][bj][n] = *(const u32x2*)(pp + (size_t)(u.pm * BM + r) * 2048 + col0 + bj * HALF + n * 16); }
#pragma unroll
                    for (int mm = 0; mm < 2; ++mm)
#pragma unroll
                        for (int bj = 0; bj < 2; ++bj)
#pragma unroll
                            for (int n = 0; n < 2; ++n) { const f32x4 pv = up4(praw[mm][bj][n]);
#pragma unroll
                                for (int j = 0; j < 4; ++j) acc[ai][bj][m2 + mm][n][j] = sigmoidf_(acc[ai][bj][m2 + mm][n][j]) * pv[j]; }
                    asm volatile("" ::: "memory"); }
        }
        st1.run(acc, u, wr, wc, fr, fq, lds, wid, lane);
        {
            f32x4 wv[2][2];
#pragma unroll
            for (int bj = 0; bj < 2; ++bj)
#pragma unroll
                for (int n = 0; n < 2; ++n) wv[bj][n] = *(const f32x4*)(gpost + col0 + bj * HALF + n * 16);
#pragma unroll
            for (int ai = 0; ai < 2; ++ai)
#pragma unroll
                for (int m = 0; m < 4; ++m) { f32x4 xs[2][2];
                    const int r = ai * HALF + wr * 64 + m * 16 + fr; const size_t off = (size_t)(u.pm * BM + r) * 2048 + col0;
#pragma unroll
                    for (int bj = 0; bj < 2; ++bj)
#pragma unroll
                        for (int n = 0; n < 2; ++n) xs[bj][n] = *(const f32x4*)(xsrc + off + bj * HALF + n * 16);
                    const float rn = S[r];
#pragma unroll
                    for (int bj = 0; bj < 2; ++bj)
#pragma unroll
                        for (int n = 0; n < 2; ++n) { const f32x4 o = xs[bj][n] + acc[ai][bj][m][n] * rn * wv[bj][n]; acc[ai][bj][m][n] = o; *(f32x4*)(x + off + bj * HALF + n * 16) = o; }
                    asm volatile("" ::: "memory"); }
        }
        if (HASNEXT) {
            st2.run(acc, u, wr, wc, fr, fq, lds, wid, lane);
            f32x4 wv[2][2];
#pragma unroll
            for (int bj = 0; bj < 2; ++bj)
#pragma unroll
                for (int n = 0; n < 2; ++n) wv[bj][n] = *(const f32x4*)(gnext + col0 + bj * HALF + n * 16);
#pragma unroll
            for (int ai = 0; ai < 2; ++ai)
#pragma unroll
                for (int m = 0; m < 4; ++m) { const int r = ai * HALF + wr * 64 + m * 16 + fr; const float r2 = S[r]; const size_t off = (size_t)(u.pm * BM + r) * 2048 + col0;
#pragma unroll
                    for (int bj = 0; bj < 2; ++bj)
#pragma unroll
                        for (int n = 0; n < 2; ++n) { const f32x4 o = acc[ai][bj][m][n] * r2 * wv[bj][n];
                            u32x2 pw; pw.x = cvt_pk_bf16(o[0], o[1]); pw.y = cvt_pk_bf16(o[2], o[3]); *(u32x2*)(hb + off + bj * HALF + n * 16) = pw; } }
        }
        asm volatile("s_waitcnt lgkmcnt(0)" ::: "memory"); __builtin_amdgcn_s_barrier(); asm volatile("" ::: "memory");
    }
};

template <class Epi, class Sched>
__device__ __forceinline__ void gemm_phase(LAS unsigned char* lds, const Gemm g, const Sched& S, const Epi& E) {
    int tid_l = threadIdx.x; asm volatile("" : "+v"(tid_l));
    const int tid = tid_l, wid = __builtin_amdgcn_readfirstlane(tid >> 6), lane = tid & 63, wr = wid >> 2, wc = wid & 3, fr = lane & 15, fq = lane >> 4;
    const int K = g.K, nt = K / BK;
    unsigned voffA[2], voffB[2];
#pragma unroll
    for (int i = 0; i < 2; ++i) { int R, C; stage_rc(tid * 16 + i * 8192, R, C); const int Rb = Epi::PERM ? ((R & ~31) + perm32(R & 31)) : R;
        voffA[i] = (unsigned)(R * K + C) * 2u; voffB[i] = (unsigned)(Rb * K + C) * 2u; }
    const size_t kstep = (size_t)(BK * 2);
    const size_t hstep = (size_t)HALF * K * 2;
    const size_t tstep = 2 * hstep;
    const unsigned ldsw = (unsigned)wid * 1024u;
    const int aoff = lds_byte(wr * 64 + fr, fq * 8), boff = lds_byte(wc * 32 + fr, fq * 8);
#define PG8_SA(b, h) (((b) * 2 + (h)) * HTB)
#define PG8_SB(b, h) ((4 + (b) * 2 + (h)) * HTB)
#define PG8_STAGE(bufoff, gbase, voff) do { _Pragma("unroll") for (int _i = 0; _i < 2; ++_i) \
        __builtin_amdgcn_global_load_lds((const unsigned*)((const char*)(gbase) + (voff)[_i]), (LAS unsigned*)(lds + (bufoff) + ldsw + _i * 8192), 16, 0, 0); } while (0)
#define PG8_LDA(dst, b, h) do { _Pragma("unroll") for (int m = 0; m < 4; ++m) _Pragma("unroll") for (int k = 0; k < 2; ++k) dst[m][k] = *(const LAS bf16x8*)(lds + PG8_SA(b, h) + aoff + m * 2048 + k * 1024); } while (0)
#define PG8_LDB(dst, b, h) do { _Pragma("unroll") for (int n = 0; n < 2; ++n) _Pragma("unroll") for (int k = 0; k < 2; ++k) dst[n][k] = *(const LAS bf16x8*)(lds + PG8_SB(b, h) + boff + n * 2048 + k * 1024); } while (0)
#define PG8_MMA(ai, bj, At, Bt) do { __builtin_amdgcn_s_setprio(1); _Pragma("unroll") for (int m = 0; m < 4; ++m) _Pragma("unroll") for (int n = 0; n < 2; ++n) _Pragma("unroll") for (int k = 0; k < 2; ++k) \
        acc[ai][bj][m][n] = __builtin_amdgcn_mfma_f32_16x16x32_bf16(Bt[n][k], At[m][k], acc[ai][bj][m][n], 0, 0, 0); __builtin_amdgcn_s_setprio(0); } while (0)
#define PG8_WAIT_V(n) asm volatile("s_waitcnt vmcnt(" #n ")" ::: "memory")
#define PG8_WAIT_L(n) asm volatile("s_waitcnt lgkmcnt(" #n ")" ::: "memory")
#define PG8_BAR __builtin_amdgcn_s_barrier()
#define PG8_SCHED __builtin_amdgcn_sched_barrier(0)
    Unit cur, nxt; int ui = 0;
    if (!S.next(0, cur)) return;
    f32x4 acc[2][2][4][2];
#pragma unroll
    for (int a = 0; a < 2; ++a)
#pragma unroll
        for (int b = 0; b < 2; ++b)
#pragma unroll
            for (int m = 0; m < 4; ++m)
#pragma unroll
                for (int n = 0; n < 2; ++n) acc[a][b][m][n] = (f32x4){0.f, 0.f, 0.f, 0.f};
    bf16x8 At[4][2], B0[2][2], B1[2][2];
    const char* cA = (const char*)g.A + (size_t)cur.z * g.zA + (size_t)cur.pm * tstep; const char* cB = (const char*)g.Bt + (size_t)cur.z * g.zB + (size_t)cur.pn * tstep;
    PG8_STAGE(PG8_SB(0, 0), cB, voffB); PG8_STAGE(PG8_SA(0, 0), cA, voffA); PG8_STAGE(PG8_SB(0, 1), cB + hstep, voffB); PG8_STAGE(PG8_SA(0, 1), cA + hstep, voffA);
    if (wr == 1) PG8_BAR;
    PG8_WAIT_V(4); PG8_BAR;
    PG8_STAGE(PG8_SB(1, 0), cB + kstep, voffB); PG8_STAGE(PG8_SA(1, 0), cA + kstep, voffA); PG8_STAGE(PG8_SB(1, 1), cB + hstep + kstep, voffB);
    PG8_WAIT_V(6); PG8_BAR;
    for (;;) {
        const bool has_next = S.next(ui + 1, nxt);
        const char* nA = has_next ? (const char*)g.A + (size_t)nxt.z * g.zA + (size_t)nxt.pm * tstep : cA; const char* nB = has_next ? (const char*)g.Bt + (size_t)nxt.z * g.zB + (size_t)nxt.pn * tstep : cB;
        for (int t = 0; t < nt; t += 2) {
            const bool last = (t == nt - 2);
            const char* a1 = cA + (size_t)(t + 1) * kstep;
            const char* a2 = last ? nA : cA + (size_t)(t + 2) * kstep; const char* b2 = last ? nB : cB + (size_t)(t + 2) * kstep;
            const char* a3 = a2 + kstep; const char* b3 = b2 + kstep;
            PG8_LDB(B0, 0, 0); PG8_SCHED; PG8_LDA(At, 0, 0); PG8_STAGE(PG8_SA(1, 1), a1 + hstep, voffA);
            PG8_WAIT_L(8); PG8_BAR; PG8_WAIT_L(0); PG8_MMA(0, 0, At, B0); PG8_BAR; PG8_SCHED;
            PG8_LDB(B1, 0, 1); PG8_STAGE(PG8_SB(0, 0), b2, voffB);
            PG8_BAR; PG8_WAIT_L(0); PG8_MMA(0, 1, At, B1); PG8_BAR;
            PG8_LDA(At, 0, 1); PG8_STAGE(PG8_SA(0, 0), a2, voffA);
            PG8_BAR; PG8_WAIT_L(0); PG8_MMA(1, 0, At, B0); PG8_BAR; PG8_SCHED;
            PG8_STAGE(PG8_SB(0, 1), b2 + hstep, voffB);
            PG8_WAIT_V(6); PG8_BAR; PG8_MMA(1, 1, At, B1); PG8_BAR;
            PG8_LDB(B0, 1, 0); PG8_SCHED; PG8_LDA(At, 1, 0); PG8_STAGE(PG8_SA(0, 1), a2 + hstep, voffA);
            PG8_WAIT_L(8); PG8_BAR; PG8_WAIT_L(0); PG8_MMA(0, 0, At, B0); PG8_BAR; PG8_SCHED;
            PG8_LDB(B1, 1, 1); PG8_STAGE(PG8_SB(1, 0), b3, voffB);
            PG8_BAR; PG8_WAIT_L(0); PG8_MMA(0, 1, At, B1); PG8_BAR;
            PG8_LDA(At, 1, 1); PG8_STAGE(PG8_SA(1, 0), a3, voffA);
            PG8_BAR; PG8_WAIT_L(0); PG8_MMA(1, 0, At, B0); PG8_BAR; PG8_SCHED;
            PG8_STAGE(PG8_SB(1, 1), b3 + hstep, voffB);
            PG8_WAIT_V(6); PG8_BAR; PG8_MMA(1, 1, At, B1); PG8_BAR;
        }
        if constexpr (!Epi::AFTER_DRAIN) E(acc, cur, wr, wc, fr, fq);
        if (!has_next) break;
#pragma unroll
        for (int a = 0; a < 2; ++a)
#pragma unroll
            for (int b = 0; b < 2; ++b)
#pragma unroll
                for (int m = 0; m < 4; ++m)
#pragma unroll
                    for (int n = 0; n < 2; ++n) acc[a][b][m][n] = (f32x4){0.f, 0.f, 0.f, 0.f};
        cur = nxt; cA = nA; cB = nB; ++ui;
    }
    PG8_WAIT_V(0);
    if (wr == 0) PG8_BAR;
    PG8_BAR;
    if constexpr (Epi::AFTER_DRAIN) E.fused(acc, cur, wr, wc, fr, fq, lds, wid, lane);
#undef PG8_SA
#undef PG8_SB
#undef PG8_STAGE
#undef PG8_LDA
#undef PG8_LDB
#undef PG8_MMA
#undef PG8_WAIT_V
#undef PG8_WAIT_L
#undef PG8_BAR
#undef PG8_SCHED
}
}

__device__ void convT(const float* __restrict__ W, int K, int N, bf16_t* __restrict__ Wt, int Npad, float* tile, int bid, int nb) {
    int tid_l = threadIdx.x; asm volatile("" : "+v"(tid_l));
    const int tk = K / 64, tn = Npad / 64, ntiles = tk * tn, tid = tid_l;
    const int r0 = tid >> 4, c4 = (tid & 15) * 4;
    f32x4 cur0 = (f32x4){0.f, 0.f, 0.f, 0.f}, cur1 = cur0, nx0 = cur0, nx1 = cur0;
    int t = bid;
    if (t < ntiles) { const int k0 = (t % tk) * 64, n = (t / tk) * 64 + c4;
        if (n < N) { cur0 = __builtin_nontemporal_load((const f32x4*)(W + (size_t)(k0 + r0) * N + n)); cur1 = __builtin_nontemporal_load((const f32x4*)(W + (size_t)(k0 + r0 + 32) * N + n)); } }
    for (; t < ntiles; t += nb) {
        const int k0 = (t % tk) * 64, n0 = (t / tk) * 64;
        tile[r0 * 65 + c4 + 0] = cur0[0]; tile[r0 * 65 + c4 + 1] = cur0[1]; tile[r0 * 65 + c4 + 2] = cur0[2]; tile[r0 * 65 + c4 + 3] = cur0[3];
        tile[(r0 + 32) * 65 + c4 + 0] = cur1[0]; tile[(r0 + 32) * 65 + c4 + 1] = cur1[1]; tile[(r0 + 32) * 65 + c4 + 2] = cur1[2]; tile[(r0 + 32) * 65 + c4 + 3] = cur1[3];
        asm volatile("s_waitcnt lgkmcnt(0)" ::: "memory"); __builtin_amdgcn_s_barrier(); asm volatile("" ::: "memory");
        { const int t2 = t + nb; nx0 = (f32x4){0.f, 0.f, 0.f, 0.f}; nx1 = nx0;
          if (t2 < ntiles) { const int k2 = (t2 % tk) * 64, n2 = (t2 / tk) * 64 + c4;
              if (n2 < N) { nx0 = __builtin_nontemporal_load((const f32x4*)(W + (size_t)(k2 + r0) * N + n2)); nx1 = __builtin_nontemporal_load((const f32x4*)(W + (size_t)(k2 + r0 + 32) * N + n2)); } } }
        { const int n = tid >> 3, kg = (tid & 7) * 8; u32x4 w;
          w.x = pk2(tile[(kg + 0) * 65 + n], tile[(kg + 1) * 65 + n]); w.y = pk2(tile[(kg + 2) * 65 + n], tile[(kg + 3) * 65 + n]);
          w.z = pk2(tile[(kg + 4) * 65 + n], tile[(kg + 5) * 65 + n]); w.w = pk2(tile[(kg + 6) * 65 + n], tile[(kg + 7) * 65 + n]);
          __builtin_nontemporal_store(w, (u32x4*)(Wt + (size_t)(n0 + n) * K + k0 + kg)); }
        asm volatile("s_waitcnt lgkmcnt(0)" ::: "memory"); __builtin_amdgcn_s_barrier(); asm volatile("" ::: "memory");
        cur0 = nx0; cur1 = nx1;
    }
    __syncthreads();
}

__device__ void row_phase(const float* __restrict__ xin, float* __restrict__ xio, const bf16_t* __restrict__ gout, const float* __restrict__ ssp,
                          const float* __restrict__ gpost, const float* __restrict__ gnext, bf16_t* __restrict__ hb, int mode, int gw, int nw) {
    int tid_l = threadIdx.x; asm volatile("" : "+v"(tid_l));
    const int lane = tid_l & 63;
    for (int row = gw; row < T; row += nw) {
        f32x4 xv[8];
        const size_t rb = (size_t)row * 2048;
        if (mode == 0 || mode == 2) {
#pragma unroll
            for (int i = 0; i < 8; ++i) xv[i] = *(const f32x4*)(xin + rb + (i * 64 + lane) * 4);
        } else {
            float ss = ssp[(size_t)row * 32 + (lane & 31)];
            ss += __shfl_xor(ss, 1); ss += __shfl_xor(ss, 2); ss += __shfl_xor(ss, 4); ss += __shfl_xor(ss, 8); ss += __shfl_xor(ss, 16);
            const float rn = rsqrtf(ss * (1.0f / 2048.0f) + EPS);
#pragma unroll
            for (int i = 0; i < 8; ++i) { const int col = (i * 64 + lane) * 4;
                const f32x4 g = up4(*(const u32x2*)(gout + rb + col)), w = *(const f32x4*)(gpost + col), x0 = *(const f32x4*)(xio + rb + col);
                xv[i] = x0 + g * rn * w; }
        }
        if (mode != 2) {
#pragma unroll
            for (int i = 0; i < 8; ++i) *(f32x4*)(xio + rb + (i * 64 + lane) * 4) = xv[i]; }
        if (gnext) {
            float s2 = 0.f;
#pragma unroll
            for (int i = 0; i < 8; ++i) s2 += (xv[i][0] * xv[i][0] + xv[i][1] * xv[i][1]) + (xv[i][2] * xv[i][2] + xv[i][3] * xv[i][3]);
            s2 += __shfl_xor(s2, 1); s2 += __shfl_xor(s2, 2); s2 += __shfl_xor(s2, 4); s2 += __shfl_xor(s2, 8); s2 += __shfl_xor(s2, 16); s2 += __shfl_xor(s2, 32);
            const float r2 = rsqrtf(s2 * (1.0f / 2048.0f) + EPS);
#pragma unroll
            for (int i = 0; i < 8; ++i) { const int col = (i * 64 + lane) * 4; const f32x4 w = *(const f32x4*)(gnext + col); const f32x4 o = xv[i] * r2 * w;
                *(u32x2*)(hb + rb + col) = pk4(o); }
        }
    }
}

struct Ctx {
    const __attribute__((address_space(4))) Params* P; int layer, bid, nb, tid, wave, lane, r, q, gw, nw;
    unsigned char* ws;
    float* ldsf;
    template <class Tp> __device__ __forceinline__ Tp* W(size_t off) const { return (Tp*)(ws + off); }
    __device__ __forceinline__ const float* in(int i) const { return P->in[i]; }
};
enum { I_X = 0, I_P, I_PREMIX, I_WIN, I_DNCONV, I_DNALOG, I_DNDTB, I_DNNORM, I_SCONVW, I_SCONVB, I_SDTB, I_SALOG, I_SD, I_SNORM, I_GW2, I_GB, I_GNORM, I_WBR, I_WOUT,
       I_POSTMIX, I_PREMLP, I_WUP, I_WDN, I_POSTMLP, I_PLEPRE, I_WPG, I_WPP, I_PLEPOST };

__device__ __forceinline__ void prep_dn_load(const bf16_t* proj, const float* cw, int idx, u32x4 (&raw)[4], int& t, int& ch) {
    if (idx >= 0) { t = idx / 384; const int j = idx - t * 384; ch = j * 8; }
#pragma unroll
    for (int k = 0; k < 4; ++k) { const int tt = t - 3 + k; raw[k] = (u32x4){0u, 0u, 0u, 0u};
        if (tt >= 0) raw[k] = *(const u32x4*)(proj + (size_t)tt * NP + C_DNQ + ch); }
}
__device__ __forceinline__ void prep_dn_finish(const float* cw, bf16_t* dq, bf16_t* dk, bf16_t* dv, const u32x4 (&raw)[4], int t, int ch) {
    float a[8];
#pragma unroll
    for (int e = 0; e < 8; ++e) a[e] = 0.f;
#pragma unroll
    for (int k = 0; k < 4; ++k) {
        const f32x4 w0 = *(const f32x4*)(cw + k * 3072 + ch), w1 = *(const f32x4*)(cw + k * 3072 + ch + 4);
        a[0] += w0[0] * lo16(raw[k].x); a[1] += w0[1] * hi16(raw[k].x); a[2] += w0[2] * lo16(raw[k].y); a[3] += w0[3] * hi16(raw[k].y);
        a[4] += w1[0] * lo16(raw[k].z); a[5] += w1[1] * hi16(raw[k].z); a[6] += w1[2] * lo16(raw[k].w); a[7] += w1[3] * hi16(raw[k].w); }
    float ss = 0.f;
#pragma unroll
    for (int e = 0; e < 8; ++e) { a[e] = siluf_(a[e]); ss += a[e] * a[e]; }
    ss += __shfl_xor(ss, 1); ss += __shfl_xor(ss, 2); ss += __shfl_xor(ss, 4); ss += __shfl_xor(ss, 8);
    float sc = 1.0f;
    if (ch < 2048) { sc = rsqrtf(ss + EPS); if (ch < 1024) sc *= 0.08838834764831845f; }
    u32x4 w; w.x = pk2(a[0] * sc, a[1] * sc); w.y = pk2(a[2] * sc, a[3] * sc); w.z = pk2(a[4] * sc, a[5] * sc); w.w = pk2(a[6] * sc, a[7] * sc);
    bf16_t* dst = (ch < 1024) ? dq : (ch < 2048 ? dk : dv);
    *(u32x4*)(dst + (size_t)t * 1024 + (ch & 1023)) = w;
}
__device__ void prep_dn(const Ctx& c) {
    const bf16_t* proj = c.W<bf16_t>(WS_PROJ);
    const float* cw = c.in(I_DNCONV) + (size_t)c.layer * 4 * 3072;
    bf16_t* dq = c.W<bf16_t>(WS_DQ); bf16_t* dk = c.W<bf16_t>(WS_DK); bf16_t* dv = c.W<bf16_t>(WS_DV);
    const int total = T * 384, stride = c.nw * 64;
    int base = c.gw * 64;
    for (; base + stride < total; base += 2 * stride) {
        u32x4 r0[4], r1[4]; int t0, c0, t1, c1;
        prep_dn_load(proj, cw, base + c.lane, r0, t0, c0);
        prep_dn_load(proj, cw, base + stride + c.lane, r1, t1, c1);
        prep_dn_finish(cw, dq, dk, dv, r0, t0, c0);
        prep_dn_finish(cw, dq, dk, dv, r1, t1, c1);
    }
    if (base < total) { u32x4 r0[4]; int t0, c0; prep_dn_load(proj, cw, base + c.lane, r0, t0, c0); prep_dn_finish(cw, dq, dk, dv, r0, t0, c0); }
}

__device__ void prep_dn_chunk(const Ctx& c, int ck, int half) {
    const bf16_t* proj = c.W<bf16_t>(WS_PROJ);
    const float* cw = c.in(I_DNCONV) + (size_t)c.layer * 4 * 3072;
    bf16_t* dq = c.W<bf16_t>(WS_DQ); bf16_t* dk = c.W<bf16_t>(WS_DK); bf16_t* dv = c.W<bf16_t>(WS_DV);
    for (int it = c.tid; it < 64 * 192; it += 1024) {
        u32x4 r0[4], r1[4]; int t0, c0, t1, c1;
        { const int l = it / 192, j = it - l * 192; t0 = ck * 64 + l; c0 = (j >> 6) * 1024 + half * 512 + (j & 63) * 8; }
        { const int i2 = it + 512, l = i2 / 192, j = i2 - l * 192; t1 = ck * 64 + l; c1 = (j >> 6) * 1024 + half * 512 + (j & 63) * 8; }
        prep_dn_load(proj, cw, -1, r0, t0, c0);
        prep_dn_load(proj, cw, -1, r1, t1, c1);
        prep_dn_finish(cw, dq, dk, dv, r0, t0, c0);
        prep_dn_finish(cw, dq, dk, dv, r1, t1, c1);
    }
}

__device__ void prep_ssd(const Ctx& c, int ck, int blk) {
    const bf16_t* proj = c.W<bf16_t>(WS_PROJ);
    const float* cw = c.in(I_SCONVW) + (size_t)c.layer * 4 * 1536; const float* cb = c.in(I_SCONVB) + (size_t)c.layer * 1536;
    const int tid = c.tid, t0 = ck * 64;
    float* dt_s = c.ldsf; float* acs_s = c.ldsf + 512;
    __syncthreads();
    if (blk < 2) {
        { const int hh = tid >> 6, l = tid & 63, h = blk * 8 + hh;
          const float raw = bf2f(proj[(size_t)(t0 + l) * NP + C_SDT + h]);
          const float dt = softplusf_(raw + c.in(I_SDTB)[c.layer * 16 + h]);
          float a = dt * (-__expf(c.in(I_SALOG)[c.layer * 16 + h]));
#pragma unroll
          for (int d = 1; d < 64; d <<= 1) { const float o = __shfl_up(a, d); if (l >= d) a += o; }
          const float alast = __shfl(a, 63);
          dt_s[tid] = dt; acs_s[tid] = a; c.ldsf[1024 + tid] = dt * __expf(alast - a); }
        __syncthreads();
        { const int h = blk * 8 + (tid >> 6); c.W<float>(WS_SACS)[(size_t)(ck * 16 + h) * 64 + (tid & 63)] = acs_s[tid]; }
        const int ch = blk * 512 + tid, h = ch >> 6, p = ch & 63, hh = tid >> 6;
        const float w0 = cw[ch], w1 = cw[1536 + ch], w2 = cw[2 * 1536 + ch], w3 = cw[3 * 1536 + ch], bb = cb[ch];
        float xm3 = 0.f, xm2 = 0.f, xm1 = 0.f;
        if (t0 > 0) { xm3 = bf2f(proj[(size_t)(t0 - 3) * NP + C_SX + ch]); xm2 = bf2f(proj[(size_t)(t0 - 2) * NP + C_SX + ch]); xm1 = bf2f(proj[(size_t)(t0 - 1) * NP + C_SX + ch]); }
        const float acl = acs_s[hh * 64 + 63];
        bf16_t* sX = c.W<bf16_t>(WS_SX); bf16_t* sXdT = c.W<bf16_t>(WS_SXDT); bf16_t* sXwT = c.W<bf16_t>(WS_SXW);
        bf16_t* sXp = sX + (size_t)t0 * 1024 + ch; asm volatile("" : "+v"(sXp));
        float raw[64];
        { unsigned rw[64];
          const bf16_t* rp0 = proj + (size_t)t0 * NP + C_SX + ch; asm volatile("" : "+v"(rp0));
#pragma unroll
          for (int l = 0; l < 64; ++l) rw[l] = rp0[(size_t)l * NP];
          PIN16(rw, 0); PIN16(rw, 16); PIN16(rw, 32); PIN16(rw, 48);
#pragma unroll
          for (int l = 0; l < 64; ++l) raw[l] = __uint_as_float(rw[l] << 16); }
#pragma unroll
        for (int l0 = 0; l0 < 64; l0 += 8) {
            float xd[8], xw[8];
#pragma unroll
            for (int j = 0; j < 8; ++j) { const int l = l0 + j;
                const float xc = raw[l];
                const float y = w0 * xm3 + w1 * xm2 + w2 * xm1 + w3 * xc + bb; xm3 = xm2; xm2 = xm1; xm1 = xc;
                const float x = siluf_(y);
                sXp[(size_t)l * 1024] = f2bf(x);
                xd[j] = x * dt_s[hh * 64 + l]; xw[j] = x * c.ldsf[1024 + hh * 64 + l]; }
            u32x4 a, b; a.x = pk2(xd[0], xd[1]); a.y = pk2(xd[2], xd[3]); a.z = pk2(xd[4], xd[5]); a.w = pk2(xd[6], xd[7]);
            b.x = pk2(xw[0], xw[1]); b.y = pk2(xw[2], xw[3]); b.z = pk2(xw[4], xw[5]); b.w = pk2(xw[6], xw[7]);
            const size_t o = ((size_t)(ck * 16 + h) * 64 + p) * 64 + l0;
            *(u32x4*)(sXdT + o) = a; *(u32x4*)(sXwT + o) = b;
        }
    } else {
        if (tid >= 256) return;
        const int isC = tid >> 7, cc = (blk - 2) * 128 + (tid & 127), ch = 1024 + isC * 256 + cc;
        const float w0 = cw[ch], w1 = cw[1536 + ch], w2 = cw[2 * 1536 + ch], w3 = cw[3 * 1536 + ch], bb = cb[ch];
        float xm3 = 0.f, xm2 = 0.f, xm1 = 0.f;
        if (t0 > 0) { xm3 = bf2f(proj[(size_t)(t0 - 3) * NP + C_SX + ch]); xm2 = bf2f(proj[(size_t)(t0 - 2) * NP + C_SX + ch]); xm1 = bf2f(proj[(size_t)(t0 - 1) * NP + C_SX + ch]); }
        bf16_t* rowdst = isC ? c.W<bf16_t>(WS_SC) : c.W<bf16_t>(WS_SB);
        bf16_t* sBT = c.W<bf16_t>(WS_SBT);
        const int g = cc >> 7, n = cc & 127;
        float raw[64];
        { unsigned rw[64];
          const bf16_t* rp0 = proj + (size_t)t0 * NP + C_SX + ch; asm volatile("" : "+v"(rp0));
#pragma unroll
          for (int l = 0; l < 64; ++l) rw[l] = rp0[(size_t)l * NP];
          PIN16(rw, 0); PIN16(rw, 16); PIN16(rw, 32); PIN16(rw, 48);
#pragma unroll
          for (int l = 0; l < 64; ++l) raw[l] = __uint_as_float(rw[l] << 16); }
#pragma unroll
        for (int l0 = 0; l0 < 64; l0 += 8) {
            float xv[8];
#pragma unroll
            for (int j = 0; j < 8; ++j) { const int l = l0 + j;
                const float xc = raw[l];
                const float y = w0 * xm3 + w1 * xm2 + w2 * xm1 + w3 * xc + bb; xm3 = xm2; xm2 = xm1; xm1 = xc;
                const float x = siluf_(y); xv[j] = x;
                rowdst[(size_t)(t0 + l) * 256 + cc] = f2bf(x); }
            if (!isC) { u32x4 a; a.x = pk2(xv[0], xv[1]); a.y = pk2(xv[2], xv[3]); a.z = pk2(xv[4], xv[5]); a.w = pk2(xv[6], xv[7]);
                *(u32x4*)(sBT + ((size_t)(ck * 2 + g) * 128 + n) * 64 + l0) = a; }
        }
    }
}

__device__ void prep_gla(const Ctx& c, int ck, int blk) {
    const bf16_t* proj = c.W<bf16_t>(WS_PROJ);
    const int tid = c.tid, t0 = ck * 64;
    float* lr_s = c.ldsf;
    __syncthreads();
    if (blk >= 10) {
        { const int l = tid >> 3, r2 = (tid & 7) * 2; const unsigned u = *(const unsigned*)(proj + (size_t)(t0 + l) * NP + C_GLR + r2); lr_s[l * 16 + r2] = lo16(u); lr_s[l * 16 + r2 + 1] = hi16(u); }
        __syncthreads();
        if (tid >= 256) return;
        const int ch = (blk - 10) * 256 + tid, h = ch >> 7, k = ch & 127;
        const float* w2 = c.in(I_GW2) + (size_t)c.layer * 16 * 512;
        float w2r[16];
#pragma unroll
        for (int r = 0; r < 16; ++r) w2r[r] = w2[r * 512 + ch];
        const float b2 = c.in(I_GB)[c.layer * 512 + ch];
        bf16_t* gQg = c.W<bf16_t>(WS_GQG); bf16_t* gKn = c.W<bf16_t>(WS_GKN); bf16_t* gKnT = c.W<bf16_t>(WS_GKNT);
        float G = 0.f;
        for (int lh = 0; lh < 64; lh += 32) {
            float qr[32], kr[32];
            { unsigned qw[32], kw[32];
              const bf16_t* rq0 = proj + (size_t)(t0 + lh) * NP + C_GQ + ch; asm volatile("" : "+v"(rq0));
#pragma unroll
              for (int l = 0; l < 32; ++l) { qw[l] = rq0[(size_t)l * NP]; kw[l] = rq0[(size_t)l * NP + (C_GK - C_GQ)]; }
              PIN16(qw, 0); PIN16(kw, 0); PIN16(qw, 16); PIN16(kw, 16);
#pragma unroll
              for (int l = 0; l < 32; ++l) { qr[l] = __uint_as_float(qw[l] << 16); kr[l] = __uint_as_float(kw[l] << 16); } }
#pragma unroll
            for (int l0 = 0; l0 < 32; l0 += 8) {
                float kn[8];
#pragma unroll
                for (int j = 0; j < 8; ++j) { const int l = lh + l0 + j;
                    float x = b2;
#pragma unroll
                    for (int r4 = 0; r4 < 16; r4 += 4) { const f32x4 lv = *(const f32x4*)(lr_s + l * 16 + r4); x += lv[0] * w2r[r4] + lv[1] * w2r[r4 + 1] + lv[2] * w2r[r4 + 2] + lv[3] * w2r[r4 + 3]; }
                    G += -softplusf_(-x) * (1.0f / 16.0f);
                    const float qv = qr[l0 + j] * 0.08838834764831845f, kv = kr[l0 + j];
                    const size_t o = ((size_t)(ck * 4 + h) * 64 + l) * 128 + k;
                    const float eG = __expf(G); gQg[o] = f2bf(qv * eG); const float kneg = kv * __builtin_amdgcn_rcpf(eG); gKn[o] = f2bf(kneg); kn[j] = kneg; }
                u32x4 a; a.x = pk2(kn[0], kn[1]); a.y = pk2(kn[2], kn[3]); a.z = pk2(kn[4], kn[5]); a.w = pk2(kn[6], kn[7]);
                *(u32x4*)(gKnT + ((size_t)(ck * 4 + h) * 128 + k) * 64 + lh + l0) = a;
            }
        }
        c.W<float>(WS_GDEC)[(size_t)ck * 512 + ch] = __expf(G);
    } else {
        const int ch = (blk - 1) * 512 + tid, h = ch >> 8, v = ch & 255;
        bf16_t* gVT = c.W<bf16_t>(WS_GVT);
        unsigned e[64];
        const bf16_t* rv0 = proj + (size_t)t0 * NP + C_GV + ch; asm volatile("" : "+v"(rv0));
#pragma unroll
        for (int l = 0; l < 64; ++l) e[l] = rv0[(size_t)l * NP];
        PIN16(e, 0); PIN16(e, 16); PIN16(e, 32); PIN16(e, 48);
#pragma unroll
        for (int l0 = 0; l0 < 64; l0 += 8) {
            u32x4 a; a.x = e[l0] | (e[l0 + 1] << 16); a.y = e[l0 + 2] | (e[l0 + 3] << 16); a.z = e[l0 + 4] | (e[l0 + 5] << 16); a.w = e[l0 + 6] | (e[l0 + 7] << 16);
            *(u32x4*)(gVT + ((size_t)(ck * 4 + h) * 256 + v) * 64 + l0) = a;
        }
    }
}

#define SOLVE_ROW_BEGIN(i) { float a0 = x[i], a1 = 0.f, a2 = 0.f, a3 = 0.f; const float* mr = Ms + (i) * 68;
#define SOLVE_ROW_END(i) x[i] = (a0 + a1) + (a2 + a3); }
__device__ void dn_d1(const Ctx& c, int ip) {
    const bf16_t* proj = c.W<bf16_t>(WS_PROJ);
    const bf16_t* dq = c.W<bf16_t>(WS_DQ); const bf16_t* dk = c.W<bf16_t>(WS_DK); const bf16_t* dv = c.W<bf16_t>(WS_DV);
    const int tid = c.tid, half = tid >> 8, lt = tid & 255, lw = c.wave & 3, r = c.r, q = c.q;
    const int item = ip * 2 + half, ck = item >> 3, h = item & 7, t0 = ck * 64;
    float* Ms = c.ldsf + half * (64 * 68 + 256); float* beta_s = Ms + 64 * 68; float* gc_s = beta_s + 64; float* eg_s = gc_s + 64; float* ekd_s = eg_s + 64;
    const size_t ch = (size_t)(ck * 8 + h);
    __syncthreads();
    if (lt < 64) { const size_t rb = (size_t)(t0 + lt) * NP;
        beta_s[lt] = sigmoidf_(bf2f(proj[rb + C_DNB + h]));
        float g = -__expf(c.in(I_DNALOG)[c.layer * 8 + h]) * softplusf_(bf2f(proj[rb + C_DNA + h]) + c.in(I_DNDTB)[c.layer * 8 + h]);
#pragma unroll
        for (int d = 1; d < 64; d <<= 1) { const float o = __shfl_up(g, d); if ((lt & 63) >= d) g += o; }
        gc_s[lt] = g; eg_s[lt] = __expf(g); ekd_s[lt] = __expf(__shfl(g, 63) - g); }
    __syncthreads();
    {
        const int ib = lw;
        bf16_t* dAtt = c.W<bf16_t>(WS_DATT);
        bf16x8 fki[4], fqi[4];
#pragma unroll
        for (int kk = 0; kk < 4; ++kk) { fki[kk] = ldfrag(dk + (size_t)(t0 + ib * 16 + r) * 1024 + h * 128 + kk * 32 + q * 8); fqi[kk] = ldfrag(dq + (size_t)(t0 + ib * 16 + r) * 1024 + h * 128 + kk * 32 + q * 8); }
#pragma unroll
        for (int jb = 0; jb < 4; ++jb) {
            f32x4 aK = (f32x4){0.f, 0.f, 0.f, 0.f}, aA = aK;
            if (jb <= ib) {
#pragma unroll
                for (int kk = 0; kk < 4; ++kk) {
                    const bf16x8 fkj = ldfrag(dk + (size_t)(t0 + jb * 16 + r) * 1024 + h * 128 + kk * 32 + q * 8);
                    aK = mfma16(fki[kk], fkj, aK);
                    aA = mfma16(fkj, fqi[kk], aA);
                }
#pragma unroll
                for (int j = 0; j < 4; ++j) { const int i = ib * 16 + 4 * q + j, jj = jb * 16 + r;
                    Ms[i * 68 + jj] = (i > jj) ? beta_s[i] * aK[j] * __expf(gc_s[i] - gc_s[jj]) : 0.f; }
            }
            { const int i = ib * 16 + r; f32x4 o;
#pragma unroll
              for (int j = 0; j < 4; ++j) { const int jj = jb * 16 + 4 * q + j; o[j] = (i >= jj) ? aA[j] * __expf(gc_s[i] - gc_s[jj]) : 0.f; }
              *(u32x2*)(dAtt + (ch * 64 + i) * 64 + jb * 16 + 4 * q) = pk4(o); }
        }
    }
    float x[64];
    const int col = lt & 127; const bool isw = lt >= 128;
    const float glast = gc_s[63];
    {
        const bf16_t* src = (isw ? dk : dv) + (size_t)t0 * 1024 + h * 128 + col;
        { unsigned rw[64];
#pragma unroll
          for (int i = 0; i < 64; ++i) rw[i] = src[(size_t)i * 1024];
          PIN16(rw, 0); PIN16(rw, 16); PIN16(rw, 32); PIN16(rw, 48);
#pragma unroll
          for (int i = 0; i < 64; ++i) x[i] = __uint_as_float(rw[i] << 16); }
        if (isw) {
            bf16_t* dKdT = c.W<bf16_t>(WS_DKDT);
#pragma unroll
            for (int l0 = 0; l0 < 64; l0 += 8) { u32x4 a;
                a.x = pk2(x[l0 + 0] * ekd_s[l0 + 0], x[l0 + 1] * ekd_s[l0 + 1]); a.y = pk2(x[l0 + 2] * ekd_s[l0 + 2], x[l0 + 3] * ekd_s[l0 + 3]);
                a.z = pk2(x[l0 + 4] * ekd_s[l0 + 4], x[l0 + 5] * ekd_s[l0 + 5]); a.w = pk2(x[l0 + 6] * ekd_s[l0 + 6], x[l0 + 7] * ekd_s[l0 + 7]);
                *(u32x4*)(dKdT + (ch * 128 + col) * 64 + l0) = a; }
#pragma unroll
            for (int i = 0; i < 64; ++i) x[i] *= beta_s[i] * eg_s[i];
        } else {
            bf16_t* dQg = c.W<bf16_t>(WS_DQG); const bf16_t* qs = dq + (size_t)t0 * 1024 + h * 128 + col;
            unsigned qv[64];
#pragma unroll
            for (int i = 0; i < 64; ++i) qv[i] = qs[(size_t)i * 1024];
            PIN16(qv, 0); PIN16(qv, 16); PIN16(qv, 32); PIN16(qv, 48);
#pragma unroll
            for (int i = 0; i < 64; ++i) dQg[(ch * 64 + i) * 128 + col] = f2bf(__uint_as_float(qv[i] << 16) * eg_s[i]);
#pragma unroll
            for (int i = 0; i < 64; ++i) x[i] *= beta_s[i];
        }
    }
    if (lt == 0) c.W<float>(WS_DGL)[ch] = __expf(glast);
    __syncthreads();
    SOLVE_ROW_BEGIN(1)
    { const f32x4 m = *(const f32x4*)(mr + 0);
      a0 -= m[0] * x[0];
    }
    SOLVE_ROW_END(1)
    SOLVE_ROW_BEGIN(2)
    { const f32x4 m = *(const f32x4*)(mr + 0);
      a0 -= m[0] * x[0];
      a1 -= m[1] * x[1];
    }
    SOLVE_ROW_END(2)
    SOLVE_ROW_BEGIN(3)
    { const f32x4 m = *(const f32x4*)(mr + 0);
      a0 -= m[0] * x[0];
      a1 -= m[1] * x[1];
      a2 -= m[2] * x[2];
    }
    SOLVE_ROW_END(3)
    SOLVE_ROW_BEGIN(4)
    { const f32x4 m = *(const f32x4*)(mr + 0);
      a0 -= m[0] * x[0];
      a1 -= m[1] * x[1];
      a2 -= m[2] * x[2];
      a3 -= m[3] * x[3];
    }
    SOLVE_ROW_END(4)
    SOLVE_ROW_BEGIN(5)
    { const f32x4 m = *(const f32x4*)(mr + 0);
      a0 -= m[0] * x[0];
      a1 -= m[1] * x[1];
      a2 -= m[2] * x[2];
      a3 -= m[3] * x[3];
    }
    { const f32x4 m = *(const f32x4*)(mr + 4);
      a0 -= m[0] * x[4];
    }
    SOLVE_ROW_END(5)
    SOLVE_ROW_BEGIN(6)
    { const f32x4 m = *(const f32x4*)(mr + 0);
      a0 -= m[0] * x[0];
      a1 -= m[1] * x[1];
      a2 -= m[2] * x[2];
      a3 -= m[3] * x[3];
    }
    { const f32x4 m = *(const f32x4*)(mr + 4);
      a0 -= m[0] * x[4];
      a1 -= m[1] * x[5];
    }
    SOLVE_ROW_END(6)
    SOLVE_ROW_BEGIN(7)
    { const f32x4 m = *(const f32x4*)(mr + 0);
      a0 -= m[0] * x[0];
      a1 -= m[1] * x[1];
      a2 -= m[2] * x[2];
      a3 -= m[3] * x[3];
    }
    { const f32x4 m = *(const f32x4*)(mr + 4);
      a0 -= m[0] * x[4];
      a1 -= m[1] * x[5];
      a2 -= m[2] * x[6];
    }
    SOLVE_ROW_END(7)
    SOLVE_ROW_BEGIN(8)
    { const f32x4 m = *(const f32x4*)(mr + 0);
      a0 -= m[0] * x[0];
      a1 -= m[1] * x[1];
      a2 -= m[2] * x[2];
      a3 -= m[3] * x[3];
    }
    { const f32x4 m = *(const f32x4*)(mr + 4);
      a0 -= m[0] * x[4];
      a1 -= m[1] * x[5];
      a2 -= m[2] * x[6];
      a3 -= m[3] * x[7];
    }
    SOLVE_ROW_END(8)
    SOLVE_ROW_BEGIN(9)
    { const f32x4 m = *(const f32x4*)(mr + 0);
      a0 -= m[0] * x[0];
      a1 -= m[1] * x[1];
      a2 -= m[2] * x[2];
      a3 -= m[3] * x[3];
    }
    { const f32x4 m = *(const f32x4*)(mr + 4);
      a0 -= m[0] * x[4];
      a1 -= m[1] * x[5];
      a2 -= m[2] * x[6];
      a3 -= m[3] * x[7];
    }
    { const f32x4 m = *(const f32x4*)(mr + 8);
      a0 -= m[0] * x[8];
    }
    SOLVE_ROW_END(9)
    SOLVE_ROW_BEGIN(10)
    { const f32x4 m = *(const f32x4*)(mr + 0);
      a0 -= m[0] * x[0];
      a1 -= m[1] * x[1];
      a2 -= m[2] * x[2];
      a3 -= m[3] * x[3];
    }
    { const f32x4 m = *(const f32x4*)(mr + 4);
      a0 -= m[0] * x[4];
      a1 -= m[1] * x[5];
      a2 -= m[2] * x[6];
      a3 -= m[3] * x[7];
    }
    { const f32x4 m = *(const f32x4*)(mr + 8);
      a0 -= m[0] * x[8];
      a1 -= m[1] * x[9];
    }
    SOLVE_ROW_END(10)
    SOLVE_ROW_BEGIN(11)
    { const f32x4 m = *(const f32x4*)(mr + 0);
      a0 -= m[0] * x[0];
      a1 -= m[1] * x[1];
      a2 -= m[2] * x[2];
      a3 -= m[3] * x[3];
    }
    { const f32x4 m = *(const f32x4*)(mr + 4);
      a0 -= m[0] * x[4];
      a1 -= m[1] * x[5];
      a2 -= m[2] * x[6];
      a3 -= m[3] * x[7];
    }
    { const f32x4 m = *(const f32x4*)(mr + 8);
      a0 -= m[0] * x[8];
      a1 -= m[1] * x[9];
      a2 -= m[2] * x[10];
    }
    SOLVE_ROW_END(11)
    SOLVE_ROW_BEGIN(12)
    { const f32x4 m = *(const f32x4*)(mr + 0);
      a0 -= m[0] * x[0];
      a1 -= m[1] * x[1];
      a2 -= m[2] * x[2];
      a3 -= m[3] * x[3];
    }
    { const f32x4 m = *(const f32x4*)(mr + 4);
      a0 -= m[0] * x[4];
      a1 -= m[1] * x[5];
      a2 -= m[2] * x[6];
      a3 -= m[3] * x[7];
    }
    { const f32x4 m = *(const f32x4*)(mr + 8);
      a0 -= m[0] * x[8];
      a1 -= m[1] * x[9];
      a2 -= m[2] * x[10];
      a3 -= m[3] * x[11];
    }
    SOLVE_ROW_END(12)
    SOLVE_ROW_BEGIN(13)
    { const f32x4 m = *(const f32x4*)(mr + 0);
      a0 -= m[0] * x[0];
      a1 -= m[1] * x[1];
      a2 -= m[2] * x[2];
      a3 -= m[3] * x[3];
    }
    { const f32x4 m = *(const f32x4*)(mr + 4);
      a0 -= m[0] * x[4];
      a1 -= m[1] * x[5];
      a2 -= m[2] * x[6];
      a3 -= m[3] * x[7];
    }
    { const f32x4 m = *(const f32x4*)(mr + 8);
      a0 -= m[0] * x[8];
      a1 -= m[1] * x[9];
      a2 -= m[2] * x[10];
      a3 -= m[3] * x[11];
    }
    { const f32x4 m = *(const f32x4*)(mr + 12);
      a0 -= m[0] * x[12];
    }
    SOLVE_ROW_END(13)
    SOLVE_ROW_BEGIN(14)
    { const f32x4 m = *(const f32x4*)(mr + 0);
      a0 -= m[0] * x[0];
      a1 -= m[1] * x[1];
      a2 -= m[2] * x[2];
      a3 -= m[3] * x[3];
    }
    { const f32x4 m = *(const f32x4*)(mr + 4);
      a0 -= m[0] * x[4];
      a1 -= m[1] * x[5];
      a2 -= m[2] * x[6];
      a3 -= m[3] * x[7];
    }
    { const f32x4 m = *(const f32x4*)(mr + 8);
      a0 -= m[0] * x[8];
      a1 -= m[1] * x[9];
      a2 -= m[2] * x[10];
      a3 -= m[3] * x[11];
    }
    { const f32x4 m = *(const f32x4*)(mr + 12);
      a0 -= m[0] * x[12];
      a1 -= m[1] * x[13];
    }
    SOLVE_ROW_END(14)
    SOLVE_ROW_BEGIN(15)
    { const f32x4 m = *(const f32x4*)(mr + 0);
      a0 -= m[0] * x[0];
      a1 -= m[1] * x[1];
      a2 -= m[2] * x[2];
      a3 -= m[3] * x[3];
    }
    { const f32x4 m = *(const f32x4*)(mr + 4);
      a0 -= m[0] * x[4];
      a1 -= m[1] * x[5];
      a2 -= m[2] * x[6];
      a3 -= m[3] * x[7];
    }
    { const f32x4 m = *(const f32x4*)(mr + 8);
      a0 -= m[0] * x[8];
      a1 -= m[1] * x[9];
      a2 -= m[2] * x[10];
      a3 -= m[3] * x[11];
    }
    { const f32x4 m = *(const f32x4*)(mr + 12);
      a0 -= m[0] * x[12];
      a1 -= m[1] * x[13];
      a2 -= m[2] * x[14];
    }
    SOLVE_ROW_END(15)
    SOLVE_ROW_BEGIN(16)
    { const f32x4 m = *(const f32x4*)(mr + 0);
      a0 -= m[0] * x[0];
      a1 -= m[1] * x[1];
      a2 -= m[2] * x[2];
      a3 -= m[3] * x[3];
    }
    { const f32x4 m = *(const f32x4*)(mr + 4);
      a0 -= m[0] * x[4];
      a1 -= m[1] * x[5];
      a2 -= m[2] * x[6];
      a3 -= m[3] * x[7];
    }
    { const f32x4 m = *(const f32x4*)(mr + 8);
      a0 -= m[0] * x[8];
      a1 -= m[1] * x[9];
      a2 -= m[2] * x[10];
      a3 -= m[3] * x[11];
    }
    { const f32x4 m = *(const f32x4*)(mr + 12);
      a0 -= m[0] * x[12];
      a1 -= m[1] * x[13];
      a2 -= m[2] * x[14];
      a3 -= m[3] * x[15];
    }
    SOLVE_ROW_END(16)
    SOLVE_ROW_BEGIN(17)
    { const f32x4 m = *(const f32x4*)(mr + 0);
      a0 -= m[0] * x[0];
      a1 -= m[1] * x[1];
      a2 -= m[2] * x[2];
      a3 -= m[3] * x[3];
    }
    { const f32x4 m = *(const f32x4*)(mr + 4);
      a0 -= m[0] * x[4];
      a1 -= m[1] * x[5];
      a2 -= m[2] * x[6];
      a3 -= m[3] * x[7];
    }
    { const f32x4 m = *(const f32x4*)(mr + 8);
      a0 -= m[0] * x[8];
      a1 -= m[1] * x[9];
      a2 -= m[2] * x[10];
      a3 -= m[3] * x[11];
    }
    { const f32x4 m = *(const f32x4*)(mr + 12);
      a0 -= m[0] * x[12];
      a1 -= m[1] * x[13];
      a2 -= m[2] * x[14];
      a3 -= m[3] * x[15];
    }
    { const f32x4 m = *(const f32x4*)(mr + 16);
      a0 -= m[0] * x[16];
    }
    SOLVE_ROW_END(17)
    SOLVE_ROW_BEGIN(18)
    { const f32x4 m = *(const f32x4*)(mr + 0);
      a0 -= m[0] * x[0];
      a1 -= m[1] * x[1];
      a2 -= m[2] * x[2];
      a3 -= m[3] * x[3];
    }
    { const f32x4 m = *(const f32x4*)(mr + 4);
      a0 -= m[0] * x[4];
      a1 -= m[1] * x[5];
      a2 -= m[2] * x[6];
      a3 -= m[3] * x[7];
    }
    { const f32x4 m = *(const f32x4*)(mr + 8);
      a0 -= m[0] * x[8];
      a1 -= m[1] * x[9];
      a2 -= m[2] * x[10];
      a3 -= m[3] * x[11];
    }
    { const f32x4 m = *(const f32x4*)(mr + 12);
      a0 -= m[0] * x[12];
      a1 -= m[1] * x[13];
      a2 -= m[2] * x[14];
      a3 -= m[3] * x[15];
    }
    { const f32x4 m = *(const f32x4*)(mr + 16);
      a0 -= m[0] * x[16];
      a1 -= m[1] * x[17];
    }
    SOLVE_ROW_END(18)
    SOLVE_ROW_BEGIN(19)
    { const f32x4 m = *(const f32x4*)(mr + 0);
      a0 -= m[0] * x[0];
      a1 -= m[1] * x[1];
      a2 -= m[2] * x[2];
      a3 -= m[3] * x[3];
    }
    { const f32x4 m = *(const f32x4*)(mr + 4);
      a0 -= m[0] * x[4];
      a1 -= m[1] * x[5];
      a2 -= m[2] * x[6];
      a3 -= m[3] * x[7];
    }
    { const f32x4 m = *(const f32x4*)(mr + 8);
      a0 -= m[0] * x[8];
      a1 -= m[1] * x[9];
      a2 -= m[2] * x[10];
      a3 -= m[3] * x[11];
    }
    { const f32x4 m = *(const f32x4*)(mr + 12);
      a0 -= m[0] * x[12];
      a1 -= m[1] * x[13];
      a2 -= m[2] * x[14];
      a3 -= m[3] * x[15];
    }
    { const f32x4 m = *(const f32x4*)(mr + 16);
      a0 -= m[0] * x[16];
      a1 -= m[1] * x[17];
      a2 -= m[2] * x[18];
    }
    SOLVE_ROW_END(19)
    SOLVE_ROW_BEGIN(20)
    { const f32x4 m = *(const f32x4*)(mr + 0);
      a0 -= m[0] * x[0];
      a1 -= m[1] * x[1];
      a2 -= m[2] * x[2];
      a3 -= m[3] * x[3];
    }
    { const f32x4 m = *(const f32x4*)(mr + 4);
      a0 -= m[0] * x[4];
      a1 -= m[1] * x[5];
      a2 -= m[2] * x[6];
      a3 -= m[3] * x[7];
    }
    { const f32x4 m = *(const f32x4*)(mr + 8);
      a0 -= m[0] * x[8];
      a1 -= m[1] * x[9];
      a2 -= m[2] * x[10];
      a3 -= m[3] * x[11];
    }
    { const f32x4 m = *(const f32x4*)(mr + 12);
      a0 -= m[0] * x[12];
      a1 -= m[1] * x[13];
      a2 -= m[2] * x[14];
      a3 -= m[3] * x[15];
    }
    { const f32x4 m = *(const f32x4*)(mr + 16);
      a0 -= m[0] * x[16];
      a1 -= m[1] * x[17];
      a2 -= m[2] * x[18];
      a3 -= m[3] * x[19];
    }
    SOLVE_ROW_END(20)
    SOLVE_ROW_BEGIN(21)
    { const f32x4 m = *(const f32x4*)(mr + 0);
      a0 -= m[0] * x[0];
      a1 -= m[1] * x[1];
      a2 -= m[2] * x[2];
      a3 -= m[3] * x[3];
    }
    { const f32x4 m = *(const f32x4*)(mr + 4);
      a0 -= m[0] * x[4];
      a1 -= m[1] * x[5];
      a2 -= m[2] * x[6];
      a3 -= m[3] * x[7];
    }
    { const f32x4 m = *(const f32x4*)(mr + 8);
      a0 -= m[0] * x[8];
      a1 -= m[1] * x[9];
      a2 -= m[2] * x[10];
      a3 -= m[3] * x[11];
    }
    { const f32x4 m = *(const f32x4*)(mr + 12);
      a0 -= m[0] * x[12];
      a1 -= m[1] * x[13];
      a2 -= m[2] * x[14];
      a3 -= m[3] * x[15];
    }
    { const f32x4 m = *(const f32x4*)(mr + 16);
      a0 -= m[0] * x[16];
      a1 -= m[1] * x[17];
      a2 -= m[2] * x[18];
      a3 -= m[3] * x[19];
    }
    { const f32x4 m = *(const f32x4*)(mr + 20);
      a0 -= m[0] * x[20];
    }
    SOLVE_ROW_END(21)
    SOLVE_ROW_BEGIN(22)
    { const f32x4 m = *(const f32x4*)(mr + 0);
      a0 -= m[0] * x[0];
      a1 -= m[1] * x[1];
      a2 -= m[2] * x[2];
      a3 -= m[3] * x[3];
    }
    { const f32x4 m = *(const f32x4*)(mr + 4);
      a0 -= m[0] * x[4];
      a1 -= m[1] * x[5];
      a2 -= m[2] * x[6];
      a3 -= m[3] * x[7];
    }
    { const f32x4 m = *(const f32x4*)(mr + 8);
      a0 -= m[0] * x[8];
      a1 -= m[1] * x[9];
      a2 -= m[2] * x[10];
      a3 -= m[3] * x[11];
    }
    { const f32x4 m = *(const f32x4*)(mr + 12);
      a0 -= m[0] * x[12];
      a1 -= m[1] * x[13];
      a2 -= m[2] * x[14];
      a3 -= m[3] * x[15];
    }
    { const f32x4 m = *(const f32x4*)(mr + 16);
      a0 -= m[0] * x[16];
      a1 -= m[1] * x[17];
      a2 -= m[2] * x[18];
      a3 -= m[3] * x[19];
    }
    { const f32x4 m = *(const f32x4*)(mr + 20);
      a0 -= m[0] * x[20];
      a1 -= m[1] * x[21];
    }
    SOLVE_ROW_END(22)
    SOLVE_ROW_BEGIN(23)
    { const f32x4 m = *(const f32x4*)(mr + 0);
      a0 -= m[0] * x[0];
      a1 -= m[1] * x[1];
      a2 -= m[2] * x[2];
      a3 -= m[3] * x[3];
    }
    { const f32x4 m = *(const f32x4*)(mr + 4);
      a0 -= m[0] * x[4];
      a1 -= m[1] * x[5];
      a2 -= m[2] * x[6];
      a3 -= m[3] * x[7];
    }
    { const f32x4 m = *(const f32x4*)(mr + 8);
      a0 -= m[0] * x[8];
      a1 -= m[1] * x[9];
      a2 -= m[2] * x[10];
      a3 -= m[3] * x[11];
    }
    { const f32x4 m = *(const f32x4*)(mr + 12);
      a0 -= m[0] * x[12];
      a1 -= m[1] * x[13];
      a2 -= m[2] * x[14];
      a3 -= m[3] * x[15];
    }
    { const f32x4 m = *(const f32x4*)(mr + 16);
      a0 -= m[0] * x[16];
      a1 -= m[1] * x[17];
      a2 -= m[2] * x[18];
      a3 -= m[3] * x[19];
    }
    { const f32x4 m = *(const f32x4*)(mr + 20);
      a0 -= m[0] * x[20];
      a1 -= m[1] * x[21];
      a2 -= m[2] * x[22];
    }
    SOLVE_ROW_END(23)
    SOLVE_ROW_BEGIN(24)
    { const f32x4 m = *(const f32x4*)(mr + 0);
      a0 -= m[0] * x[0];
      a1 -= m[1] * x[1];
      a2 -= m[2] * x[2];
      a3 -= m[3] * x[3];
    }
    { const f32x4 m = *(const f32x4*)(mr + 4);
      a0 -= m[0] * x[4];
      a1 -= m[1] * x[5];
      a2 -= m[2] * x[6];
      a3 -= m[3] * x[7];
    }
    { const f32x4 m = *(const f32x4*)(mr + 8);
      a0 -= m[0] * x[8];
      a1 -= m[1] * x[9];
      a2 -= m[2] * x[10];
      a3 -= m[3] * x[11];
    }
    { const f32x4 m = *(const f32x4*)(mr + 12);
      a0 -= m[0] * x[12];
      a1 -= m[1] * x[13];
      a2 -= m[2] * x[14];
      a3 -= m[3] * x[15];
    }
    { const f32x4 m = *(const f32x4*)(mr + 16);
      a0 -= m[0] * x[16];
      a1 -= m[1] * x[17];
      a2 -= m[2] * x[18];
      a3 -= m[3] * x[19];
    }
    { const f32x4 m = *(const f32x4*)(mr + 20);
      a0 -= m[0] * x[20];
      a1 -= m[1] * x[21];
      a2 -= m[2] * x[22];
      a3 -= m[3] * x[23];
    }
    SOLVE_ROW_END(24)
    SOLVE_ROW_BEGIN(25)
    { const f32x4 m = *(const f32x4*)(mr + 0);
      a0 -= m[0] * x[0];
      a1 -= m[1] * x[1];
      a2 -= m[2] * x[2];
      a3 -= m[3] * x[3];
    }
    { const f32x4 m = *(const f32x4*)(mr + 4);
      a0 -= m[0] * x[4];
      a1 -= m[1] * x[5];
      a2 -= m[2] * x[6];
      a3 -= m[3] * x[7];
    }
    { const f32x4 m = *(const f32x4*)(mr + 8);
      a0 -= m[0] * x[8];
      a1 -= m[1] * x[9];
      a2 -= m[2] * x[10];
      a3 -= m[3] * x[11];
    }
    { const f32x4 m = *(const f32x4*)(mr + 12);
      a0 -= m[0] * x[12];
      a1 -= m[1] * x[13];
      a2 -= m[2] * x[14];
      a3 -= m[3] * x[15];
    }
    { const f32x4 m = *(const f32x4*)(mr + 16);
      a0 -= m[0] * x[16];
      a1 -= m[1] * x[17];
      a2 -= m[2] * x[18];
      a3 -= m[3] * x[19];
    }
    { const f32x4 m = *(const f32x4*)(mr + 20);
      a0 -= m[0] * x[20];
      a1 -= m[1] * x[21];
      a2 -= m[2] * x[22];
      a3 -= m[3] * x[23];
    }
    { const f32x4 m = *(const f32x4*)(mr + 24);
      a0 -= m[0] * x[24];
    }
    SOLVE_ROW_END(25)
    SOLVE_ROW_BEGIN(26)
    { const f32x4 m = *(const f32x4*)(mr + 0);
      a0 -= m[0] * x[0];
      a1 -= m[1] * x[1];
      a2 -= m[2] * x[2];
      a3 -= m[3] * x[3];
    }
    { const f32x4 m = *(const f32x4*)(mr + 4);
      a0 -= m[0] * x[4];
      a1 -= m[1] * x[5];
      a2 -= m[2] * x[6];
      a3 -= m[3] * x[7];
    }
    { const f32x4 m = *(const f32x4*)(mr + 8);
      a0 -= m[0] * x[8];
      a1 -= m[1] * x[9];
      a2 -= m[2] * x[10];
      a3 -= m[3] * x[11];
    }
    { const f32x4 m = *(const f32x4*)(mr + 12);
      a0 -= m[0] * x[12];
      a1 -= m[1] * x[13];
      a2 -= m[2] * x[14];
      a3 -= m[3] * x[15];
    }
    { const f32x4 m = *(const f32x4*)(mr + 16);
      a0 -= m[0] * x[16];
      a1 -= m[1] * x[17];
      a2 -= m[2] * x[18];
      a3 -= m[3] * x[19];
    }
    { const f32x4 m = *(const f32x4*)(mr + 20);
      a0 -= m[0] * x[20];
      a1 -= m[1] * x[21];
      a2 -= m[2] * x[22];
      a3 -= m[3] * x[23];
    }
    { const f32x4 m = *(const f32x4*)(mr + 24);
      a0 -= m[0] * x[24];
      a1 -= m[1] * x[25];
    }
    SOLVE_ROW_END(26)
    SOLVE_ROW_BEGIN(27)
    { const f32x4 m = *(const f32x4*)(mr + 0);
      a0 -= m[0] * x[0];
      a1 -= m[1] * x[1];
      a2 -= m[2] * x[2];
      a3 -= m[3] * x[3];
    }
    { const f32x4 m = *(const f32x4*)(mr + 4);
      a0 -= m[0] * x[4];
      a1 -= m[1] * x[5];
      a2 -= m[2] * x[6];
      a3 -= m[3] * x[7];
    }
    { const f32x4 m = *(const f32x4*)(mr + 8);
      a0 -= m[0] * x[8];
      a1 -= m[1] * x[9];
      a2 -= m[2] * x[10];
      a3 -= m[3] * x[11];
    }
    { const f32x4 m = *(const f32x4*)(mr + 12);
      a0 -= m[0] * x[12];
      a1 -= m[1] * x[13];
      a2 -= m[2] * x[14];
      a3 -= m[3] * x[15];
    }
    { const f32x4 m = *(const f32x4*)(mr + 16);
      a0 -= m[0] * x[16];
      a1 -= m[1] * x[17];
      a2 -= m[2] * x[18];
      a3 -= m[3] * x[19];
    }
    { const f32x4 m = *(const f32x4*)(mr + 20);
      a0 -= m[0] * x[20];
      a1 -= m[1] * x[21];
      a2 -= m[2] * x[22];
      a3 -= m[3] * x[23];
    }
    { const f32x4 m = *(const f32x4*)(mr + 24);
      a0 -= m[0] * x[24];
      a1 -= m[1] * x[25];
      a2 -= m[2] * x[26];
    }
    SOLVE_ROW_END(27)
    SOLVE_ROW_BEGIN(28)
    { const f32x4 m = *(const f32x4*)(mr + 0);
      a0 -= m[0] * x[0];
      a1 -= m[1] * x[1];
      a2 -= m[2] * x[2];
      a3 -= m[3] * x[3];
    }
    { const f32x4 m = *(const f32x4*)(mr + 4);
      a0 -= m[0] * x[4];
      a1 -= m[1] * x[5];
      a2 -= m[2] * x[6];
      a3 -= m[3] * x[7];
    }
    { const f32x4 m = *(const f32x4*)(mr + 8);
      a0 -= m[0] * x[8];
      a1 -= m[1] * x[9];
      a2 -= m[2] * x[10];
      a3 -= m[3] * x[11];
    }
    { const f32x4 m = *(const f32x4*)(mr + 12);
      a0 -= m[0] * x[12];
      a1 -= m[1] * x[13];
      a2 -= m[2] * x[14];
      a3 -= m[3] * x[15];
    }
    { const f32x4 m = *(const f32x4*)(mr + 16);
      a0 -= m[0] * x[16];
      a1 -= m[1] * x[17];
      a2 -= m[2] * x[18];
      a3 -= m[3] * x[19];
    }
    { const f32x4 m = *(const f32x4*)(mr + 20);
      a0 -= m[0] * x[20];
      a1 -= m[1] * x[21];
      a2 -= m[2] * x[22];
      a3 -= m[3] * x[23];
    }
    { const f32x4 m = *(const f32x4*)(mr + 24);
      a0 -= m[0] * x[24];
      a1 -= m[1] * x[25];
      a2 -= m[2] * x[26];
      a3 -= m[3] * x[27];
    }
    SOLVE_ROW_END(28)
    SOLVE_ROW_BEGIN(29)
    { const f32x4 m = *(const f32x4*)(mr + 0);
      a0 -= m[0] * x[0];
      a1 -= m[1] * x[1];
      a2 -= m[2] * x[2];
      a3 -= m[3] * x[3];
    }
    { const f32x4 m = *(const f32x4*)(mr + 4);
      a0 -= m[0] * x[4];
      a1 -= m[1] * x[5];
      a2 -= m[2] * x[6];
      a3 -= m[3] * x[7];
    }
    { const f32x4 m = *(const f32x4*)(mr + 8);
      a0 -= m[0] * x[8];
      a1 -= m[1] * x[9];
      a2 -= m[2] * x[10];
      a3 -= m[3] * x[11];
    }
    { const f32x4 m = *(const f32x4*)(mr + 12);
      a0 -= m[0] * x[12];
      a1 -= m[1] * x[13];
      a2 -= m[2] * x[14];
      a3 -= m[3] * x[15];
    }
    { const f32x4 m = *(const f32x4*)(mr + 16);
      a0 -= m[0] * x[16];
      a1 -= m[1] * x[17];
      a2 -= m[2] * x[18];
      a3 -= m[3] * x[19];
    }
    { const f32x4 m = *(const f32x4*)(mr + 20);
      a0 -= m[0] * x[20];
      a1 -= m[1] * x[21];
      a2 -= m[2] * x[22];
      a3 -= m[3] * x[23];
    }
    { const f32x4 m = *(const f32x4*)(mr + 24);
      a0 -= m[0] * x[24];
      a1 -= m[1] * x[25];
      a2 -= m[2] * x[26];
      a3 -= m[3] * x[27];
    }
    { const f32x4 m = *(const f32x4*)(mr + 28);
      a0 -= m[0] * x[28];
    }
    SOLVE_ROW_END(29)
    SOLVE_ROW_BEGIN(30)
    { const f32x4 m = *(const f32x4*)(mr + 0);
      a0 -= m[0] * x[0];
      a1 -= m[1] * x[1];
      a2 -= m[2] * x[2];
      a3 -= m[3] * x[3];
    }
    { const f32x4 m = *(const f32x4*)(mr + 4);
      a0 -= m[0] * x[4];
      a1 -= m[1] * x[5];
      a2 -= m[2] * x[6];
      a3 -= m[3] * x[7];
    }
    { const f32x4 m = *(const f32x4*)(mr + 8);
      a0 -= m[0] * x[8];
      a1 -= m[1] * x[9];
      a2 -= m[2] * x[10];
      a3 -= m[3] * x[11];
    }
    { const f32x4 m = *(const f32x4*)(mr + 12);
      a0 -= m[0] * x[12];
      a1 -= m[1] * x[13];
      a2 -= m[2] * x[14];
      a3 -= m[3] * x[15];
    }
    { const f32x4 m = *(const f32x4*)(mr + 16);
      a0 -= m[0] * x[16];
      a1 -= m[1] * x[17];
      a2 -= m[2] * x[18];
      a3 -= m[3] * x[19];
    }
    { const f32x4 m = *(const f32x4*)(mr + 20);
      a0 -= m[0] * x[20];
      a1 -= m[1] * x[21];
      a2 -= m[2] * x[22];
      a3 -= m[3] * x[23];
    }
    { const f32x4 m = *(const f32x4*)(mr + 24);
      a0 -= m[0] * x[24];
      a1 -= m[1] * x[25];
      a2 -= m[2] * x[26];
      a3 -= m[3] * x[27];
    }
    { const f32x4 m = *(const f32x4*)(mr + 28);
      a0 -= m[0] * x[28];
      a1 -= m[1] * x[29];
    }
    SOLVE_ROW_END(30)
    SOLVE_ROW_BEGIN(31)
    { const f32x4 m = *(const f32x4*)(mr + 0);
      a0 -= m[0] * x[0];
      a1 -= m[1] * x[1];
      a2 -= m[2] * x[2];
      a3 -= m[3] * x[3];
    }
    { const f32x4 m = *(const f32x4*)(mr + 4);
      a0 -= m[0] * x[4];
      a1 -= m[1] * x[5];
      a2 -= m[2] * x[6];
      a3 -= m[3] * x[7];
    }
    { const f32x4 m = *(const f32x4*)(mr + 8);
      a0 -= m[0] * x[8];
      a1 -= m[1] * x[9];
      a2 -= m[2] * x[10];
      a3 -= m[3] * x[11];
    }
    { const f32x4 m = *(const f32x4*)(mr + 12);
      a0 -= m[0] * x[12];
      a1 -= m[1] * x[13];
      a2 -= m[2] * x[14];
      a3 -= m[3] * x[15];
    }
    { const f32x4 m = *(const f32x4*)(mr + 16);
      a0 -= m[0] * x[16];
      a1 -= m[1] * x[17];
      a2 -= m[2] * x[18];
      a3 -= m[3] * x[19];
    }
    { const f32x4 m = *(const f32x4*)(mr + 20);
      a0 -= m[0] * x[20];
      a1 -= m[1] * x[21];
      a2 -= m[2] * x[22];
      a3 -= m[3] * x[23];
    }
    { const f32x4 m = *(const f32x4*)(mr + 24);
      a0 -= m[0] * x[24];
      a1 -= m[1] * x[25];
      a2 -= m[2] * x[26];
      a3 -= m[3] * x[27];
    }
    { const f32x4 m = *(const f32x4*)(mr + 28);
      a0 -= m[0] * x[28];
      a1 -= m[1] * x[29];
      a2 -= m[2] * x[30];
    }
    SOLVE_ROW_END(31)
    SOLVE_ROW_BEGIN(32)
    { const f32x4 m = *(const f32x4*)(mr + 0);
      a0 -= m[0] * x[0];
      a1 -= m[1] * x[1];
      a2 -= m[2] * x[2];
      a3 -= m[3] * x[3];
    }
    { const f32x4 m = *(const f32x4*)(mr + 4);
      a0 -= m[0] * x[4];
      a1 -= m[1] * x[5];
      a2 -= m[2] * x[6];
      a3 -= m[3] * x[7];
    }
    { const f32x4 m = *(const f32x4*)(mr + 8);
      a0 -= m[0] * x[8];
      a1 -= m[1] * x[9];
      a2 -= m[2] * x[10];
      a3 -= m[3] * x[11];
    }
    { const f32x4 m = *(const f32x4*)(mr + 12);
      a0 -= m[0] * x[12];
      a1 -= m[1] * x[13];
      a2 -= m[2] * x[14];
      a3 -= m[3] * x[15];
    }
    { const f32x4 m = *(const f32x4*)(mr + 16);
      a0 -= m[0] * x[16];
      a1 -= m[1] * x[17];
      a2 -= m[2] * x[18];
      a3 -= m[3] * x[19];
    }
    { const f32x4 m = *(const f32x4*)(mr + 20);
      a0 -= m[0] * x[20];
      a1 -= m[1] * x[21];
      a2 -= m[2] * x[22];
      a3 -= m[3] * x[23];
    }
    { const f32x4 m = *(const f32x4*)(mr + 24);
      a0 -= m[0] * x[24];
      a1 -= m[1] * x[25];
      a2 -= m[2] * x[26];
      a3 -= m[3] * x[27];
    }
    { const f32x4 m = *(const f32x4*)(mr + 28);
      a0 -= m[0] * x[28];
      a1 -= m[1] * x[29];
      a2 -= m[2] * x[30];
      a3 -= m[3] * x[31];
    }
    SOLVE_ROW_END(32)
    SOLVE_ROW_BEGIN(33)
    { const f32x4 m = *(const f32x4*)(mr + 0);
      a0 -= m[0] * x[0];
      a1 -= m[1] * x[1];
      a2 -= m[2] * x[2];
      a3 -= m[3] * x[3];
    }
    { const f32x4 m = *(const f32x4*)(mr + 4);
      a0 -= m[0] * x[4];
      a1 -= m[1] * x[5];
      a2 -= m[2] * x[6];
      a3 -= m[3] * x[7];
    }
    { const f32x4 m = *(const f32x4*)(mr + 8);
      a0 -= m[0] * x[8];
      a1 -= m[1] * x[9];
      a2 -= m[2] * x[10];
      a3 -= m[3] * x[11];
    }
    { const f32x4 m = *(const f32x4*)(mr + 12);
      a0 -= m[0] * x[12];
      a1 -= m[1] * x[13];
      a2 -= m[2] * x[14];
      a3 -= m[3] * x[15];
    }
    { const f32x4 m = *(const f32x4*)(mr + 16);
      a0 -= m[0] * x[16];
      a1 -= m[1] * x[17];
      a2 -= m[2] * x[18];
      a3 -= m[3] * x[19];
    }
    { const f32x4 m = *(const f32x4*)(mr + 20);
      a0 -= m[0] * x[20];
      a1 -= m[1] * x[21];
      a2 -= m[2] * x[22];
      a3 -= m[3] * x[23];
    }
    { const f32x4 m = *(const f32x4*)(mr + 24);
      a0 -= m[0] * x[24];
      a1 -= m[1] * x[25];
      a2 -= m[2] * x[26];
      a3 -= m[3] * x[27];
    }
    { const f32x4 m = *(const f32x4*)(mr + 28);
      a0 -= m[0] * x[28];
      a1 -= m[1] * x[29];
      a2 -= m[2] * x[30];
      a3 -= m[3] * x[31];
    }
    { const f32x4 m = *(const f32x4*)(mr + 32);
      a0 -= m[0] * x[32];
    }
    SOLVE_ROW_END(33)
    SOLVE_ROW_BEGIN(34)
    { const f32x4 m = *(const f32x4*)(mr + 0);
      a0 -= m[0] * x[0];
      a1 -= m[1] * x[1];
      a2 -= m[2] * x[2];
      a3 -= m[3] * x[3];
    }
    { const f32x4 m = *(const f32x4*)(mr + 4);
      a0 -= m[0] * x[4];
      a1 -= m[1] * x[5];
      a2 -= m[2] * x[6];
      a3 -= m[3] * x[7];
    }
    { const f32x4 m = *(const f32x4*)(mr + 8);
      a0 -= m[0] * x[8];
      a1 -= m[1] * x[9];
      a2 -= m[2] * x[10];
      a3 -= m[3] * x[11];
    }
    { const f32x4 m = *(const f32x4*)(mr + 12);
      a0 -= m[0] * x[12];
      a1 -= m[1] * x[13];
      a2 -= m[2] * x[14];
      a3 -= m[3] * x[15];
    }
    { const f32x4 m = *(const f32x4*)(mr + 16);
      a0 -= m[0] * x[16];
      a1 -= m[1] * x[17];
      a2 -= m[2] * x[18];
      a3 -= m[3] * x[19];
    }
    { const f32x4 m = *(const f32x4*)(mr + 20);
      a0 -= m[0] * x[20];
      a1 -= m[1] * x[21];
      a2 -= m[2] * x[22];
      a3 -= m[3] * x[23];
    }
    { const f32x4 m = *(const f32x4*)(mr + 24);
      a0 -= m[0] * x[24];
      a1 -= m[1] * x[25];
      a2 -= m[2] * x[26];
      a3 -= m[3] * x[27];
    }
    { const f32x4 m = *(const f32x4*)(mr + 28);
      a0 -= m[0] * x[28];
      a1 -= m[1] * x[29];
      a2 -= m[2] * x[30];
      a3 -= m[3] * x[31];
    }
    { const f32x4 m = *(const f32x4*)(mr + 32);
      a0 -= m[0] * x[32];
      a1 -= m[1] * x[33];
    }
    SOLVE_ROW_END(34)
    SOLVE_ROW_BEGIN(35)
    { const f32x4 m = *(const f32x4*)(mr + 0);
      a0 -= m[0] * x[0];
      a1 -= m[1] * x[1];
      a2 -= m[2] * x[2];
      a3 -= m[3] * x[3];
    }
    { const f32x4 m = *(const f32x4*)(mr + 4);
      a0 -= m[0] * x[4];
      a1 -= m[1] * x[5];
      a2 -= m[2] * x[6];
      a3 -= m[3] * x[7];
    }
    { const f32x4 m = *(const f32x4*)(mr + 8);
      a0 -= m[0] * x[8];
      a1 -= m[1] * x[9];
      a2 -= m[2] * x[10];
      a3 -= m[3] * x[11];
    }
    { const f32x4 m = *(const f32x4*)(mr + 12);
      a0 -= m[0] * x[12];
      a1 -= m[1] * x[13];
      a2 -= m[2] * x[14];
      a3 -= m[3] * x[15];
    }
    { const f32x4 m = *(const f32x4*)(mr + 16);
      a0 -= m[0] * x[16];
      a1 -= m[1] * x[17];
      a2 -= m[2] * x[18];
      a3 -= m[3] * x[19];
    }
    { const f32x4 m = *(const f32x4*)(mr + 20);
      a0 -= m[0] * x[20];
      a1 -= m[1] * x[21];
      a2 -= m[2] * x[22];
      a3 -= m[3] * x[23];
    }
    { const f32x4 m = *(const f32x4*)(mr + 24);
      a0 -= m[0] * x[24];
      a1 -= m[1] * x[25];
      a2 -= m[2] * x[26];
      a3 -= m[3] * x[27];
    }
    { const f32x4 m = *(const f32x4*)(mr + 28);
      a0 -= m[0] * x[28];
      a1 -= m[1] * x[29];
      a2 -= m[2] * x[30];
      a3 -= m[3] * x[31];
    }
    { const f32x4 m = *(const f32x4*)(mr + 32);
      a0 -= m[0] * x[32];
      a1 -= m[1] * x[33];
      a2 -= m[2] * x[34];
    }
    SOLVE_ROW_END(35)
    SOLVE_ROW_BEGIN(36)
    { const f32x4 m = *(const f32x4*)(mr + 0);
      a0 -= m[0] * x[0];
      a1 -= m[1] * x[1];
      a2 -= m[2] * x[2];
      a3 -= m[3] * x[3];
    }
    { const f32x4 m = *(const f32x4*)(mr + 4);
      a0 -= m[0] * x[4];
      a1 -= m[1] * x[5];
      a2 -= m[2] * x[6];
      a3 -= m[3] * x[7];
    }
    { const f32x4 m = *(const f32x4*)(mr + 8);
      a0 -= m[0] * x[8];
      a1 -= m[1] * x[9];
      a2 -= m[2] * x[10];
      a3 -= m[3] * x[11];
    }
    { const f32x4 m = *(const f32x4*)(mr + 12);
      a0 -= m[0] * x[12];
      a1 -= m[1] * x[13];
      a2 -= m[2] * x[14];
      a3 -= m[3] * x[15];
    }
    { const f32x4 m = *(const f32x4*)(mr + 16);
      a0 -= m[0] * x[16];
      a1 -= m[1] * x[17];
      a2 -= m[2] * x[18];
      a3 -= m[3] * x[19];
    }
    { const f32x4 m = *(const f32x4*)(mr + 20);
      a0 -= m[0] * x[20];
      a1 -= m[1] * x[21];
      a2 -= m[2] * x[22];
      a3 -= m[3] * x[23];
    }
    { const f32x4 m = *(const f32x4*)(mr + 24);
      a0 -= m[0] * x[24];
      a1 -= m[1] * x[25];
      a2 -= m[2] * x[26];
      a3 -= m[3] * x[27];
    }
    { const f32x4 m = *(const f32x4*)(mr + 28);
      a0 -= m[0] * x[28];
      a1 -= m[1] * x[29];
      a2 -= m[2] * x[30];
      a3 -= m[3] * x[31];
    }
    { const f32x4 m = *(const f32x4*)(mr + 32);
      a0 -= m[0] * x[32];
      a1 -= m[1] * x[33];
      a2 -= m[2] * x[34];
      a3 -= m[3] * x[35];
    }
    SOLVE_ROW_END(36)
    SOLVE_ROW_BEGIN(37)
    { const f32x4 m = *(const f32x4*)(mr + 0);
      a0 -= m[0] * x[0];
      a1 -= m[1] * x[1];
      a2 -= m[2] * x[2];
      a3 -= m[3] * x[3];
    }
    { const f32x4 m = *(const f32x4*)(mr + 4);
      a0 -= m[0] * x[4];
      a1 -= m[1] * x[5];
      a2 -= m[2] * x[6];
      a3 -= m[3] * x[7];
    }
    { const f32x4 m = *(const f32x4*)(mr + 8);
      a0 -= m[0] * x[8];
      a1 -= m[1] * x[9];
      a2 -= m[2] * x[10];
      a3 -= m[3] * x[11];
    }
    { const f32x4 m = *(const f32x4*)(mr + 12);
      a0 -= m[0] * x[12];
      a1 -= m[1] * x[13];
      a2 -= m[2] * x[14];
      a3 -= m[3] * x[15];
    }
    { const f32x4 m = *(const f32x4*)(mr + 16);
      a0 -= m[0] * x[16];
      a1 -= m[1] * x[17];
      a2 -= m[2] * x[18];
      a3 -= m[3] * x[19];
    }
    { const f32x4 m = *(const f32x4*)(mr + 20);
      a0 -= m[0] * x[20];
      a1 -= m[1] * x[21];
      a2 -= m[2] * x[22];
      a3 -= m[3] * x[23];
    }
    { const f32x4 m = *(const f32x4*)(mr + 24);
      a0 -= m[0] * x[24];
      a1 -= m[1] * x[25];
      a2 -= m[2] * x[26];
      a3 -= m[3] * x[27];
    }
    { const f32x4 m = *(const f32x4*)(mr + 28);
      a0 -= m[0] * x[28];
      a1 -= m[1] * x[29];
      a2 -= m[2] * x[30];
      a3 -= m[3] * x[31];
    }
    { const f32x4 m = *(const f32x4*)(mr + 32);
      a0 -= m[0] * x[32];
      a1 -= m[1] * x[33];
      a2 -= m[2] * x[34];
      a3 -= m[3] * x[35];
    }
    { const f32x4 m = *(const f32x4*)(mr + 36);
      a0 -= m[0] * x[36];
    }
    SOLVE_ROW_END(37)
    SOLVE_ROW_BEGIN(38)
    { const f32x4 m = *(const f32x4*)(mr + 0);
      a0 -= m[0] * x[0];
      a1 -= m[1] * x[1];
      a2 -= m[2] * x[2];
      a3 -= m[3] * x[3];
    }
    { const f32x4 m = *(const f32x4*)(mr + 4);
      a0 -= m[0] * x[4];
      a1 -= m[1] * x[5];
      a2 -= m[2] * x[6];
      a3 -= m[3] * x[7];
    }
    { const f32x4 m = *(const f32x4*)(mr + 8);
      a0 -= m[0] * x[8];
      a1 -= m[1] * x[9];
      a2 -= m[2] * x[10];
      a3 -= m[3] * x[11];
    }
    { const f32x4 m = *(const f32x4*)(mr + 12);
      a0 -= m[0] * x[12];
      a1 -= m[1] * x[13];
      a2 -= m[2] * x[14];
      a3 -= m[3] * x[15];
    }
    { const f32x4 m = *(const f32x4*)(mr + 16);
      a0 -= m[0] * x[16];
      a1 -= m[1] * x[17];
      a2 -= m[2] * x[18];
      a3 -= m[3] * x[19];
    }
    { const f32x4 m = *(const f32x4*)(mr + 20);
      a0 -= m[0] * x[20];
      a1 -= m[1] * x[21];
      a2 -= m[2] * x[22];
      a3 -= m[3] * x[23];
    }
    { const f32x4 m = *(const f32x4*)(mr + 24);
      a0 -= m[0] * x[24];
      a1 -= m[1] * x[25];
      a2 -= m[2] * x[26];
      a3 -= m[3] * x[27];
    }
    { const f32x4 m = *(const f32x4*)(mr + 28);
      a0 -= m[0] * x[28];
      a1 -= m[1] * x[29];
      a2 -= m[2] * x[30];
      a3 -= m[3] * x[31];
    }
    { const f32x4 m = *(const f32x4*)(mr + 32);
      a0 -= m[0] * x[32];
      a1 -= m[1] * x[33];
      a2 -= m[2] * x[34];
      a3 -= m[3] * x[35];
    }
    { const f32x4 m = *(const f32x4*)(mr + 36);
      a0 -= m[0] * x[36];
      a1 -= m[1] * x[37];
    }
    SOLVE_ROW_END(38)
    SOLVE_ROW_BEGIN(39)
    { const f32x4 m = *(const f32x4*)(mr + 0);
      a0 -= m[0] * x[0];
      a1 -= m[1] * x[1];
      a2 -= m[2] * x[2];
      a3 -= m[3] * x[3];
    }
    { const f32x4 m = *(const f32x4*)(mr + 4);
      a0 -= m[0] * x[4];
      a1 -= m[1] * x[5];
      a2 -= m[2] * x[6];
      a3 -= m[3] * x[7];
    }
    { const f32x4 m = *(const f32x4*)(mr + 8);
      a0 -= m[0] * x[8];
      a1 -= m[1] * x[9];
      a2 -= m[2] * x[10];
      a3 -= m[3] * x[11];
    }
    { const f32x4 m = *(const f32x4*)(mr + 12);
      a0 -= m[0] * x[12];
      a1 -= m[1] * x[13];
      a2 -= m[2] * x[14];
      a3 -= m[3] * x[15];
    }
    { const f32x4 m = *(const f32x4*)(mr + 16);
      a0 -= m[0] * x[16];
      a1 -= m[1] * x[17];
      a2 -= m[2] * x[18];
      a3 -= m[3] * x[19];
    }
    { const f32x4 m = *(const f32x4*)(mr + 20);
      a0 -= m[0] * x[20];
      a1 -= m[1] * x[21];
      a2 -= m[2] * x[22];
      a3 -= m[3] * x[23];
    }
    { const f32x4 m = *(const f32x4*)(mr + 24);
      a0 -= m[0] * x[24];
      a1 -= m[1] * x[25];
      a2 -= m[2] * x[26];
      a3 -= m[3] * x[27];
    }
    { const f32x4 m = *(const f32x4*)(mr + 28);
      a0 -= m[0] * x[28];
      a1 -= m[1] * x[29];
      a2 -= m[2] * x[30];
      a3 -= m[3] * x[31];
    }
    { const f32x4 m = *(const f32x4*)(mr + 32);
      a0 -= m[0] * x[32];
      a1 -= m[1] * x[33];
      a2 -= m[2] * x[34];
      a3 -= m[3] * x[35];
    }
    { const f32x4 m = *(const f32x4*)(mr + 36);
      a0 -= m[0] * x[36];
      a1 -= m[1] * x[37];
      a2 -= m[2] * x[38];
    }
    SOLVE_ROW_END(39)
    SOLVE_ROW_BEGIN(40)
    { const f32x4 m = *(const f32x4*)(mr + 0);
      a0 -= m[0] * x[0];
      a1 -= m[1] * x[1];
      a2 -= m[2] * x[2];
      a3 -= m[3] * x[3];
    }
    { const f32x4 m = *(const f32x4*)(mr + 4);
      a0 -= m[0] * x[4];
      a1 -= m[1] * x[5];
      a2 -= m[2] * x[6];
      a3 -= m[3] * x[7];
    }
    { const f32x4 m = *(const f32x4*)(mr + 8);
      a0 -= m[0] * x[8];
      a1 -= m[1] * x[9];
      a2 -= m[2] * x[10];
      a3 -= m[3] * x[11];
    }
    { const f32x4 m = *(const f32x4*)(mr + 12);
      a0 -= m[0] * x[12];
      a1 -= m[1] * x[13];
      a2 -= m[2] * x[14];
      a3 -= m[3] * x[15];
    }
    { const f32x4 m = *(const f32x4*)(mr + 16);
      a0 -= m[0] * x[16];
      a1 -= m[1] * x[17];
      a2 -= m[2] * x[18];
      a3 -= m[3] * x[19];
    }
    { const f32x4 m = *(const f32x4*)(mr + 20);
      a0 -= m[0] * x[20];
      a1 -= m[1] * x[21];
      a2 -= m[2] * x[22];
      a3 -= m[3] * x[23];
    }
    { const f32x4 m = *(const f32x4*)(mr + 24);
      a0 -= m[0] * x[24];
      a1 -= m[1] * x[25];
      a2 -= m[2] * x[26];
      a3 -= m[3] * x[27];
    }
    { const f32x4 m = *(const f32x4*)(mr + 28);
      a0 -= m[0] * x[28];
      a1 -= m[1] * x[29];
      a2 -= m[2] * x[30];
      a3 -= m[3] * x[31];
    }
    { const f32x4 m = *(const f32x4*)(mr + 32);
      a0 -= m[0] * x[32];
      a1 -= m[1] * x[33];
      a2 -= m[2] * x[34];
      a3 -= m[3] * x[35];
    }
    { const f32x4 m = *(const f32x4*)(mr + 36);
      a0 -= m[0] * x[36];
      a1 -= m[1] * x[37];
      a2 -= m[2] * x[38];
      a3 -= m[3] * x[39];
    }
    SOLVE_ROW_END(40)
    SOLVE_ROW_BEGIN(41)
    { const f32x4 m = *(const f32x4*)(mr + 0);
      a0 -= m[0] * x[0];
      a1 -= m[1] * x[1];
      a2 -= m[2] * x[2];
      a3 -= m[3] * x[3];
    }
    { const f32x4 m = *(const f32x4*)(mr + 4);
      a0 -= m[0] * x[4];
      a1 -= m[1] * x[5];
      a2 -= m[2] * x[6];
      a3 -= m[3] * x[7];
    }
    { const f32x4 m = *(const f32x4*)(mr + 8);
      a0 -= m[0] * x[8];
      a1 -= m[1] * x[9];
      a2 -= m[2] * x[10];
      a3 -= m[3] * x[11];
    }
    { const f32x4 m = *(const f32x4*)(mr + 12);
      a0 -= m[0] * x[12];
      a1 -= m[1] * x[13];
      a2 -= m[2] * x[14];
      a3 -= m[3] * x[15];
    }
    { const f32x4 m = *(const f32x4*)(mr + 16);
      a0 -= m[0] * x[16];
      a1 -= m[1] * x[17];
      a2 -= m[2] * x[18];
      a3 -= m[3] * x[19];
    }
    { const f32x4 m = *(const f32x4*)(mr + 20);
      a0 -= m[0] * x[20];
      a1 -= m[1] * x[21];
      a2 -= m[2] * x[22];
      a3 -= m[3] * x[23];
    }
    { const f32x4 m = *(const f32x4*)(mr + 24);
      a0 -= m[0] * x[24];
      a1 -= m[1] * x[25];
      a2 -= m[2] * x[26];
      a3 -= m[3] * x[27];
    }
    { const f32x4 m = *(const f32x4*)(mr + 28);
      a0 -= m[0] * x[28];
      a1 -= m[1] * x[29];
      a2 -= m[2] * x[30];
      a3 -= m[3] * x[31];
    }
    { const f32x4 m = *(const f32x4*)(mr + 32);
      a0 -= m[0] * x[32];
      a1 -= m[1] * x[33];
      a2 -= m[2] * x[34];
      a3 -= m[3] * x[35];
    }
    { const f32x4 m = *(const f32x4*)(mr + 36);
      a0 -= m[0] * x[36];
      a1 -= m[1] * x[37];
      a2 -= m[2] * x[38];
      a3 -= m[3] * x[39];
    }
    { const f32x4 m = *(const f32x4*)(mr + 40);
      a0 -= m[0] * x[40];
    }
    SOLVE_ROW_END(41)
    SOLVE_ROW_BEGIN(42)
    { const f32x4 m = *(const f32x4*)(mr + 0);
      a0 -= m[0] * x[0];
      a1 -= m[1] * x[1];
      a2 -= m[2] * x[2];
      a3 -= m[3] * x[3];
    }
    { const f32x4 m = *(const f32x4*)(mr + 4);
      a0 -= m[0] * x[4];
      a1 -= m[1] * x[5];
      a2 -= m[2] * x[6];
      a3 -= m[3] * x[7];
    }
    { const f32x4 m = *(const f32x4*)(mr + 8);
      a0 -= m[0] * x[8];
      a1 -= m[1] * x[9];
      a2 -= m[2] * x[10];
      a3 -= m[3] * x[11];
    }
    { const f32x4 m = *(const f32x4*)(mr + 12);
      a0 -= m[0] * x[12];
      a1 -= m[1] * x[13];
      a2 -= m[2] * x[14];
      a3 -= m[3] * x[15];
    }
    { const f32x4 m = *(const f32x4*)(mr + 16);
      a0 -= m[0] * x[16];
      a1 -= m[1] * x[17];
      a2 -= m[2] * x[18];
      a3 -= m[3] * x[19];
    }
    { const f32x4 m = *(const f32x4*)(mr + 20);
      a0 -= m[0] * x[20];
      a1 -= m[1] * x[21];
      a2 -= m[2] * x[22];
      a3 -= m[3] * x[23];
    }
    { const f32x4 m = *(const f32x4*)(mr + 24);
      a0 -= m[0] * x[24];
      a1 -= m[1] * x[25];
      a2 -= m[2] * x[26];
      a3 -= m[3] * x[27];
    }
    { const f32x4 m = *(const f32x4*)(mr + 28);
      a0 -= m[0] * x[28];
      a1 -= m[1] * x[29];
      a2 -= m[2] * x[30];
      a3 -= m[3] * x[31];
    }
    { const f32x4 m = *(const f32x4*)(mr + 32);
      a0 -= m[0] * x[32];
      a1 -= m[1] * x[33];
      a2 -= m[2] * x[34];
      a3 -= m[3] * x[35];
    }
    { const f32x4 m = *(const f32x4*)(mr + 36);
      a0 -= m[0] * x[36];
      a1 -= m[1] * x[37];
      a2 -= m[2] * x[38];
      a3 -= m[3] * x[39];
    }
    { const f32x4 m = *(const f32x4*)(mr + 40);
      a0 -= m[0] * x[40];
      a1 -= m[1] * x[41];
    }
    SOLVE_ROW_END(42)
    SOLVE_ROW_BEGIN(43)
    { const f32x4 m = *(const f32x4*)(mr + 0);
      a0 -= m[0] * x[0];
      a1 -= m[1] * x[1];
      a2 -= m[2] * x[2];
      a3 -= m[3] * x[3];
    }
    { const f32x4 m = *(const f32x4*)(mr + 4);
      a0 -= m[0] * x[4];
      a1 -= m[1] * x[5];
      a2 -= m[2] * x[6];
      a3 -= m[3] * x[7];
    }
    { const f32x4 m = *(const f32x4*)(mr + 8);
      a0 -= m[0] * x[8];
      a1 -= m[1] * x[9];
      a2 -= m[2] * x[10];
      a3 -= m[3] * x[11];
    }
    { const f32x4 m = *(const f32x4*)(mr + 12);
      a0 -= m[0] * x[12];
      a1 -= m[1] * x[13];
      a2 -= m[2] * x[14];
      a3 -= m[3] * x[15];
    }
    { const f32x4 m = *(const f32x4*)(mr + 16);
      a0 -= m[0] * x[16];
      a1 -= m[1] * x[17];
      a2 -= m[2] * x[18];
      a3 -= m[3] * x[19];
    }
    { const f32x4 m = *(const f32x4*)(mr + 20);
      a0 -= m[0] * x[20];
      a1 -= m[1] * x[21];
      a2 -= m[2] * x[22];
      a3 -= m[3] * x[23];
    }
    { const f32x4 m = *(const f32x4*)(mr + 24);
      a0 -= m[0] * x[24];
      a1 -= m[1] * x[25];
      a2 -= m[2] * x[26];
      a3 -= m[3] * x[27];
    }
    { const f32x4 m = *(const f32x4*)(mr + 28);
      a0 -= m[0] * x[28];
      a1 -= m[1] * x[29];
      a2 -= m[2] * x[30];
      a3 -= m[3] * x[31];
    }
    { const f32x4 m = *(const f32x4*)(mr + 32);
      a0 -= m[0] * x[32];
      a1 -= m[1] * x[33];
      a2 -= m[2] * x[34];
      a3 -= m[3] * x[35];
    }
    { const f32x4 m = *(const f32x4*)(mr + 36);
      a0 -= m[0] * x[36];
      a1 -= m[1] * x[37];
      a2 -= m[2] * x[38];
      a3 -= m[3] * x[39];
    }
    { const f32x4 m = *(const f32x4*)(mr + 40);
      a0 -= m[0] * x[40];
      a1 -= m[1] * x[41];
      a2 -= m[2] * x[42];
    }
    SOLVE_ROW_END(43)
    SOLVE_ROW_BEGIN(44)
    { const f32x4 m = *(const f32x4*)(mr + 0);
      a0 -= m[0] * x[0];
      a1 -= m[1] * x[1];
      a2 -= m[2] * x[2];
      a3 -= m[3] * x[3];
    }
    { const f32x4 m = *(const f32x4*)(mr + 4);
      a0 -= m[0] * x[4];
      a1 -= m[1] * x[5];
      a2 -= m[2] * x[6];
      a3 -= m[3] * x[7];
    }
    { const f32x4 m = *(const f32x4*)(mr + 8);
      a0 -= m[0] * x[8];
      a1 -= m[1] * x[9];
      a2 -= m[2] * x[10];
      a3 -= m[3] * x[11];
    }
    { const f32x4 m = *(const f32x4*)(mr + 12);
      a0 -= m[0] * x[12];
      a1 -= m[1] * x[13];
      a2 -= m[2] * x[14];
      a3 -= m[3] * x[15];
    }
    { const f32x4 m = *(const f32x4*)(mr + 16);
      a0 -= m[0] * x[16];
      a1 -= m[1] * x[17];
      a2 -= m[2] * x[18];
      a3 -= m[3] * x[19];
    }
    { const f32x4 m = *(const f32x4*)(mr + 20);
      a0 -= m[0] * x[20];
      a1 -= m[1] * x[21];
      a2 -= m[2] * x[22];
      a3 -= m[3] * x[23];
    }
    { const f32x4 m = *(const f32x4*)(mr + 24);
      a0 -= m[0] * x[24];
      a1 -= m[1] * x[25];
      a2 -= m[2] * x[26];
      a3 -= m[3] * x[27];
    }
    { const f32x4 m = *(const f32x4*)(mr + 28);
      a0 -= m[0] * x[28];
      a1 -= m[1] * x[29];
      a2 -= m[2] * x[30];
      a3 -= m[3] * x[31];
    }
    { const f32x4 m = *(const f32x4*)(mr + 32);
      a0 -= m[0] * x[32];
      a1 -= m[1] * x[33];
      a2 -= m[2] * x[34];
      a3 -= m[3] * x[35];
    }
    { const f32x4 m = *(const f32x4*)(mr + 36);
      a0 -= m[0] * x[36];
      a1 -= m[1] * x[37];
      a2 -= m[2] * x[38];
      a3 -= m[3] * x[39];
    }
    { const f32x4 m = *(const f32x4*)(mr + 40);
      a0 -= m[0] * x[40];
      a1 -= m[1] * x[41];
      a2 -= m[2] * x[42];
      a3 -= m[3] * x[43];
    }
    SOLVE_ROW_END(44)
    SOLVE_ROW_BEGIN(45)
    { const f32x4 m = *(const f32x4*)(mr + 0);
      a0 -= m[0] * x[0];
      a1 -= m[1] * x[1];
      a2 -= m[2] * x[2];
      a3 -= m[3] * x[3];
    }
    { const f32x4 m = *(const f32x4*)(mr + 4);
      a0 -= m[0] * x[4];
      a1 -= m[1] * x[5];
      a2 -= m[2] * x[6];
      a3 -= m[3] * x[7];
    }
    { const f32x4 m = *(const f32x4*)(mr + 8);
      a0 -= m[0] * x[8];
      a1 -= m[1] * x[9];
      a2 -= m[2] * x[10];
      a3 -= m[3] * x[11];
    }
    { const f32x4 m = *(const f32x4*)(mr + 12);
      a0 -= m[0] * x[12];
      a1 -= m[1] * x[13];
      a2 -= m[2] * x[14];
      a3 -= m[3] * x[15];
    }
    { const f32x4 m = *(const f32x4*)(mr + 16);
      a0 -= m[0] * x[16];
      a1 -= m[1] * x[17];
      a2 -= m[2] * x[18];
      a3 -= m[3] * x[19];
    }
    { const f32x4 m = *(const f32x4*)(mr + 20);
      a0 -= m[0] * x[20];
      a1 -= m[1] * x[21];
      a2 -= m[2] * x[22];
      a3 -= m[3] * x[23];
    }
    { const f32x4 m = *(const f32x4*)(mr + 24);
      a0 -= m[0] * x[24];
      a1 -= m[1] * x[25];
      a2 -= m[2] * x[26];
      a3 -= m[3] * x[27];
    }
    { const f32x4 m = *(const f32x4*)(mr + 28);
      a0 -= m[0] * x[28];
      a1 -= m[1] * x[29];
      a2 -= m[2] * x[30];
      a3 -= m[3] * x[31];
    }
    { const f32x4 m = *(const f32x4*)(mr + 32);
      a0 -= m[0] * x[32];
      a1 -= m[1] * x[33];
      a2 -= m[2] * x[34];
      a3 -= m[3] * x[35];
    }
    { const f32x4 m = *(const f32x4*)(mr + 36);
      a0 -= m[0] * x[36];
      a1 -= m[1] * x[37];
      a2 -= m[2] * x[38];
      a3 -= m[3] * x[39];
    }
    { const f32x4 m = *(const f32x4*)(mr + 40);
      a0 -= m[0] * x[40];
      a1 -= m[1] * x[41];
      a2 -= m[2] * x[42];
      a3 -= m[3] * x[43];
    }
    { const f32x4 m = *(const f32x4*)(mr + 44);
      a0 -= m[0] * x[44];
    }
    SOLVE_ROW_END(45)
    SOLVE_ROW_BEGIN(46)
    { const f32x4 m = *(const f32x4*)(mr + 0);
      a0 -= m[0] * x[0];
      a1 -= m[1] * x[1];
      a2 -= m[2] * x[2];
      a3 -= m[3] * x[3];
    }
    { const f32x4 m = *(const f32x4*)(mr + 4);
      a0 -= m[0] * x[4];
      a1 -= m[1] * x[5];
      a2 -= m[2] * x[6];
      a3 -= m[3] * x[7];
    }
    { const f32x4 m = *(const f32x4*)(mr + 8);
      a0 -= m[0] * x[8];
      a1 -= m[1] * x[9];
      a2 -= m[2] * x[10];
      a3 -= m[3] * x[11];
    }
    { const f32x4 m = *(const f32x4*)(mr + 12);
      a0 -= m[0] * x[12];
      a1 -= m[1] * x[13];
      a2 -= m[2] * x[14];
      a3 -= m[3] * x[15];
    }
    { const f32x4 m = *(const f32x4*)(mr + 16);
      a0 -= m[0] * x[16];
      a1 -= m[1] * x[17];
      a2 -= m[2] * x[18];
      a3 -= m[3] * x[19];
    }
    { const f32x4 m = *(const f32x4*)(mr + 20);
      a0 -= m[0] * x[20];
      a1 -= m[1] * x[21];
      a2 -= m[2] * x[22];
      a3 -= m[3] * x[23];
    }
    { const f32x4 m = *(const f32x4*)(mr + 24);
      a0 -= m[0] * x[24];
      a1 -= m[1] * x[25];
      a2 -= m[2] * x[26];
      a3 -= m[3] * x[27];
    }
    { const f32x4 m = *(const f32x4*)(mr + 28);
      a0 -= m[0] * x[28];
      a1 -= m[1] * x[29];
      a2 -= m[2] * x[30];
      a3 -= m[3] * x[31];
    }
    { const f32x4 m = *(const f32x4*)(mr + 32);
      a0 -= m[0] * x[32];
      a1 -= m[1] * x[33];
      a2 -= m[2] * x[34];
      a3 -= m[3] * x[35];
    }
    { const f32x4 m = *(const f32x4*)(mr + 36);
      a0 -= m[0] * x[36];
      a1 -= m[1] * x[37];
      a2 -= m[2] * x[38];
      a3 -= m[3] * x[39];
    }
    { const f32x4 m = *(const f32x4*)(mr + 40);
      a0 -= m[0] * x[40];
      a1 -= m[1] * x[41];
      a2 -= m[2] * x[42];
      a3 -= m[3] * x[43];
    }
    { const f32x4 m = *(const f32x4*)(mr + 44);
      a0 -= m[0] * x[44];
      a1 -= m[1] * x[45];
    }
    SOLVE_ROW_END(46)
    SOLVE_ROW_BEGIN(47)
    { const f32x4 m = *(const f32x4*)(mr + 0);
      a0 -= m[0] * x[0];
      a1 -= m[1] * x[1];
      a2 -= m[2] * x[2];
      a3 -= m[3] * x[3];
    }
    { const f32x4 m = *(const f32x4*)(mr + 4);
      a0 -= m[0] * x[4];
      a1 -= m[1] * x[5];
      a2 -= m[2] * x[6];
      a3 -= m[3] * x[7];
    }
    { const f32x4 m = *(const f32x4*)(mr + 8);
      a0 -= m[0] * x[8];
      a1 -= m[1] * x[9];
      a2 -= m[2] * x[10];
      a3 -= m[3] * x[11];
    }
    { const f32x4 m = *(const f32x4*)(mr + 12);
      a0 -= m[0] * x[12];
      a1 -= m[1] * x[13];
      a2 -= m[2] * x[14];
      a3 -= m[3] * x[15];
    }
    { const f32x4 m = *(const f32x4*)(mr + 16);
      a0 -= m[0] * x[16];
      a1 -= m[1] * x[17];
      a2 -= m[2] * x[18];
      a3 -= m[3] * x[19];
    }
    { const f32x4 m = *(const f32x4*)(mr + 20);
      a0 -= m[0] * x[20];
      a1 -= m[1] * x[21];
      a2 -= m[2] * x[22];
      a3 -= m[3] * x[23];
    }
    { const f32x4 m = *(const f32x4*)(mr + 24);
      a0 -= m[0] * x[24];
      a1 -= m[1] * x[25];
      a2 -= m[2] * x[26];
      a3 -= m[3] * x[27];
    }
    { const f32x4 m = *(const f32x4*)(mr + 28);
      a0 -= m[0] * x[28];
      a1 -= m[1] * x[29];
      a2 -= m[2] * x[30];
      a3 -= m[3] * x[31];
    }
    { const f32x4 m = *(const f32x4*)(mr + 32);
      a0 -= m[0] * x[32];
      a1 -= m[1] * x[33];
      a2 -= m[2] * x[34];
      a3 -= m[3] * x[35];
    }
    { const f32x4 m = *(const f32x4*)(mr + 36);
      a0 -= m[0] * x[36];
      a1 -= m[1] * x[37];
      a2 -= m[2] * x[38];
      a3 -= m[3] * x[39];
    }
    { const f32x4 m = *(const f32x4*)(mr + 40);
      a0 -= m[0] * x[40];
      a1 -= m[1] * x[41];
      a2 -= m[2] * x[42];
      a3 -= m[3] * x[43];
    }
    { const f32x4 m = *(const f32x4*)(mr + 44);
      a0 -= m[0] * x[44];
      a1 -= m[1] * x[45];
      a2 -= m[2] * x[46];
    }
    SOLVE_ROW_END(47)
    SOLVE_ROW_BEGIN(48)
    { const f32x4 m = *(const f32x4*)(mr + 0);
      a0 -= m[0] * x[0];
      a1 -= m[1] * x[1];
      a2 -= m[2] * x[2];
      a3 -= m[3] * x[3];
    }
    { const f32x4 m = *(const f32x4*)(mr + 4);
      a0 -= m[0] * x[4];
      a1 -= m[1] * x[5];
      a2 -= m[2] * x[6];
      a3 -= m[3] * x[7];
    }
    { const f32x4 m = *(const f32x4*)(mr + 8);
      a0 -= m[0] * x[8];
      a1 -= m[1] * x[9];
      a2 -= m[2] * x[10];
      a3 -= m[3] * x[11];
    }
    { const f32x4 m = *(const f32x4*)(mr + 12);
      a0 -= m[0] * x[12];
      a1 -= m[1] * x[13];
      a2 -= m[2] * x[14];
      a3 -= m[3] * x[15];
    }
    { const f32x4 m = *(const f32x4*)(mr + 16);
      a0 -= m[0] * x[16];
      a1 -= m[1] * x[17];
      a2 -= m[2] * x[18];
      a3 -= m[3] * x[19];
    }
    { const f32x4 m = *(const f32x4*)(mr + 20);
      a0 -= m[0] * x[20];
      a1 -= m[1] * x[21];
      a2 -= m[2] * x[22];
      a3 -= m[3] * x[23];
    }
    { const f32x4 m = *(const f32x4*)(mr + 24);
      a0 -= m[0] * x[24];
      a1 -= m[1] * x[25];
      a2 -= m[2] * x[26];
      a3 -= m[3] * x[27];
    }
    { const f32x4 m = *(const f32x4*)(mr + 28);
      a0 -= m[0] * x[28];
      a1 -= m[1] * x[29];
      a2 -= m[2] * x[30];
      a3 -= m[3] * x[31];
    }
    { const f32x4 m = *(const f32x4*)(mr + 32);
      a0 -= m[0] * x[32];
      a1 -= m[1] * x[33];
      a2 -= m[2] * x[34];
      a3 -= m[3] * x[35];
    }
    { const f32x4 m = *(const f32x4*)(mr + 36);
      a0 -= m[0] * x[36];
      a1 -= m[1] * x[37];
      a2 -= m[2] * x[38];
      a3 -= m[3] * x[39];
    }
    { const f32x4 m = *(const f32x4*)(mr + 40);
      a0 -= m[0] * x[40];
      a1 -= m[1] * x[41];
      a2 -= m[2] * x[42];
      a3 -= m[3] * x[43];
    }
    { const f32x4 m = *(const f32x4*)(mr + 44);
      a0 -= m[0] * x[44];
      a1 -= m[1] * x[45];
      a2 -= m[2] * x[46];
      a3 -= m[3] * x[47];
    }
    SOLVE_ROW_END(48)
    SOLVE_ROW_BEGIN(49)
    { const f32x4 m = *(const f32x4*)(mr + 0);
      a0 -= m[0] * x[0];
      a1 -= m[1] * x[1];
      a2 -= m[2] * x[2];
      a3 -= m[3] * x[3];
    }
    { const f32x4 m = *(const f32x4*)(mr + 4);
      a0 -= m[0] * x[4];
      a1 -= m[1] * x[5];
      a2 -= m[2] * x[6];
      a3 -= m[3] * x[7];
    }
    { const f32x4 m = *(const f32x4*)(mr + 8);
      a0 -= m[0] * x[8];
      a1 -= m[1] * x[9];
      a2 -= m[2] * x[10];
      a3 -= m[3] * x[11];
    }
    { const f32x4 m = *(const f32x4*)(mr + 12);
      a0 -= m[0] * x[12];
      a1 -= m[1] * x[13];
      a2 -= m[2] * x[14];
      a3 -= m[3] * x[15];
    }
    { const f32x4 m = *(const f32x4*)(mr + 16);
      a0 -= m[0] * x[16];
      a1 -= m[1] * x[17];
      a2 -= m[2] * x[18];
      a3 -= m[3] * x[19];
    }
    { const f32x4 m = *(const f32x4*)(mr + 20);
      a0 -= m[0] * x[20];
      a1 -= m[1] * x[21];
      a2 -= m[2] * x[22];
      a3 -= m[3] * x[23];
    }
    { const f32x4 m = *(const f32x4*)(mr + 24);
      a0 -= m[0] * x[24];
      a1 -= m[1] * x[25];
      a2 -= m[2] * x[26];
      a3 -= m[3] * x[27];
    }
    { const f32x4 m = *(const f32x4*)(mr + 28);
      a0 -= m[0] * x[28];
      a1 -= m[1] * x[29];
      a2 -= m[2] * x[30];
      a3 -= m[3] * x[31];
    }
    { const f32x4 m = *(const f32x4*)(mr + 32);
      a0 -= m[0] * x[32];
      a1 -= m[1] * x[33];
      a2 -= m[2] * x[34];
      a3 -= m[3] * x[35];
    }
    { const f32x4 m = *(const f32x4*)(mr + 36);
      a0 -= m[0] * x[36];
      a1 -= m[1] * x[37];
      a2 -= m[2] * x[38];
      a3 -= m[3] * x[39];
    }
    { const f32x4 m = *(const f32x4*)(mr + 40);
      a0 -= m[0] * x[40];
      a1 -= m[1] * x[41];
      a2 -= m[2] * x[42];
      a3 -= m[3] * x[43];
    }
    { const f32x4 m = *(const f32x4*)(mr + 44);
      a0 -= m[0] * x[44];
      a1 -= m[1] * x[45];
      a2 -= m[2] * x[46];
      a3 -= m[3] * x[47];
    }
    { const f32x4 m = *(const f32x4*)(mr + 48);
      a0 -= m[0] * x[48];
    }
    SOLVE_ROW_END(49)
    SOLVE_ROW_BEGIN(50)
    { const f32x4 m = *(const f32x4*)(mr + 0);
      a0 -= m[0] * x[0];
      a1 -= m[1] * x[1];
      a2 -= m[2] * x[2];
      a3 -= m[3] * x[3];
    }
    { const f32x4 m = *(const f32x4*)(mr + 4);
      a0 -= m[0] * x[4];
      a1 -= m[1] * x[5];
      a2 -= m[2] * x[6];
      a3 -= m[3] * x[7];
    }
    { const f32x4 m = *(const f32x4*)(mr + 8);
      a0 -= m[0] * x[8];
      a1 -= m[1] * x[9];
      a2 -= m[2] * x[10];
      a3 -= m[3] * x[11];
    }
    { const f32x4 m = *(const f32x4*)(mr + 12);
      a0 -= m[0] * x[12];
      a1 -= m[1] * x[13];
      a2 -= m[2] * x[14];
      a3 -= m[3] * x[15];
    }
    { const f32x4 m = *(const f32x4*)(mr + 16);
      a0 -= m[0] * x[16];
      a1 -= m[1] * x[17];
      a2 -= m[2] * x[18];
      a3 -= m[3] * x[19];
    }
    { const f32x4 m = *(const f32x4*)(mr + 20);
      a0 -= m[0] * x[20];
      a1 -= m[1] * x[21];
      a2 -= m[2] * x[22];
      a3 -= m[3] * x[23];
    }
    { const f32x4 m = *(const f32x4*)(mr + 24);
      a0 -= m[0] * x[24];
      a1 -= m[1] * x[25];
      a2 -= m[2] * x[26];
      a3 -= m[3] * x[27];
    }
    { const f32x4 m = *(const f32x4*)(mr + 28);
      a0 -= m[0] * x[28];
      a1 -= m[1] * x[29];
      a2 -= m[2] * x[30];
      a3 -= m[3] * x[31];
    }
    { const f32x4 m = *(const f32x4*)(mr + 32);
      a0 -= m[0] * x[32];
      a1 -= m[1] * x[33];
      a2 -= m[2] * x[34];
      a3 -= m[3] * x[35];
    }
    { const f32x4 m = *(const f32x4*)(mr + 36);
      a0 -= m[0] * x[36];
      a1 -= m[1] * x[37];
      a2 -= m[2] * x[38];
      a3 -= m[3] * x[39];
    }
    { const f32x4 m = *(const f32x4*)(mr + 40);
      a0 -= m[0] * x[40];
      a1 -= m[1] * x[41];
      a2 -= m[2] * x[42];
      a3 -= m[3] * x[43];
    }
    { const f32x4 m = *(const f32x4*)(mr + 44);
      a0 -= m[0] * x[44];
      a1 -= m[1] * x[45];
      a2 -= m[2] * x[46];
      a3 -= m[3] * x[47];
    }
    { const f32x4 m = *(const f32x4*)(mr + 48);
      a0 -= m[0] * x[48];
      a1 -= m[1] * x[49];
    }
    SOLVE_ROW_END(50)
    SOLVE_ROW_BEGIN(51)
    { const f32x4 m = *(const f32x4*)(mr + 0);
      a0 -= m[0] * x[0];
      a1 -= m[1] * x[1];
      a2 -= m[2] * x[2];
      a3 -= m[3] * x[3];
    }
    { const f32x4 m = *(const f32x4*)(mr + 4);
      a0 -= m[0] * x[4];
      a1 -= m[1] * x[5];
      a2 -= m[2] * x[6];
      a3 -= m[3] * x[7];
    }
    { const f32x4 m = *(const f32x4*)(mr + 8);
      a0 -= m[0] * x[8];
      a1 -= m[1] * x[9];
      a2 -= m[2] * x[10];
      a3 -= m[3] * x[11];
    }
    { const f32x4 m = *(const f32x4*)(mr + 12);
      a0 -= m[0] * x[12];
      a1 -= m[1] * x[13];
      a2 -= m[2] * x[14];
      a3 -= m[3] * x[15];
    }
    { const f32x4 m = *(const f32x4*)(mr + 16);
      a0 -= m[0] * x[16];
      a1 -= m[1] * x[17];
      a2 -= m[2] * x[18];
      a3 -= m[3] * x[19];
    }
    { const f32x4 m = *(const f32x4*)(mr + 20);
      a0 -= m[0] * x[20];
      a1 -= m[1] * x[21];
      a2 -= m[2] * x[22];
      a3 -= m[3] * x[23];
    }
    { const f32x4 m = *(const f32x4*)(mr + 24);
      a0 -= m[0] * x[24];
      a1 -= m[1] * x[25];
      a2 -= m[2] * x[26];
      a3 -= m[3] * x[27];
    }
    { const f32x4 m = *(const f32x4*)(mr + 28);
      a0 -= m[0] * x[28];
      a1 -= m[1] * x[29];
      a2 -= m[2] * x[30];
      a3 -= m[3] * x[31];
    }
    { const f32x4 m = *(const f32x4*)(mr + 32);
      a0 -= m[0] * x[32];
      a1 -= m[1] * x[33];
      a2 -= m[2] * x[34];
      a3 -= m[3] * x[35];
    }
    { const f32x4 m = *(const f32x4*)(mr + 36);
      a0 -= m[0] * x[36];
      a1 -= m[1] * x[37];
      a2 -= m[2] * x[38];
      a3 -= m[3] * x[39];
    }
    { const f32x4 m = *(const f32x4*)(mr + 40);
      a0 -= m[0] * x[40];
      a1 -= m[1] * x[41];
      a2 -= m[2] * x[42];
      a3 -= m[3] * x[43];
    }
    { const f32x4 m = *(const f32x4*)(mr + 44);
      a0 -= m[0] * x[44];
      a1 -= m[1] * x[45];
      a2 -= m[2] * x[46];
      a3 -= m[3] * x[47];
    }
    { const f32x4 m = *(const f32x4*)(mr + 48);
      a0 -= m[0] * x[48];
      a1 -= m[1] * x[49];
      a2 -= m[2] * x[50];
    }
    SOLVE_ROW_END(51)
    SOLVE_ROW_BEGIN(52)
    { const f32x4 m = *(const f32x4*)(mr + 0);
      a0 -= m[0] * x[0];
      a1 -= m[1] * x[1];
      a2 -= m[2] * x[2];
      a3 -= m[3] * x[3];
    }
    { const f32x4 m = *(const f32x4*)(mr + 4);
      a0 -= m[0] * x[4];
      a1 -= m[1] * x[5];
      a2 -= m[2] * x[6];
      a3 -= m[3] * x[7];
    }
    { const f32x4 m = *(const f32x4*)(mr + 8);
      a0 -= m[0] * x[8];
      a1 -= m[1] * x[9];
      a2 -= m[2] * x[10];
      a3 -= m[3] * x[11];
    }
    { const f32x4 m = *(const f32x4*)(mr + 12);
      a0 -= m[0] * x[12];
      a1 -= m[1] * x[13];
      a2 -= m[2] * x[14];
      a3 -= m[3] * x[15];
    }
    { const f32x4 m = *(const f32x4*)(mr + 16);
      a0 -= m[0] * x[16];
      a1 -= m[1] * x[17];
      a2 -= m[2] * x[18];
      a3 -= m[3] * x[19];
    }
    { const f32x4 m = *(const f32x4*)(mr + 20);
      a0 -= m[0] * x[20];
      a1 -= m[1] * x[21];
      a2 -= m[2] * x[22];
      a3 -= m[3] * x[23];
    }
    { const f32x4 m = *(const f32x4*)(mr + 24);
      a0 -= m[0] * x[24];
      a1 -= m[1] * x[25];
      a2 -= m[2] * x[26];
      a3 -= m[3] * x[27];
    }
    { const f32x4 m = *(const f32x4*)(mr + 28);
      a0 -= m[0] * x[28];
      a1 -= m[1] * x[29];
      a2 -= m[2] * x[30];
      a3 -= m[3] * x[31];
    }
    { const f32x4 m = *(const f32x4*)(mr + 32);
      a0 -= m[0] * x[32];
      a1 -= m[1] * x[33];
      a2 -= m[2] * x[34];
      a3 -= m[3] * x[35];
    }
    { const f32x4 m = *(const f32x4*)(mr + 36);
      a0 -= m[0] * x[36];
      a1 -= m[1] * x[37];
      a2 -= m[2] * x[38];
      a3 -= m[3] * x[39];
    }
    { const f32x4 m = *(const f32x4*)(mr + 40);
      a0 -= m[0] * x[40];
      a1 -= m[1] * x[41];
      a2 -= m[2] * x[42];
      a3 -= m[3] * x[43];
    }
    { const f32x4 m = *(const f32x4*)(mr + 44);
      a0 -= m[0] * x[44];
      a1 -= m[1] * x[45];
      a2 -= m[2] * x[46];
      a3 -= m[3] * x[47];
    }
    { const f32x4 m = *(const f32x4*)(mr + 48);
      a0 -= m[0] * x[48];
      a1 -= m[1] * x[49];
      a2 -= m[2] * x[50];
      a3 -= m[3] * x[51];
    }
    SOLVE_ROW_END(52)
    SOLVE_ROW_BEGIN(53)
    { const f32x4 m = *(const f32x4*)(mr + 0);
      a0 -= m[0] * x[0];
      a1 -= m[1] * x[1];
      a2 -= m[2] * x[2];
      a3 -= m[3] * x[3];
    }
    { const f32x4 m = *(const f32x4*)(mr + 4);
      a0 -= m[0] * x[4];
      a1 -= m[1] * x[5];
      a2 -= m[2] * x[6];
      a3 -= m[3] * x[7];
    }
    { const f32x4 m = *(const f32x4*)(mr + 8);
      a0 -= m[0] * x[8];
      a1 -= m[1] * x[9];
      a2 -= m[2] * x[10];
      a3 -= m[3] * x[11];
    }
    { const f32x4 m = *(const f32x4*)(mr + 12);
      a0 -= m[0] * x[12];
      a1 -= m[1] * x[13];
      a2 -= m[2] * x[14];
      a3 -= m[3] * x[15];
    }
    { const f32x4 m = *(const f32x4*)(mr + 16);
      a0 -= m[0] * x[16];
      a1 -= m[1] * x[17];
      a2 -= m[2] * x[18];
      a3 -= m[3] * x[19];
    }
    { const f32x4 m = *(const f32x4*)(mr + 20);
      a0 -= m[0] * x[20];
      a1 -= m[1] * x[21];
      a2 -= m[2] * x[22];
      a3 -= m[3] * x[23];
    }
    { const f32x4 m = *(const f32x4*)(mr + 24);
      a0 -= m[0] * x[24];
      a1 -= m[1] * x[25];
      a2 -= m[2] * x[26];
      a3 -= m[3] * x[27];
    }
    { const f32x4 m = *(const f32x4*)(mr + 28);
      a0 -= m[0] * x[28];
      a1 -= m[1] * x[29];
      a2 -= m[2] * x[30];
      a3 -= m[3] * x[31];
    }
    { const f32x4 m = *(const f32x4*)(mr + 32);
      a0 -= m[0] * x[32];
      a1 -= m[1] * x[33];
      a2 -= m[2] * x[34];
      a3 -= m[3] * x[35];
    }
    { const f32x4 m = *(const f32x4*)(mr + 36);
      a0 -= m[0] * x[36];
      a1 -= m[1] * x[37];
      a2 -= m[2] * x[38];
      a3 -= m[3] * x[39];
    }
    { const f32x4 m = *(const f32x4*)(mr + 40);
      a0 -= m[0] * x[40];
      a1 -= m[1] * x[41];
      a2 -= m[2] * x[42];
      a3 -= m[3] * x[43];
    }
    { const f32x4 m = *(const f32x4*)(mr + 44);
      a0 -= m[0] * x[44];
      a1 -= m[1] * x[45];
      a2 -= m[2] * x[46];
      a3 -= m[3] * x[47];
    }
    { const f32x4 m = *(const f32x4*)(mr + 48);
      a0 -= m[0] * x[48];
      a1 -= m[1] * x[49];
      a2 -= m[2] * x[50];
      a3 -= m[3] * x[51];
    }
    { const f32x4 m = *(const f32x4*)(mr + 52);
      a0 -= m[0] * x[52];
    }
    SOLVE_ROW_END(53)
    SOLVE_ROW_BEGIN(54)
    { const f32x4 m = *(const f32x4*)(mr + 0);
      a0 -= m[0] * x[0];
      a1 -= m[1] * x[1];
      a2 -= m[2] * x[2];
      a3 -= m[3] * x[3];
    }
    { const f32x4 m = *(const f32x4*)(mr + 4);
      a0 -= m[0] * x[4];
      a1 -= m[1] * x[5];
      a2 -= m[2] * x[6];
      a3 -= m[3] * x[7];
    }
    { const f32x4 m = *(const f32x4*)(mr + 8);
      a0 -= m[0] * x[8];
      a1 -= m[1] * x[9];
      a2 -= m[2] * x[10];
      a3 -= m[3] * x[11];
    }
    { const f32x4 m = *(const f32x4*)(mr + 12);
      a0 -= m[0] * x[12];
      a1 -= m[1] * x[13];
      a2 -= m[2] * x[14];
      a3 -= m[3] * x[15];
    }
    { const f32x4 m = *(const f32x4*)(mr + 16);
      a0 -= m[0] * x[16];
      a1 -= m[1] * x[17];
      a2 -= m[2] * x[18];
      a3 -= m[3] * x[19];
    }
    { const f32x4 m = *(const f32x4*)(mr + 20);
      a0 -= m[0] * x[20];
      a1 -= m[1] * x[21];
      a2 -= m[2] * x[22];
      a3 -= m[3] * x[23];
    }
    { const f32x4 m = *(const f32x4*)(mr + 24);
      a0 -= m[0] * x[24];
      a1 -= m[1] * x[25];
      a2 -= m[2] * x[26];
      a3 -= m[3] * x[27];
    }
    { const f32x4 m = *(const f32x4*)(mr + 28);
      a0 -= m[0] * x[28];
      a1 -= m[1] * x[29];
      a2 -= m[2] * x[30];
      a3 -= m[3] * x[31];
    }
    { const f32x4 m = *(const f32x4*)(mr + 32);
      a0 -= m[0] * x[32];
      a1 -= m[1] * x[33];
      a2 -= m[2] * x[34];
      a3 -= m[3] * x[35];
    }
    { const f32x4 m = *(const f32x4*)(mr + 36);
      a0 -= m[0] * x[36];
      a1 -= m[1] * x[37];
      a2 -= m[2] * x[38];
      a3 -= m[3] * x[39];
    }
    { const f32x4 m = *(const f32x4*)(mr + 40);
      a0 -= m[0] * x[40];
      a1 -= m[1] * x[41];
      a2 -= m[2] * x[42];
      a3 -= m[3] * x[43];
    }
    { const f32x4 m = *(const f32x4*)(mr + 44);
      a0 -= m[0] * x[44];
      a1 -= m[1] * x[45];
      a2 -= m[2] * x[46];
      a3 -= m[3] * x[47];
    }
    { const f32x4 m = *(const f32x4*)(mr + 48);
      a0 -= m[0] * x[48];
      a1 -= m[1] * x[49];
      a2 -= m[2] * x[50];
      a3 -= m[3] * x[51];
    }
    { const f32x4 m = *(const f32x4*)(mr + 52);
      a0 -= m[0] * x[52];
      a1 -= m[1] * x[53];
    }
    SOLVE_ROW_END(54)
    SOLVE_ROW_BEGIN(55)
    { const f32x4 m = *(const f32x4*)(mr + 0);
      a0 -= m[0] * x[0];
      a1 -= m[1] * x[1];
      a2 -= m[2] * x[2];
      a3 -= m[3] * x[3];
    }
    { const f32x4 m = *(const f32x4*)(mr + 4);
      a0 -= m[0] * x[4];
      a1 -= m[1] * x[5];
      a2 -= m[2] * x[6];
      a3 -= m[3] * x[7];
    }
    { const f32x4 m = *(const f32x4*)(mr + 8);
      a0 -= m[0] * x[8];
      a1 -= m[1] * x[9];
      a2 -= m[2] * x[10];
      a3 -= m[3] * x[11];
    }
    { const f32x4 m = *(const f32x4*)(mr + 12);
      a0 -= m[0] * x[12];
      a1 -= m[1] * x[13];
      a2 -= m[2] * x[14];
      a3 -= m[3] * x[15];
    }
    { const f32x4 m = *(const f32x4*)(mr + 16);
      a0 -= m[0] * x[16];
      a1 -= m[1] * x[17];
      a2 -= m[2] * x[18];
      a3 -= m[3] * x[19];
    }
    { const f32x4 m = *(const f32x4*)(mr + 20);
      a0 -= m[0] * x[20];
      a1 -= m[1] * x[21];
      a2 -= m[2] * x[22];
      a3 -= m[3] * x[23];
    }
    { const f32x4 m = *(const f32x4*)(mr + 24);
      a0 -= m[0] * x[24];
      a1 -= m[1] * x[25];
      a2 -= m[2] * x[26];
      a3 -= m[3] * x[27];
    }
    { const f32x4 m = *(const f32x4*)(mr + 28);
      a0 -= m[0] * x[28];
      a1 -= m[1] * x[29];
      a2 -= m[2] * x[30];
      a3 -= m[3] * x[31];
    }
    { const f32x4 m = *(const f32x4*)(mr + 32);
      a0 -= m[0] * x[32];
      a1 -= m[1] * x[33];
      a2 -= m[2] * x[34];
      a3 -= m[3] * x[35];
    }
    { const f32x4 m = *(const f32x4*)(mr + 36);
      a0 -= m[0] * x[36];
      a1 -= m[1] * x[37];
      a2 -= m[2] * x[38];
      a3 -= m[3] * x[39];
    }
    { const f32x4 m = *(const f32x4*)(mr + 40);
      a0 -= m[0] * x[40];
      a1 -= m[1] * x[41];
      a2 -= m[2] * x[42];
      a3 -= m[3] * x[43];
    }
    { const f32x4 m = *(const f32x4*)(mr + 44);
      a0 -= m[0] * x[44];
      a1 -= m[1] * x[45];
      a2 -= m[2] * x[46];
      a3 -= m[3] * x[47];
    }
    { const f32x4 m = *(const f32x4*)(mr + 48);
      a0 -= m[0] * x[48];
      a1 -= m[1] * x[49];
      a2 -= m[2] * x[50];
      a3 -= m[3] * x[51];
    }
    { const f32x4 m = *(const f32x4*)(mr + 52);
      a0 -= m[0] * x[52];
      a1 -= m[1] * x[53];
      a2 -= m[2] * x[54];
    }
    SOLVE_ROW_END(55)
    SOLVE_ROW_BEGIN(56)
    { const f32x4 m = *(const f32x4*)(mr + 0);
      a0 -= m[0] * x[0];
      a1 -= m[1] * x[1];
      a2 -= m[2] * x[2];
      a3 -= m[3] * x[3];
    }
    { const f32x4 m = *(const f32x4*)(mr + 4);
      a0 -= m[0] * x[4];
      a1 -= m[1] * x[5];
      a2 -= m[2] * x[6];
      a3 -= m[3] * x[7];
    }
    { const f32x4 m = *(const f32x4*)(mr + 8);
      a0 -= m[0] * x[8];
      a1 -= m[1] * x[9];
      a2 -= m[2] * x[10];
      a3 -= m[3] * x[11];
    }
    { const f32x4 m = *(const f32x4*)(mr + 12);
      a0 -= m[0] * x[12];
      a1 -= m[1] * x[13];
      a2 -= m[2] * x[14];
      a3 -= m[3] * x[15];
    }
    { const f32x4 m = *(const f32x4*)(mr + 16);
      a0 -= m[0] * x[16];
      a1 -= m[1] * x[17];
      a2 -= m[2] * x[18];
      a3 -= m[3] * x[19];
    }
    { const f32x4 m = *(const f32x4*)(mr + 20);
      a0 -= m[0] * x[20];
      a1 -= m[1] * x[21];
      a2 -= m[2] * x[22];
      a3 -= m[3] * x[23];
    }
    { const f32x4 m = *(const f32x4*)(mr + 24);
      a0 -= m[0] * x[24];
      a1 -= m[1] * x[25];
      a2 -= m[2] * x[26];
      a3 -= m[3] * x[27];
    }
    { const f32x4 m = *(const f32x4*)(mr + 28);
      a0 -= m[0] * x[28];
      a1 -= m[1] * x[29];
      a2 -= m[2] * x[30];
      a3 -= m[3] * x[31];
    }
    { const f32x4 m = *(const f32x4*)(mr + 32);
      a0 -= m[0] * x[32];
      a1 -= m[1] * x[33];
      a2 -= m[2] * x[34];
      a3 -= m[3] * x[35];
    }
    { const f32x4 m = *(const f32x4*)(mr + 36);
      a0 -= m[0] * x[36];
      a1 -= m[1] * x[37];
      a2 -= m[2] * x[38];
      a3 -= m[3] * x[39];
    }
    { const f32x4 m = *(const f32x4*)(mr + 40);
      a0 -= m[0] * x[40];
      a1 -= m[1] * x[41];
      a2 -= m[2] * x[42];
      a3 -= m[3] * x[43];
    }
    { const f32x4 m = *(const f32x4*)(mr + 44);
      a0 -= m[0] * x[44];
      a1 -= m[1] * x[45];
      a2 -= m[2] * x[46];
      a3 -= m[3] * x[47];
    }
    { const f32x4 m = *(const f32x4*)(mr + 48);
      a0 -= m[0] * x[48];
      a1 -= m[1] * x[49];
      a2 -= m[2] * x[50];
      a3 -= m[3] * x[51];
    }
    { const f32x4 m = *(const f32x4*)(mr + 52);
      a0 -= m[0] * x[52];
      a1 -= m[1] * x[53];
      a2 -= m[2] * x[54];
      a3 -= m[3] * x[55];
    }
    SOLVE_ROW_END(56)
    SOLVE_ROW_BEGIN(57)
    { const f32x4 m = *(const f32x4*)(mr + 0);
      a0 -= m[0] * x[0];
      a1 -= m[1] * x[1];
      a2 -= m[2] * x[2];
      a3 -= m[3] * x[3];
    }
    { const f32x4 m = *(const f32x4*)(mr + 4);
      a0 -= m[0] * x[4];
      a1 -= m[1] * x[5];
      a2 -= m[2] * x[6];
      a3 -= m[3] * x[7];
    }
    { const f32x4 m = *(const f32x4*)(mr + 8);
      a0 -= m[0] * x[8];
      a1 -= m[1] * x[9];
      a2 -= m[2] * x[10];
      a3 -= m[3] * x[11];
    }
    { const f32x4 m = *(const f32x4*)(mr + 12);
      a0 -= m[0] * x[12];
      a1 -= m[1] * x[13];
      a2 -= m[2] * x[14];
      a3 -= m[3] * x[15];
    }
    { const f32x4 m = *(const f32x4*)(mr + 16);
      a0 -= m[0] * x[16];
      a1 -= m[1] * x[17];
      a2 -= m[2] * x[18];
      a3 -= m[3] * x[19];
    }
    { const f32x4 m = *(const f32x4*)(mr + 20);
      a0 -= m[0] * x[20];
      a1 -= m[1] * x[21];
      a2 -= m[2] * x[22];
      a3 -= m[3] * x[23];
    }
    { const f32x4 m = *(const f32x4*)(mr + 24);
      a0 -= m[0] * x[24];
      a1 -= m[1] * x[25];
      a2 -= m[2] * x[26];
      a3 -= m[3] * x[27];
    }
    { const f32x4 m = *(const f32x4*)(mr + 28);
      a0 -= m[0] * x[28];
      a1 -= m[1] * x[29];
      a2 -= m[2] * x[30];
      a3 -= m[3] * x[31];
    }
    { const f32x4 m = *(const f32x4*)(mr + 32);
      a0 -= m[0] * x[32];
      a1 -= m[1] * x[33];
      a2 -= m[2] * x[34];
      a3 -= m[3] * x[35];
    }
    { const f32x4 m = *(const f32x4*)(mr + 36);
      a0 -= m[0] * x[36];
      a1 -= m[1] * x[37];
      a2 -= m[2] * x[38];
      a3 -= m[3] * x[39];
    }
    { const f32x4 m = *(const f32x4*)(mr + 40);
      a0 -= m[0] * x[40];
      a1 -= m[1] * x[41];
      a2 -= m[2] * x[42];
      a3 -= m[3] * x[43];
    }
    { const f32x4 m = *(const f32x4*)(mr + 44);
      a0 -= m[0] * x[44];
      a1 -= m[1] * x[45];
      a2 -= m[2] * x[46];
      a3 -= m[3] * x[47];
    }
    { const f32x4 m = *(const f32x4*)(mr + 48);
      a0 -= m[0] * x[48];
      a1 -= m[1] * x[49];
      a2 -= m[2] * x[50];
      a3 -= m[3] * x[51];
    }
    { const f32x4 m = *(const f32x4*)(mr + 52);
      a0 -= m[0] * x[52];
      a1 -= m[1] * x[53];
      a2 -= m[2] * x[54];
      a3 -= m[3] * x[55];
    }
    { const f32x4 m = *(const f32x4*)(mr + 56);
      a0 -= m[0] * x[56];
    }
    SOLVE_ROW_END(57)
    SOLVE_ROW_BEGIN(58)
    { const f32x4 m = *(const f32x4*)(mr + 0);
      a0 -= m[0] * x[0];
      a1 -= m[1] * x[1];
      a2 -= m[2] * x[2];
      a3 -= m[3] * x[3];
    }
    { const f32x4 m = *(const f32x4*)(mr + 4);
      a0 -= m[0] * x[4];
      a1 -= m[1] * x[5];
      a2 -= m[2] * x[6];
      a3 -= m[3] * x[7];
    }
    { const f32x4 m = *(const f32x4*)(mr + 8);
      a0 -= m[0] * x[8];
      a1 -= m[1] * x[9];
      a2 -= m[2] * x[10];
      a3 -= m[3] * x[11];
    }
    { const f32x4 m = *(const f32x4*)(mr + 12);
      a0 -= m[0] * x[12];
      a1 -= m[1] * x[13];
      a2 -= m[2] * x[14];
      a3 -= m[3] * x[15];
    }
    { const f32x4 m = *(const f32x4*)(mr + 16);
      a0 -= m[0] * x[16];
      a1 -= m[1] * x[17];
      a2 -= m[2] * x[18];
      a3 -= m[3] * x[19];
    }
    { const f32x4 m = *(const f32x4*)(mr + 20);
      a0 -= m[0] * x[20];
      a1 -= m[1] * x[21];
      a2 -= m[2] * x[22];
      a3 -= m[3] * x[23];
    }
    { const f32x4 m = *(const f32x4*)(mr + 24);
      a0 -= m[0] * x[24];
      a1 -= m[1] * x[25];
      a2 -= m[2] * x[26];
      a3 -= m[3] * x[27];
    }
    { const f32x4 m = *(const f32x4*)(mr + 28);
      a0 -= m[0] * x[28];
      a1 -= m[1] * x[29];
      a2 -= m[2] * x[30];
      a3 -= m[3] * x[31];
    }
    { const f32x4 m = *(const f32x4*)(mr + 32);
      a0 -= m[0] * x[32];
      a1 -= m[1] * x[33];
      a2 -= m[2] * x[34];
      a3 -= m[3] * x[35];
    }
    { const f32x4 m = *(const f32x4*)(mr + 36);
      a0 -= m[0] * x[36];
      a1 -= m[1] * x[37];
      a2 -= m[2] * x[38];
      a3 -= m[3] * x[39];
    }
    { const f32x4 m = *(const f32x4*)(mr + 40);
      a0 -= m[0] * x[40];
      a1 -= m[1] * x[41];
      a2 -= m[2] * x[42];
      a3 -= m[3] * x[43];
    }
    { const f32x4 m = *(const f32x4*)(mr + 44);
      a0 -= m[0] * x[44];
      a1 -= m[1] * x[45];
      a2 -= m[2] * x[46];
      a3 -= m[3] * x[47];
    }
    { const f32x4 m = *(const f32x4*)(mr + 48);
      a0 -= m[0] * x[48];
      a1 -= m[1] * x[49];
      a2 -= m[2] * x[50];
      a3 -= m[3] * x[51];
    }
    { const f32x4 m = *(const f32x4*)(mr + 52);
      a0 -= m[0] * x[52];
      a1 -= m[1] * x[53];
      a2 -= m[2] * x[54];
      a3 -= m[3] * x[55];
    }
    { const f32x4 m = *(const f32x4*)(mr + 56);
      a0 -= m[0] * x[56];
      a1 -= m[1] * x[57];
    }
    SOLVE_ROW_END(58)
    SOLVE_ROW_BEGIN(59)
    { const f32x4 m = *(const f32x4*)(mr + 0);
      a0 -= m[0] * x[0];
      a1 -= m[1] * x[1];
      a2 -= m[2] * x[2];
      a3 -= m[3] * x[3];
    }
    { const f32x4 m = *(const f32x4*)(mr + 4);
      a0 -= m[0] * x[4];
      a1 -= m[1] * x[5];
      a2 -= m[2] * x[6];
      a3 -= m[3] * x[7];
    }
    { const f32x4 m = *(const f32x4*)(mr + 8);
      a0 -= m[0] * x[8];
      a1 -= m[1] * x[9];
      a2 -= m[2] * x[10];
      a3 -= m[3] * x[11];
    }
    { const f32x4 m = *(const f32x4*)(mr + 12);
      a0 -= m[0] * x[12];
      a1 -= m[1] * x[13];
      a2 -= m[2] * x[14];
      a3 -= m[3] * x[15];
    }
    { const f32x4 m = *(const f32x4*)(mr + 16);
      a0 -= m[0] * x[16];
      a1 -= m[1] * x[17];
      a2 -= m[2] * x[18];
      a3 -= m[3] * x[19];
    }
    { const f32x4 m = *(const f32x4*)(mr + 20);
      a0 -= m[0] * x[20];
      a1 -= m[1] * x[21];
      a2 -= m[2] * x[22];
      a3 -= m[3] * x[23];
    }
    { const f32x4 m = *(const f32x4*)(mr + 24);
      a0 -= m[0] * x[24];
      a1 -= m[1] * x[25];
      a2 -= m[2] * x[26];
      a3 -= m[3] * x[27];
    }
    { const f32x4 m = *(const f32x4*)(mr + 28);
      a0 -= m[0] * x[28];
      a1 -= m[1] * x[29];
      a2 -= m[2] * x[30];
      a3 -= m[3] * x[31];
    }
    { const f32x4 m = *(const f32x4*)(mr + 32);
      a0 -= m[0] * x[32];
      a1 -= m[1] * x[33];
      a2 -= m[2] * x[34];
      a3 -= m[3] * x[35];
    }
    { const f32x4 m = *(const f32x4*)(mr + 36);
      a0 -= m[0] * x[36];
      a1 -= m[1] * x[37];
      a2 -= m[2] * x[38];
      a3 -= m[3] * x[39];
    }
    { const f32x4 m = *(const f32x4*)(mr + 40);
      a0 -= m[0] * x[40];
      a1 -= m[1] * x[41];
      a2 -= m[2] * x[42];
      a3 -= m[3] * x[43];
    }
    { const f32x4 m = *(const f32x4*)(mr + 44);
      a0 -= m[0] * x[44];
      a1 -= m[1] * x[45];
      a2 -= m[2] * x[46];
      a3 -= m[3] * x[47];
    }
    { const f32x4 m = *(const f32x4*)(mr + 48);
      a0 -= m[0] * x[48];
      a1 -= m[1] * x[49];
      a2 -= m[2] * x[50];
      a3 -= m[3] * x[51];
    }
    { const f32x4 m = *(const f32x4*)(mr + 52);
      a0 -= m[0] * x[52];
      a1 -= m[1] * x[53];
      a2 -= m[2] * x[54];
      a3 -= m[3] * x[55];
    }
    { const f32x4 m = *(const f32x4*)(mr + 56);
      a0 -= m[0] * x[56];
      a1 -= m[1] * x[57];
      a2 -= m[2] * x[58];
    }
    SOLVE_ROW_END(59)
    SOLVE_ROW_BEGIN(60)
    { const f32x4 m = *(const f32x4*)(mr + 0);
      a0 -= m[0] * x[0];
      a1 -= m[1] * x[1];
      a2 -= m[2] * x[2];
      a3 -= m[3] * x[3];
    }
    { const f32x4 m = *(const f32x4*)(mr + 4);
      a0 -= m[0] * x[4];
      a1 -= m[1] * x[5];
      a2 -= m[2] * x[6];
      a3 -= m[3] * x[7];
    }
    { const f32x4 m = *(const f32x4*)(mr + 8);
      a0 -= m[0] * x[8];
      a1 -= m[1] * x[9];
      a2 -= m[2] * x[10];
      a3 -= m[3] * x[11];
    }
    { const f32x4 m = *(const f32x4*)(mr + 12);
      a0 -= m[0] * x[12];
      a1 -= m[1] * x[13];
      a2 -= m[2] * x[14];
      a3 -= m[3] * x[15];
    }
    { const f32x4 m = *(const f32x4*)(mr + 16);
      a0 -= m[0] * x[16];
      a1 -= m[1] * x[17];
      a2 -= m[2] * x[18];
      a3 -= m[3] * x[19];
    }
    { const f32x4 m = *(const f32x4*)(mr + 20);
      a0 -= m[0] * x[20];
      a1 -= m[1] * x[21];
      a2 -= m[2] * x[22];
      a3 -= m[3] * x[23];
    }
    { const f32x4 m = *(const f32x4*)(mr + 24);
      a0 -= m[0] * x[24];
      a1 -= m[1] * x[25];
      a2 -= m[2] * x[26];
      a3 -= m[3] * x[27];
    }
    { const f32x4 m = *(const f32x4*)(mr + 28);
      a0 -= m[0] * x[28];
      a1 -= m[1] * x[29];
      a2 -= m[2] * x[30];
      a3 -= m[3] * x[31];
    }
    { const f32x4 m = *(const f32x4*)(mr + 32);
      a0 -= m[0] * x[32];
      a1 -= m[1] * x[33];
      a2 -= m[2] * x[34];
      a3 -= m[3] * x[35];
    }
    { const f32x4 m = *(const f32x4*)(mr + 36);
      a0 -= m[0] * x[36];
      a1 -= m[1] * x[37];
      a2 -= m[2] * x[38];
      a3 -= m[3] * x[39];
    }
    { const f32x4 m = *(const f32x4*)(mr + 40);
      a0 -= m[0] * x[40];
      a1 -= m[1] * x[41];
      a2 -= m[2] * x[42];
      a3 -= m[3] * x[43];
    }
    { const f32x4 m = *(const f32x4*)(mr + 44);
      a0 -= m[0] * x[44];
      a1 -= m[1] * x[45];
      a2 -= m[2] * x[46];
      a3 -= m[3] * x[47];
    }
    { const f32x4 m = *(const f32x4*)(mr + 48);
      a0 -= m[0] * x[48];
      a1 -= m[1] * x[49];
      a2 -= m[2] * x[50];
      a3 -= m[3] * x[51];
    }
    { const f32x4 m = *(const f32x4*)(mr + 52);
      a0 -= m[0] * x[52];
      a1 -= m[1] * x[53];
      a2 -= m[2] * x[54];
      a3 -= m[3] * x[55];
    }
    { const f32x4 m = *(const f32x4*)(mr + 56);
      a0 -= m[0] * x[56];
      a1 -= m[1] * x[57];
      a2 -= m[2] * x[58];
      a3 -= m[3] * x[59];
    }
    SOLVE_ROW_END(60)
    SOLVE_ROW_BEGIN(61)
    { const f32x4 m = *(const f32x4*)(mr + 0);
      a0 -= m[0] * x[0];
      a1 -= m[1] * x[1];
      a2 -= m[2] * x[2];
      a3 -= m[3] * x[3];
    }
    { const f32x4 m = *(const f32x4*)(mr + 4);
      a0 -= m[0] * x[4];
      a1 -= m[1] * x[5];
      a2 -= m[2] * x[6];
      a3 -= m[3] * x[7];
    }
    { const f32x4 m = *(const f32x4*)(mr + 8);
      a0 -= m[0] * x[8];
      a1 -= m[1] * x[9];
      a2 -= m[2] * x[10];
      a3 -= m[3] * x[11];
    }
    { const f32x4 m = *(const f32x4*)(mr + 12);
      a0 -= m[0] * x[12];
      a1 -= m[1] * x[13];
      a2 -= m[2] * x[14];
      a3 -= m[3] * x[15];
    }
    { const f32x4 m = *(const f32x4*)(mr + 16);
      a0 -= m[0] * x[16];
      a1 -= m[1] * x[17];
      a2 -= m[2] * x[18];
      a3 -= m[3] * x[19];
    }
    { const f32x4 m = *(const f32x4*)(mr + 20);
      a0 -= m[0] * x[20];
      a1 -= m[1] * x[21];
      a2 -= m[2] * x[22];
      a3 -= m[3] * x[23];
    }
    { const f32x4 m = *(const f32x4*)(mr + 24);
      a0 -= m[0] * x[24];
      a1 -= m[1] * x[25];
      a2 -= m[2] * x[26];
      a3 -= m[3] * x[27];
    }
    { const f32x4 m = *(const f32x4*)(mr + 28);
      a0 -= m[0] * x[28];
      a1 -= m[1] * x[29];
      a2 -= m[2] * x[30];
      a3 -= m[3] * x[31];
    }
    { const f32x4 m = *(const f32x4*)(mr + 32);
      a0 -= m[0] * x[32];
      a1 -= m[1] * x[33];
      a2 -= m[2] * x[34];
      a3 -= m[3] * x[35];
    }
    { const f32x4 m = *(const f32x4*)(mr + 36);
      a0 -= m[0] * x[36];
      a1 -= m[1] * x[37];
      a2 -= m[2] * x[38];
      a3 -= m[3] * x[39];
    }
    { const f32x4 m = *(const f32x4*)(mr + 40);
      a0 -= m[0] * x[40];
      a1 -= m[1] * x[41];
      a2 -= m[2] * x[42];
      a3 -= m[3] * x[43];
    }
    { const f32x4 m = *(const f32x4*)(mr + 44);
      a0 -= m[0] * x[44];
      a1 -= m[1] * x[45];
      a2 -= m[2] * x[46];
      a3 -= m[3] * x[47];
    }
    { const f32x4 m = *(const f32x4*)(mr + 48);
      a0 -= m[0] * x[48];
      a1 -= m[1] * x[49];
      a2 -= m[2] * x[50];
      a3 -= m[3] * x[51];
    }
    { const f32x4 m = *(const f32x4*)(mr + 52);
      a0 -= m[0] * x[52];
      a1 -= m[1] * x[53];
      a2 -= m[2] * x[54];
      a3 -= m[3] * x[55];
    }
    { const f32x4 m = *(const f32x4*)(mr + 56);
      a0 -= m[0] * x[56];
      a1 -= m[1] * x[57];
      a2 -= m[2] * x[58];
      a3 -= m[3] * x[59];
    }
    { const f32x4 m = *(const f32x4*)(mr + 60);
      a0 -= m[0] * x[60];
    }
    SOLVE_ROW_END(61)
    SOLVE_ROW_BEGIN(62)
    { const f32x4 m = *(const f32x4*)(mr + 0);
      a0 -= m[0] * x[0];
      a1 -= m[1] * x[1];
      a2 -= m[2] * x[2];
      a3 -= m[3] * x[3];
    }
    { const f32x4 m = *(const f32x4*)(mr + 4);
      a0 -= m[0] * x[4];
      a1 -= m[1] * x[5];
      a2 -= m[2] * x[6];
      a3 -= m[3] * x[7];
    }
    { const f32x4 m = *(const f32x4*)(mr + 8);
      a0 -= m[0] * x[8];
      a1 -= m[1] * x[9];
      a2 -= m[2] * x[10];
      a3 -= m[3] * x[11];
    }
    { const f32x4 m = *(const f32x4*)(mr + 12);
      a0 -= m[0] * x[12];
      a1 -= m[1] * x[13];
      a2 -= m[2] * x[14];
      a3 -= m[3] * x[15];
    }
    { const f32x4 m = *(const f32x4*)(mr + 16);
      a0 -= m[0] * x[16];
      a1 -= m[1] * x[17];
      a2 -= m[2] * x[18];
      a3 -= m[3] * x[19];
    }
    { const f32x4 m = *(const f32x4*)(mr + 20);
      a0 -= m[0] * x[20];
      a1 -= m[1] * x[21];
      a2 -= m[2] * x[22];
      a3 -= m[3] * x[23];
    }
    { const f32x4 m = *(const f32x4*)(mr + 24);
      a0 -= m[0] * x[24];
      a1 -= m[1] * x[25];
      a2 -= m[2] * x[26];
      a3 -= m[3] * x[27];
    }
    { const f32x4 m = *(const f32x4*)(mr + 28);
      a0 -= m[0] * x[28];
      a1 -= m[1] * x[29];
      a2 -= m[2] * x[30];
      a3 -= m[3] * x[31];
    }
    { const f32x4 m = *(const f32x4*)(mr + 32);
      a0 -= m[0] * x[32];
      a1 -= m[1] * x[33];
      a2 -= m[2] * x[34];
      a3 -= m[3] * x[35];
    }
    { const f32x4 m = *(const f32x4*)(mr + 36);
      a0 -= m[0] * x[36];
      a1 -= m[1] * x[37];
      a2 -= m[2] * x[38];
      a3 -= m[3] * x[39];
    }
    { const f32x4 m = *(const f32x4*)(mr + 40);
      a0 -= m[0] * x[40];
      a1 -= m[1] * x[41];
      a2 -= m[2] * x[42];
      a3 -= m[3] * x[43];
    }
    { const f32x4 m = *(const f32x4*)(mr + 44);
      a0 -= m[0] * x[44];
      a1 -= m[1] * x[45];
      a2 -= m[2] * x[46];
      a3 -= m[3] * x[47];
    }
    { const f32x4 m = *(const f32x4*)(mr + 48);
      a0 -= m[0] * x[48];
      a1 -= m[1] * x[49];
      a2 -= m[2] * x[50];
      a3 -= m[3] * x[51];
    }
    { const f32x4 m = *(const f32x4*)(mr + 52);
      a0 -= m[0] * x[52];
      a1 -= m[1] * x[53];
      a2 -= m[2] * x[54];
      a3 -= m[3] * x[55];
    }
    { const f32x4 m = *(const f32x4*)(mr + 56);
      a0 -= m[0] * x[56];
      a1 -= m[1] * x[57];
      a2 -= m[2] * x[58];
      a3 -= m[3] * x[59];
    }
    { const f32x4 m = *(const f32x4*)(mr + 60);
      a0 -= m[0] * x[60];
      a1 -= m[1] * x[61];
    }
    SOLVE_ROW_END(62)
    SOLVE_ROW_BEGIN(63)
    { const f32x4 m = *(const f32x4*)(mr + 0);
      a0 -= m[0] * x[0];
      a1 -= m[1] * x[1];
      a2 -= m[2] * x[2];
      a3 -= m[3] * x[3];
    }
    { const f32x4 m = *(const f32x4*)(mr + 4);
      a0 -= m[0] * x[4];
      a1 -= m[1] * x[5];
      a2 -= m[2] * x[6];
      a3 -= m[3] * x[7];
    }
    { const f32x4 m = *(const f32x4*)(mr + 8);
      a0 -= m[0] * x[8];
      a1 -= m[1] * x[9];
      a2 -= m[2] * x[10];
      a3 -= m[3] * x[11];
    }
    { const f32x4 m = *(const f32x4*)(mr + 12);
      a0 -= m[0] * x[12];
      a1 -= m[1] * x[13];
      a2 -= m[2] * x[14];
      a3 -= m[3] * x[15];
    }
    { const f32x4 m = *(const f32x4*)(mr + 16);
      a0 -= m[0] * x[16];
      a1 -= m[1] * x[17];
      a2 -= m[2] * x[18];
      a3 -= m[3] * x[19];
    }
    { const f32x4 m = *(const f32x4*)(mr + 20);
      a0 -= m[0] * x[20];
      a1 -= m[1] * x[21];
      a2 -= m[2] * x[22];
      a3 -= m[3] * x[23];
    }
    { const f32x4 m = *(const f32x4*)(mr + 24);
      a0 -= m[0] * x[24];
      a1 -= m[1] * x[25];
      a2 -= m[2] * x[26];
      a3 -= m[3] * x[27];
    }
    { const f32x4 m = *(const f32x4*)(mr + 28);
      a0 -= m[0] * x[28];
      a1 -= m[1] * x[29];
      a2 -= m[2] * x[30];
      a3 -= m[3] * x[31];
    }
    { const f32x4 m = *(const f32x4*)(mr + 32);
      a0 -= m[0] * x[32];
      a1 -= m[1] * x[33];
      a2 -= m[2] * x[34];
      a3 -= m[3] * x[35];
    }
    { const f32x4 m = *(const f32x4*)(mr + 36);
      a0 -= m[0] * x[36];
      a1 -= m[1] * x[37];
      a2 -= m[2] * x[38];
      a3 -= m[3] * x[39];
    }
    { const f32x4 m = *(const f32x4*)(mr + 40);
      a0 -= m[0] * x[40];
      a1 -= m[1] * x[41];
      a2 -= m[2] * x[42];
      a3 -= m[3] * x[43];
    }
    { const f32x4 m = *(const f32x4*)(mr + 44);
      a0 -= m[0] * x[44];
      a1 -= m[1] * x[45];
      a2 -= m[2] * x[46];
      a3 -= m[3] * x[47];
    }
    { const f32x4 m = *(const f32x4*)(mr + 48);
      a0 -= m[0] * x[48];
      a1 -= m[1] * x[49];
      a2 -= m[2] * x[50];
      a3 -= m[3] * x[51];
    }
    { const f32x4 m = *(const f32x4*)(mr + 52);
      a0 -= m[0] * x[52];
      a1 -= m[1] * x[53];
      a2 -= m[2] * x[54];
      a3 -= m[3] * x[55];
    }
    { const f32x4 m = *(const f32x4*)(mr + 56);
      a0 -= m[0] * x[56];
      a1 -= m[1] * x[57];
      a2 -= m[2] * x[58];
      a3 -= m[3] * x[59];
    }
    { const f32x4 m = *(const f32x4*)(mr + 60);
      a0 -= m[0] * x[60];
      a1 -= m[1] * x[61];
      a2 -= m[2] * x[62];
    }
    SOLVE_ROW_END(63)
    if (isw) { bf16_t* dW = c.W<bf16_t>(WS_DW);
#pragma unroll
        for (int i = 0; i < 64; ++i) dW[(ch * 64 + i) * 128 + col] = f2bf(x[i]);
    } else { bf16_t* dUT = c.W<bf16_t>(WS_DUT);
#pragma unroll
        for (int l0 = 0; l0 < 64; l0 += 8) { u32x4 a; a.x = pk2(x[l0], x[l0 + 1]); a.y = pk2(x[l0 + 2], x[l0 + 3]); a.z = pk2(x[l0 + 4], x[l0 + 5]); a.w = pk2(x[l0 + 6], x[l0 + 7]);
            *(u32x4*)(dUT + (ch * 128 + col) * 64 + l0) = a; } }
}

__device__ void ssd_mm(const Ctx& c, int ck, int g, int lb) {
    const bf16_t* sB = c.W<bf16_t>(WS_SB); const bf16_t* sC = c.W<bf16_t>(WS_SC); const float* sAcs = c.W<float>(WS_SACS); bf16_t* sMm = c.W<bf16_t>(WS_SMM);
    const int r = c.r, q = c.q, t0 = ck * 64;
    f32x4 cb[4];
#pragma unroll
    for (int sb = 0; sb < 4; ++sb) { f32x4 a = (f32x4){0.f, 0.f, 0.f, 0.f};
#pragma unroll
        for (int k0 = 0; k0 < 128; k0 += 32)
            a = mfma16(ldfrag(sB + (size_t)(t0 + sb * 16 + r) * 256 + g * 128 + k0 + q * 8), ldfrag(sC + (size_t)(t0 + lb * 16 + r) * 256 + g * 128 + k0 + q * 8), a);
        cb[sb] = a; }
    const int l = lb * 16 + r;
    for (int hh = 0; hh < 8; ++hh) { const int h = g * 8 + hh; const float* ac = sAcs + (size_t)(ck * 16 + h) * 64; const float al = ac[l];
#pragma unroll
        for (int sb = 0; sb < 4; ++sb) { const f32x4 as = *(const f32x4*)(ac + sb * 16 + 4 * q); f32x4 o;
#pragma unroll
            for (int j = 0; j < 4; ++j) { const int s = sb * 16 + 4 * q + j; o[j] = (s <= l) ? cb[sb][j] * __expf(al - as[j]) : 0.f; }
            *(u32x2*)(sMm + ((size_t)(ck * 16 + h) * 64 + l) * 64 + sb * 16 + 4 * q) = pk4(o); } }
}
__device__ void ssd_s1(const Ctx& c, int ck, int h) {
    const bf16_t* sXw = c.W<bf16_t>(WS_SXW); const bf16_t* sBT = c.W<bf16_t>(WS_SBT); bf16_t* sSt = c.W<bf16_t>(WS_SST);
    const int r = c.r, q = c.q, g = h >> 3; const size_t chh = (size_t)(ck * 16 + h);
    bf16x8 xw[4][2];
#pragma unroll
    for (int pb = 0; pb < 4; ++pb)
#pragma unroll
        for (int kk = 0; kk < 2; ++kk) xw[pb][kk] = ldfrag(sXw + (chh * 64 + pb * 16 + r) * 64 + kk * 32 + q * 8);
#pragma unroll
    for (int nb = 0; nb < 8; ++nb) { bf16x8 bt[2];
#pragma unroll
        for (int kk = 0; kk < 2; ++kk) bt[kk] = ldfrag(sBT + ((size_t)(ck * 2 + g) * 128 + nb * 16 + r) * 64 + kk * 32 + q * 8);
#pragma unroll
        for (int pb = 0; pb < 4; ++pb) { f32x4 a = (f32x4){0.f, 0.f, 0.f, 0.f};
#pragma unroll
            for (int kk = 0; kk < 2; ++kk) a = mfma16(bt[kk], xw[pb][kk], a);
            *(u32x2*)(sSt + (chh * 64 + pb * 16 + r) * 128 + nb * 16 + 4 * q) = pk4(a); } }
}
__device__ void gla_attn(const Ctx& c, int ck, int h, int ib) {
    const bf16_t* gQg = c.W<bf16_t>(WS_GQG); const bf16_t* gKn = c.W<bf16_t>(WS_GKN); bf16_t* gAtt = c.W<bf16_t>(WS_GATT);
    const int r = c.r, q = c.q; const size_t chh = (size_t)(ck * 4 + h); const int i = ib * 16 + r;
#pragma unroll
    for (int jb = 0; jb < 4; ++jb) { f32x4 a = (f32x4){0.f, 0.f, 0.f, 0.f};
        if (jb <= ib) {
#pragma unroll
            for (int k0 = 0; k0 < 128; k0 += 32)
                a = mfma16(ldfrag(gKn + (chh * 64 + jb * 16 + r) * 128 + k0 + q * 8), ldfrag(gQg + (chh * 64 + i) * 128 + k0 + q * 8), a);
        }
#pragma unroll
        for (int j = 0; j < 4; ++j) { const int jj = jb * 16 + 4 * q + j; if (jj > i) a[j] = 0.f; }
        *(u32x2*)(gAtt + (chh * 64 + i) * 64 + jb * 16 + 4 * q) = pk4(a); }
}
__device__ void gla_g1(const Ctx& c, int ck, int h, int vq) {
    const bf16_t* gVT = c.W<bf16_t>(WS_GVT); const bf16_t* gKnT = c.W<bf16_t>(WS_GKNT); bf16_t* gSt = c.W<bf16_t>(WS_GST); const float* gDec = c.W<float>(WS_GDEC);
    const int r = c.r, q = c.q; const size_t chh = (size_t)(ck * 4 + h);
    bf16x8 vt[4][2];
#pragma unroll
    for (int vb = 0; vb < 4; ++vb)
#pragma unroll
        for (int kk = 0; kk < 2; ++kk) vt[vb][kk] = ldfrag(gVT + (chh * 256 + (vq * 4 + vb) * 16 + r) * 64 + kk * 32 + q * 8);
#pragma unroll
    for (int kb = 0; kb < 8; ++kb) { bf16x8 kt[2];
#pragma unroll
        for (int kk = 0; kk < 2; ++kk) kt[kk] = ldfrag(gKnT + (chh * 128 + kb * 16 + r) * 64 + kk * 32 + q * 8);
        const f32x4 d = *(const f32x4*)(gDec + (size_t)ck * 512 + h * 128 + kb * 16 + 4 * q);
#pragma unroll
        for (int vb = 0; vb < 4; ++vb) { f32x4 a = (f32x4){0.f, 0.f, 0.f, 0.f};
#pragma unroll
            for (int kk = 0; kk < 2; ++kk) a = mfma16(kt[kk], vt[vb][kk], a);
            a = a * d;
            *(u32x2*)(gSt + (chh * 256 + (vq * 4 + vb) * 16 + r) * 128 + kb * 16 + 4 * q) = pk4(a); } }
}

__device__ void scan_ssd(const Ctx& c, int idx) {
    bf16_t* sSt = c.W<bf16_t>(WS_SST); const float* sAcs = c.W<float>(WS_SACS);
    const size_t e4 = (size_t)idx * 4; const int h = (int)(e4 >> 13);
    f32x4 S = (f32x4){0.f, 0.f, 0.f, 0.f};
#pragma unroll 4
    for (int ck = 0; ck < NCH; ++ck) { u32x2* ad = (u32x2*)(sSt + (size_t)ck * 131072 + e4);
        const f32x4 st = up4(__builtin_nontemporal_load(ad)); const float d = __expf(sAcs[(size_t)(ck * 16 + h) * 64 + 63]);
        __builtin_nontemporal_store(pk4(S), ad); S = S * d + st; }
}
__device__ void scan_gla(const Ctx& c, int idx) {
    bf16_t* gSt = c.W<bf16_t>(WS_GST); const float* gDec = c.W<float>(WS_GDEC);
    const size_t e4 = (size_t)idx * 4; const int h = (int)(e4 >> 15), k4 = (int)(e4 & 127);
    f32x4 S = (f32x4){0.f, 0.f, 0.f, 0.f};
#pragma unroll 4
    for (int ck = 0; ck < NCH; ++ck) { u32x2* ad = (u32x2*)(gSt + (size_t)ck * 131072 + e4);
        const f32x4 st = up4(__builtin_nontemporal_load(ad)); const f32x4 d = *(const f32x4*)(gDec + (size_t)ck * 512 + h * 128 + k4);
        __builtin_nontemporal_store(pk4(S), ad); S = S * d + st; }
}
struct DnStage { bf16x8 f[4]; u32x2 u; float gl; };
__device__ __forceinline__ void dn_stage_load(DnStage& S, const bf16_t* dW, const bf16_t* dUT, const bf16_t* dKdT, const float* dGl, int ck, int h, int vs, int wave, int r, int q) {
    const int cc = ck < NCH ? ck : NCH - 1; const size_t ch = (size_t)(cc * 8 + h);
    if (wave < 4) {
#pragma unroll
        for (int kk = 0; kk < 4; ++kk) S.f[kk] = ldfrag(dW + (ch * 64 + wave * 16 + r) * 128 + kk * 32 + q * 8);
        S.u = *(const u32x2*)(dUT + (ch * 128 + vs * 16 + r) * 64 + wave * 16 + 4 * q);
    } else {
#pragma unroll
        for (int t = 0; t < 2; ++t)
#pragma unroll
            for (int kk = 0; kk < 2; ++kk) S.f[t * 2 + kk] = ldfrag(dKdT + (ch * 128 + ((wave - 4) * 2 + t) * 16 + r) * 64 + kk * 32 + q * 8);
        S.gl = dGl[ch];
    }
}
__device__ __forceinline__ void dn_step(const DnStage& S, f32x4 (&Sacc)[2], bf16_t* ST, bf16_t* VN, bf16_t* dVnT, bf16_t* dST, int ck, int h, int vs, int wave, int r, int q) {
    const size_t ch = (size_t)(ck * 8 + h);
    if (wave < 4) {
        bf16x8 sf[4];
#pragma unroll
        for (int kk = 0; kk < 4; ++kk) sf[kk] = *(const bf16x8*)(ST + r * 136 + kk * 32 + q * 8);
        f32x4 a = (f32x4){0.f, 0.f, 0.f, 0.f};
#pragma unroll
        for (int kk = 0; kk < 4; ++kk) a = mfma16(S.f[kk], sf[kk], a);
        const f32x4 vn = up4(S.u) - a; const u32x2 pv = pk4(vn);
        *(u32x2*)(VN + r * 72 + wave * 16 + 4 * q) = pv;
        *(u32x2*)(dVnT + (ch * 128 + vs * 16 + r) * 64 + wave * 16 + 4 * q) = pv;
    }
    asm volatile("s_waitcnt lgkmcnt(0)" ::: "memory"); __builtin_amdgcn_s_barrier(); asm volatile("" ::: "memory");
    if (wave >= 4) {
        bf16x8 vf[2];
#pragma unroll
        for (int kk = 0; kk < 2; ++kk) vf[kk] = *(const bf16x8*)(VN + r * 72 + kk * 32 + q * 8);
#pragma unroll
        for (int t = 0; t < 2; ++t) { const int kb = (wave - 4) * 2 + t;
            f32x4 a = Sacc[t] * S.gl;
#pragma unroll
            for (int kk = 0; kk < 2; ++kk) a = mfma16(S.f[t * 2 + kk], vf[kk], a);
            Sacc[t] = a; const u32x2 ps = pk4(a);
            *(u32x2*)(ST + r * 136 + kb * 16 + 4 * q) = ps;
            if (ck + 1 < NCH) *(u32x2*)(dST + (((size_t)(ck + 1) * 8 + h) * 128 + vs * 16 + r) * 128 + kb * 16 + 4 * q) = ps; }
    }
    asm volatile("s_waitcnt lgkmcnt(0)" ::: "memory"); __builtin_amdgcn_s_barrier(); asm volatile("" ::: "memory");
}
__device__ void dn_seq(const Ctx& c, int h, int vs) {
    const bf16_t* dW = c.W<bf16_t>(WS_DW); const bf16_t* dUT = c.W<bf16_t>(WS_DUT); const bf16_t* dKdT = c.W<bf16_t>(WS_DKDT); const float* dGl = c.W<float>(WS_DGL);
    bf16_t* dVnT = c.W<bf16_t>(WS_DVNT); bf16_t* dST = c.W<bf16_t>(WS_DST);
    bf16_t* ST = (bf16_t*)c.ldsf; bf16_t* VN = ST + 16 * 136;
    const int wave = c.wave, r = c.r, q = c.q;
    f32x4 Sacc[2]; Sacc[0] = (f32x4){0.f, 0.f, 0.f, 0.f}; Sacc[1] = Sacc[0];
    __syncthreads();
    { u32x2 z; z.x = 0u; z.y = 0u; *(u32x2*)(ST + r * 136 + wave * 16 + 4 * q) = z;
      *(u32x2*)(dST + ((size_t)h * 128 + vs * 16 + r) * 128 + wave * 16 + 4 * q) = z; }
    __syncthreads();
    DnStage s0, s1, s2, s3, s4, s5;
#define DL(S, cc) dn_stage_load(S, dW, dUT, dKdT, dGl, cc, h, vs, wave, r, q)
#define DS(S, cc) dn_step(S, Sacc, ST, VN, dVnT, dST, cc, h, vs, wave, r, q)
    DL(s0, 0); DL(s1, 1); DL(s2, 2); DL(s3, 3); DL(s4, 4);
    for (int ck = 0; ck < 126; ck += 6) {
        DL(s5, ck + 5);  DS(s0, ck);
        DL(s0, ck + 6);  DS(s1, ck + 1);
        DL(s1, ck + 7);  DS(s2, ck + 2);
        DL(s2, ck + 8);  DS(s3, ck + 3);
        DL(s3, ck + 9);  DS(s4, ck + 4);
        DL(s4, ck + 10); DS(s5, ck + 5);
    }
    DS(s0, 126); DS(s1, 127);
#undef DL
#undef DS
}

__device__ void dn_d3(const Ctx& c, int ck, int h, int ib) {
    const bf16_t* proj = c.W<bf16_t>(WS_PROJ);
    const bf16_t* dQg = c.W<bf16_t>(WS_DQG); const bf16_t* dAtt = c.W<bf16_t>(WS_DATT); const bf16_t* dST = c.W<bf16_t>(WS_DST); const bf16_t* dVnT = c.W<bf16_t>(WS_DVNT);
    bf16_t* y = c.W<bf16_t>(WS_YBR);
    const int r = c.r, q = c.q, i = ib * 16 + r, t = ck * 64 + i; const size_t ch = (size_t)(ck * 8 + h);
    bf16x8 bq[4], ba[2];
#pragma unroll
    for (int kk = 0; kk < 4; ++kk) bq[kk] = ldfrag(dQg + (ch * 64 + i) * 128 + kk * 32 + q * 8);
#pragma unroll
    for (int kk = 0; kk < 2; ++kk) ba[kk] = ldfrag(dAtt + (ch * 64 + i) * 64 + kk * 32 + q * 8);
    f32x4 acc[8]; float ss = 0.f;
    bf16x8 fa[2][6];
#pragma unroll
    for (int kk = 0; kk < 4; ++kk) fa[0][kk] = ldfrag(dST + (ch * 128 + r) * 128 + kk * 32 + q * 8);
#pragma unroll
    for (int kk = 0; kk < 2; ++kk) fa[0][4 + kk] = ldfrag(dVnT + (ch * 128 + r) * 64 + kk * 32 + q * 8);
#pragma unroll
    for (int vb = 0; vb < 8; ++vb) { f32x4 a = (f32x4){0.f, 0.f, 0.f, 0.f};
        if (vb + 1 < 8) {
#pragma unroll
            for (int kk = 0; kk < 4; ++kk) fa[(vb + 1) & 1][kk] = ldfrag(dST + (ch * 128 + (vb + 1) * 16 + r) * 128 + kk * 32 + q * 8);
#pragma unroll
            for (int kk = 0; kk < 2; ++kk) fa[(vb + 1) & 1][4 + kk] = ldfrag(dVnT + (ch * 128 + (vb + 1) * 16 + r) * 64 + kk * 32 + q * 8); }
#pragma unroll
        for (int kk = 0; kk < 4; ++kk) a = mfma16(fa[vb & 1][kk], bq[kk], a);
#pragma unroll
        for (int kk = 0; kk < 2; ++kk) a = mfma16(fa[vb & 1][4 + kk], ba[kk], a);
        acc[vb] = a; ss += (a[0] * a[0] + a[1] * a[1]) + (a[2] * a[2] + a[3] * a[3]); }
    ss += __shfl_xor(ss, 16); ss += __shfl_xor(ss, 32);
    const float rn = rsqrtf(ss * (1.0f / 128.0f) + EPS);
    const float* nw = c.in(I_DNNORM) + c.layer * 128;
#pragma unroll
    for (int vb = 0; vb < 8; ++vb) { const int v0 = vb * 16 + 4 * q;
        const f32x4 g = up4(*(const u32x2*)(proj + (size_t)t * NP + C_DNG + h * 128 + v0)); const f32x4 w = *(const f32x4*)(nw + v0); f32x4 o;
#pragma unroll
        for (int j = 0; j < 4; ++j) o[j] = acc[vb][j] * rn * w[j] * siluf_(g[j]);
        *(u32x2*)(y + (size_t)t * 1024 + h * 128 + v0) = pk4(o); }
}
__device__ void ssd_s3(const Ctx& c, int ck, int g) {
    const bf16_t* proj = c.W<bf16_t>(WS_PROJ);
    const bf16_t* sC = c.W<bf16_t>(WS_SC); const bf16_t* sMm = c.W<bf16_t>(WS_SMM); const bf16_t* sSt = c.W<bf16_t>(WS_SST); const bf16_t* sXdT = c.W<bf16_t>(WS_SXDT);
    const bf16_t* sX = c.W<bf16_t>(WS_SX); const float* sAcs = c.W<float>(WS_SACS);
    bf16_t* y = c.W<bf16_t>(WS_YBR) + (size_t)T * 1024;
    const int r = c.r, q = c.q, lb = c.wave & 3, hq = c.wave >> 2, l = lb * 16 + r, t = ck * 64 + l;
    float* ssx = c.ldsf;
    bf16x8 bc[4];
#pragma unroll
    for (int kk = 0; kk < 4; ++kk) bc[kk] = ldfrag(sC + (size_t)t * 256 + g * 128 + kk * 32 + q * 8);
    f32x4 acc[4][4]; float ss = 0.f;
#pragma unroll
    for (int hh = 0; hh < 4; ++hh) { const int h = g * 8 + hq * 4 + hh; const size_t chh = (size_t)(ck * 16 + h);
        const float el = __expf(sAcs[chh * 64 + l]); const float dsk = c.in(I_SD)[c.layer * 16 + h];
        bf16x8 bm[2];
#pragma unroll
        for (int kk = 0; kk < 2; ++kk) bm[kk] = ldfrag(sMm + (chh * 64 + l) * 64 + kk * 32 + q * 8);
#pragma unroll
        for (int p2 = 0; p2 < 4; p2 += 2) {
            bf16x8 fs[2][4], fx[2][2]; u32x2 xr[2], zr[2];
#pragma unroll
            for (int t = 0; t < 2; ++t) { const int pb = p2 + t;
#pragma unroll
                for (int kk = 0; kk < 4; ++kk) fs[t][kk] = ldfrag(sSt + (chh * 64 + pb * 16 + r) * 128 + kk * 32 + q * 8);
#pragma unroll
                for (int kk = 0; kk < 2; ++kk) fx[t][kk] = ldfrag(sXdT + (chh * 64 + pb * 16 + r) * 64 + kk * 32 + q * 8);
                xr[t] = *(const u32x2*)(sX + (size_t)t * 0 + (size_t)(ck * 64 + l) * 1024 + h * 64 + pb * 16 + 4 * q);
                zr[t] = *(const u32x2*)(proj + (size_t)(ck * 64 + l) * NP + C_SZ + h * 64 + pb * 16 + 4 * q); }
            asm volatile("" ::: "memory");
#pragma unroll
            for (int t = 0; t < 2; ++t) { const int pb = p2 + t; f32x4 a = (f32x4){0.f, 0.f, 0.f, 0.f};
#pragma unroll
                for (int kk = 0; kk < 4; ++kk) a = mfma16(fs[t][kk], bc[kk], a);
                a = a * el;
#pragma unroll
                for (int kk = 0; kk < 2; ++kk) a = mfma16(fx[t][kk], bm[kk], a);
                const f32x4 xv = up4(xr[t]), zv = up4(zr[t]);
#pragma unroll
                for (int j = 0; j < 4; ++j) { a[j] = (a[j] + dsk * xv[j]) * siluf_(zv[j]); ss += a[j] * a[j]; }
                acc[hh][pb] = a; } } }
    ss += __shfl_xor(ss, 16); ss += __shfl_xor(ss, 32);
    __syncthreads();
    if (q == 0) ssx[l * 2 + hq] = ss;
    __syncthreads();
    const float rn = rsqrtf((ssx[l * 2] + ssx[l * 2 + 1]) * (1.0f / 512.0f) + EPS);
    const float* nw = c.in(I_SNORM) + c.layer * 1024 + g * 512;
    f32x4 wn[4][4];
#pragma unroll
    for (int hh = 0; hh < 4; ++hh)
#pragma unroll
        for (int pb = 0; pb < 4; ++pb) wn[hh][pb] = *(const f32x4*)(nw + (hq * 4 + hh) * 64 + pb * 16 + 4 * q);
    asm volatile("" ::: "memory");
#pragma unroll
    for (int hh = 0; hh < 4; ++hh)
#pragma unroll
        for (int pb = 0; pb < 4; ++pb) { const int p0 = pb * 16 + 4 * q, hl = hq * 4 + hh;
            const f32x4 o = acc[hh][pb] * rn * wn[hh][pb];
            *(u32x2*)(y + (size_t)t * 1024 + (g * 8 + hl) * 64 + p0) = pk4(o); }
}
__device__ void gla_g3(const Ctx& c, int ck, int h, int ib) {
    const bf16_t* proj = c.W<bf16_t>(WS_PROJ);
    const bf16_t* gQg = c.W<bf16_t>(WS_GQG); const bf16_t* gAtt = c.W<bf16_t>(WS_GATT); const bf16_t* gSt = c.W<bf16_t>(WS_GST); const bf16_t* gVT = c.W<bf16_t>(WS_GVT);
    bf16_t* y = c.W<bf16_t>(WS_YBR) + (size_t)2 * T * 1024;
    const int r = c.r, q = c.q, i = ib * 16 + r, t = ck * 64 + i; const size_t chh = (size_t)(ck * 4 + h);
    bf16x8 bq[4], ba[2];
#pragma unroll
    for (int kk = 0; kk < 4; ++kk) bq[kk] = ldfrag(gQg + (chh * 64 + i) * 128 + kk * 32 + q * 8);
#pragma unroll
    for (int kk = 0; kk < 2; ++kk) ba[kk] = ldfrag(gAtt + (chh * 64 + i) * 64 + kk * 32 + q * 8);
    f32x4 acc[16]; float ss = 0.f;
    bf16x8 fa[2][6];
#pragma unroll
    for (int kk = 0; kk < 4; ++kk) fa[0][kk] = ldfrag(gSt + (chh * 256 + r) * 128 + kk * 32 + q * 8);
#pragma unroll
    for (int kk = 0; kk < 2; ++kk) fa[0][4 + kk] = ldfrag(gVT + (chh * 256 + r) * 64 + kk * 32 + q * 8);
#pragma unroll
    for (int vb = 0; vb < 16; ++vb) { f32x4 a = (f32x4){0.f, 0.f, 0.f, 0.f};
        if (vb + 1 < 16) {
#pragma unroll
            for (int kk = 0; kk < 4; ++kk) fa[(vb + 1) & 1][kk] = ldfrag(gSt + (chh * 256 + (vb + 1) * 16 + r) * 128 + kk * 32 + q * 8);
#pragma unroll
            for (int kk = 0; kk < 2; ++kk) fa[(vb + 1) & 1][4 + kk] = ldfrag(gVT + (chh * 256 + (vb + 1) * 16 + r) * 64 + kk * 32 + q * 8); }
#pragma unroll
        for (int kk = 0; kk < 4; ++kk) a = mfma16(fa[vb & 1][kk], bq[kk], a);
#pragma unroll
        for (int kk = 0; kk < 2; ++kk) a = mfma16(fa[vb & 1][4 + kk], ba[kk], a);
        acc[vb] = a; ss += (a[0] * a[0] + a[1] * a[1]) + (a[2] * a[2] + a[3] * a[3]); }
    ss += __shfl_xor(ss, 16); ss += __shfl_xor(ss, 32);
    const float rn = rsqrtf(ss * (1.0f / 256.0f) + EPS);
    const float* nw = c.in(I_GNORM) + c.layer * 256;
#pragma unroll
    for (int vb = 0; vb < 16; ++vb) { const int v0 = vb * 16 + 4 * q;
        const f32x4 g = up4(*(const u32x2*)(proj + (size_t)t * NP + C_GO + h * 256 + v0)); const f32x4 w = *(const f32x4*)(nw + v0); f32x4 o;
#pragma unroll
        for (int j = 0; j < 4; ++j) o[j] = acc[vb][j] * rn * w[j] * siluf_(g[j]);
        *(u32x2*)(y + (size_t)t * 1024 + h * 256 + v0) = pk4(o); }
}

constexpr int PH_PER_LAYER = 10, N_PHASES = 2 * PH_PER_LAYER + 1;

__device__ __forceinline__ void run_phase(int ph, unsigned char* ldsraw) {
    const __attribute__((address_space(4))) Params* Pk = (const __attribute__((address_space(4))) Params*)__builtin_amdgcn_kernarg_segment_ptr();
    asm volatile("" : "+s"(Pk));
    int bid_ = blockIdx.x, nb_ = gridDim.x, tid_ = threadIdx.x; asm volatile("" : "+s"(bid_), "+s"(nb_), "+v"(tid_));
    Ctx c; c.P = Pk; c.layer = ph == 0 ? 0 : (ph - 1) / PH_PER_LAYER; c.bid = bid_; c.nb = nb_; c.tid = tid_; c.wave = __builtin_amdgcn_readfirstlane(c.tid >> 6); c.lane = c.tid & 63;
    c.r = c.lane & 15; c.q = c.lane >> 4; c.gw = c.bid * 8 + c.wave; c.nw = c.nb * 8; c.ws = Pk->ws; c.ldsf = (float*)ldsraw;
    LAS unsigned char* lds3 = (LAS unsigned char*)ldsraw;
    const int L = c.layer;
    const int lp = ph == 0 ? -1 : (ph - 1) % PH_PER_LAYER;
    float* xio = Pk->out; float* gout = c.W<float>(WS_GOUT); bf16_t* hb = c.W<bf16_t>(WS_HB);
    pg8::RowStats stA{c.W<float>(WS_SLOTA), c.W<unsigned>(WS_CNTA), 0u}, stB{c.W<float>(WS_SLOTB), c.W<unsigned>(WS_CNTB), 0u};
    switch (lp) {
    case -1: {
        row_phase(c.in(I_X), xio, nullptr, nullptr, nullptr, c.in(I_PREMIX), hb, 2, c.gw, c.nw);
        const float* p = c.in(I_P); bf16_t* pb = c.W<bf16_t>(WS_PB); const size_t n4 = (size_t)2 * T * 256 / 4;
        for (size_t i = (size_t)c.bid * 512 + c.tid; i < n4; i += (size_t)c.nb * 512) { const f32x4 v = __builtin_nontemporal_load((const f32x4*)(p + i * 4)); *(u32x2*)(pb + i * 4) = pk4(v); }
        convT(c.in(I_WIN), 2048, INT, c.W<bf16_t>(WS_WIN), NP, c.ldsf, c.bid, c.nb);
    } break;
    case 0: {
        pg8::Gemm g{hb, c.W<bf16_t>(L == 0 ? WS_WIN : WS_WIN1), T, NP, 2048, 0, 0}; pg8::StaticOrder S; S.init(T, NP, c.nb, c.bid);
        pg8::EpiBf16<0> E{c.W<bf16_t>(WS_PROJ), NP};
        pg8::gemm_phase(lds3, g, S, E);
    } break;
    case 1: {
        for (int cb0 = c.bid; cb0 < 256; cb0 += c.nb) { int cb = cb0; asm volatile("" : "+s"(cb));
            { int t2 = c.tid; asm volatile("" : "+v"(t2)); c.tid = t2; c.wave = __builtin_amdgcn_readfirstlane(t2 >> 6); c.lane = t2 & 63; c.r = c.lane & 15; c.q = c.lane >> 4; }
            const int ck = cb >> 1, half = cb & 1;
            prep_dn_chunk(c, ck, half);
            prep_ssd(c, ck, half);
            prep_ssd(c, ck, 2 + half);
            prep_gla(c, ck, 10 + half);
            prep_gla(c, ck, 1 + half);
            __syncthreads();
            dn_d1(c, ck * 4 + half * 2); dn_d1(c, ck * 4 + half * 2 + 1);
            if (c.wave < 4) ssd_mm(c, ck, half, c.wave);
            ssd_s1(c, ck, half * 8 + c.wave);
            gla_attn(c, ck, half * 2 + (c.wave >> 2), c.wave & 3);
            gla_g1(c, ck, half * 2 + (c.wave >> 2), c.wave & 3);
            __syncthreads();
        }
    } break;
    case 2: break;
    case 3: {
        if (c.bid < 64) { dn_seq(c, c.bid & 7, c.bid >> 3);
#if PROBE == 2
            dn_seq(c, c.bid & 7, c.bid >> 3);
#endif
        }
        else { const int nbs = c.nb - 64, b2 = c.bid - 64;
            for (int idx = b2 * 512 + c.tid; idx < 65536; idx += nbs * 512) { if (idx < 32768) scan_ssd(c, idx); else scan_gla(c, idx - 32768); }
            float* tile = c.ldsf;
            for (int b = 0; b < 3; ++b) convT(c.in(I_WBR) + ((size_t)L * 3 + b) * 1024 * 2048, 1024, 2048, c.W<bf16_t>(WS_WBR) + (size_t)b * 2048 * 1024, 2048, tile, b2, nbs);
            convT(c.in(I_WOUT) + (size_t)L * 2048 * 2048, 2048, 2048, c.W<bf16_t>(WS_WOUT), 2048, tile, b2, nbs);
            convT(c.in(I_WUP) + (size_t)L * 2048 * 8192, 2048, 8192, c.W<bf16_t>(WS_WUP), 8192, tile, b2, nbs);
            convT(c.in(I_WDN) + (size_t)L * 8192 * 2048, 8192, 2048, c.W<bf16_t>(WS_WDN), 2048, tile, b2, nbs);
            convT(c.in(I_WPG) + (size_t)L * 2048 * 2048, 2048, 2048, c.W<bf16_t>(WS_WPG), 2048, tile, b2, nbs);
            convT(c.in(I_WPP) + (size_t)L * 256 * 2048, 256, 2048, c.W<bf16_t>(WS_WPP), 2048, tile, b2, nbs);
            if (L == 0) convT(c.in(I_WIN) + (size_t)2048 * INT, 2048, INT, c.W<bf16_t>(WS_WIN1), NP, tile, b2, nbs);
        }
    } break;
    case 4: {
        for (int it = c.bid; it < 256; it += c.nb) ssd_s3(c, it >> 1, it & 1);
        for (int it = c.gw; it < 4096; it += c.nw) dn_d3(c, it >> 5, (it >> 2) & 7, it & 3);
        for (int it = c.gw; it < 2048; it += c.nw) gla_g3(c, it >> 4, (it >> 2) & 3, it & 3);
    } break;
    case 5: {
        pg8::StackOrder<3> S; S.init(T, 2048, c.nb, c.bid);
        pg8::Gemm g{c.W<bf16_t>(WS_YBR), c.W<bf16_t>(WS_WBR), T, 2048, 1024, (size_t)T * 1024 * 2, (size_t)2048 * 1024 * 2};
        pg8::EpiBranch E{gout, c.W<bf16_t>(WS_MIXB), c.W<bf16_t>(WS_PROJ)}; pg8::gemm_phase(lds3, g, S, E);
    } break;
    case 6: {
        pg8::Gemm g{c.W<bf16_t>(WS_MIXB), c.W<bf16_t>(WS_WOUT), T, 2048, 2048, 0, 0}; pg8::StaticOrder S; S.init(T, 2048, c.nb, c.bid);
        stA.want = 64u * (unsigned)(3 * L + 1); stB.want = stA.want;
        pg8::EpiRowFused<0, 1> E{L == 0 ? c.in(I_X) : (const float*)xio, xio, hb, nullptr, c.in(I_POSTMIX) + L * 2048, c.in(I_PREMLP) + L * 2048, stA, stB}; pg8::gemm_phase(lds3, g, S, E);
    } break;
    case 7: {
        pg8::Gemm g{hb, c.W<bf16_t>(WS_WUP), T, DFF, 2048, 0, 0}; pg8::StaticOrder S; S.init(T, DFF, c.nb, c.bid);
        pg8::EpiBf16<1> E{c.W<bf16_t>(WS_PROJ), DFF}; pg8::gemm_phase(lds3, g, S, E);
    } break;
    case 8: {
        { pg8::Gemm g{c.W<bf16_t>(WS_PROJ), c.W<bf16_t>(WS_WDN), T, 2048, DFF, 0, 0}; pg8::StaticOrder S; S.init(T, 2048, c.nb, c.bid);
          stA.want = 64u * (unsigned)(3 * L + 2); stB.want = stA.want;
          pg8::EpiRowFused<0, 1> E{xio, xio, hb, nullptr, c.in(I_POSTMLP) + L * 2048, c.in(I_PLEPRE) + L * 2048, stA, stB}; pg8::gemm_phase(lds3, g, S, E); }
        { pg8::Gemm g{c.W<bf16_t>(WS_PB) + (size_t)L * T * 256, c.W<bf16_t>(WS_WPP), T, 2048, 256, 0, 0}; pg8::StaticOrder S; S.init(T, 2048, c.nb, c.bid);
          pg8::EpiBf16<0> E{c.W<bf16_t>(WS_PP), 2048}; pg8::gemm_phase(lds3, g, S, E); }
    } break;
    case 9: {
        pg8::Gemm g{hb, c.W<bf16_t>(WS_WPG), T, 2048, 2048, 0, 0}; pg8::StaticOrder S; S.init(T, 2048, c.nb, c.bid);
        stA.want = 64u * (unsigned)(3 * L + 3); stB.want = stA.want;
        if (L == 0) { pg8::EpiRowFused<1, 1> E{xio, xio, hb, c.W<bf16_t>(WS_PP), c.in(I_PLEPOST), c.in(I_PREMIX) + 2048, stA, stB}; pg8::gemm_phase(lds3, g, S, E); }
        else { pg8::EpiRowFused<1, 0> E{xio, xio, hb, c.W<bf16_t>(WS_PP), c.in(I_PLEPOST) + 2048, nullptr, stA, stB}; pg8::gemm_phase(lds3, g, S, E); }
    } break;
    }
}

__global__ void __launch_bounds__(512, 2) mega(Params P, int ph_lo, int ph_hi) {
    extern __shared__ __attribute__((aligned(16))) unsigned char lds[];
    cg::grid_group grid = cg::this_grid();
    if (ph_lo < 0) grid.sync();
    volatile LAS unsigned* st = (volatile LAS unsigned*)((LAS unsigned char*)lds + 131072);
    if (threadIdx.x < 4) st[threadIdx.x] = 0u;
    __syncthreads();
    XcdBarrier bar = xcd_barrier_post((unsigned*)(P.ws + WS_BAR), st);
    for (int ph = ph_lo; ph < ph_hi; ++ph) {
        run_phase(ph, lds);
#if PROBE >= 20
        if (ph >= 1 && (ph - 1) % PH_PER_LAYER == PROBE - 20) { xcd_barrier(bar); run_phase(ph, lds); }
#endif
        if (ph + 1 < ph_hi && !(ph >= 1 && (ph - 1) % PH_PER_LAYER == 2)) xcd_barrier(bar);
    }
}

extern "C" void kernel_launch(void* const* d_in, const int* in_sizes, int n_in, void* d_out, int out_size, void* d_ws, size_t ws_size, hipStream_t stream) {
    static int grid = 0;
    constexpr int LDS_BYTES = 131072 + 64;
    if (grid == 0) {
        if (ws_size < WS_TOTAL) { fprintf(stderr, "kernel_launch: workspace too small: %zu < %zu\n", ws_size, (size_t)WS_TOTAL); grid = -1; return; }
        int dev = 0, cus = 0, per_cu = 0;
        hipGetDevice(&dev); hipDeviceGetAttribute(&cus, hipDeviceAttributeMultiprocessorCount, dev);
        if (hipFuncSetAttribute((const void*)mega, hipFuncAttributeMaxDynamicSharedMemorySize, LDS_BYTES) != hipSuccess) { fprintf(stderr, "hipFuncSetAttribute failed\n"); grid = -1; return; }
        hipOccupancyMaxActiveBlocksPerMultiprocessor(&per_cu, (const void*)mega, 512, LDS_BYTES);
        if (per_cu < 1) { fprintf(stderr, "occupancy query says %d blocks per CU\n", per_cu); per_cu = 1; }
        (void)hipGetLastError();
        grid = cus;
    }
    if (grid < 0) return;
    Params P{};
    for (int i = 0; i < 28; ++i) P.in[i] = (const float*)d_in[i];
    P.out = (float*)d_out; P.ws = (unsigned char*)d_ws;
    (void)hipMemsetAsync((unsigned char*)d_ws + WS_BAR, 0, 32768, stream);
#if SINGLE_LAUNCH
    { int lo = 0, hi = N_PHASES; void* args[] = {&P, &lo, &hi};
      hipError_t e = hipLaunchCooperativeKernel((const void*)mega, dim3(grid), dim3(512), args, LDS_BYTES, stream);
      if (e != hipSuccess) fprintf(stderr, "cooperative launch failed: %s\n", hipGetErrorString(e)); }
#else
    for (int ph = 0; ph < N_PHASES; ++ph) { int lo = ph, hi = ph + 1; void* args[] = {&P, &lo, &hi};
        hipError_t e = hipLaunchCooperativeKernel((const void*)mega, dim3(grid), dim3(512), args, LDS_BYTES, stream);
        if (e != hipSuccess) { fprintf(stderr, "cooperative launch failed: %s\n", hipGetErrorString(e)); break; } }
#endif
}
```

```cpp
#include <hip/hip_runtime.h>
#include <hip/hip_cooperative_groups.h>
#include <cstdio>
namespace cg = cooperative_groups;

#ifndef PROBE
#define PROBE 0
#endif
#ifndef SINGLE_LAUNCH
#define SINGLE_LAUNCH 1
#endif

#define LAS __attribute__((address_space(3)))
typedef unsigned short bf16_t;
typedef short bf16x8 __attribute__((ext_vector_type(8)));
typedef float f32x4 __attribute__((ext_vector_type(4)));
typedef unsigned u32x4 __attribute__((ext_vector_type(4)));
typedef unsigned u32x2 __attribute__((ext_vector_type(2)));

constexpr int T = 8192, DM = 2048, NP = 16128, INT = 15920, DFF = 8192, PLE = 256;
constexpr int NCH = 128;
constexpr float EPS = 1e-6f;
constexpr int C_DNQ = 0, C_DNB = 3072, C_DNA = 3080, C_DNG = 3088;
constexpr int C_SZ = 4112, C_SX = 5136, C_SDT = 6672;
constexpr int C_GQ = 6688, C_GK = 7200, C_GV = 7712, C_GLR = 8736, C_GO = 8752, C_BR = 9776;

constexpr size_t al256(size_t x) { return (x + 255) & ~(size_t)255; }
constexpr size_t WS_WIN = 0;
constexpr size_t WS_WBR = WS_WIN + (size_t)NP * 2048 * 2;
constexpr size_t WS_WOUT = WS_WBR + (size_t)3 * 2048 * 1024 * 2;
constexpr size_t WS_WUP = WS_WOUT + (size_t)2048 * 2048 * 2;
constexpr size_t WS_WDN = WS_WUP + (size_t)8192 * 2048 * 2;
constexpr size_t WS_WPG = WS_WDN + (size_t)2048 * 8192 * 2;
constexpr size_t WS_WPP = WS_WPG + (size_t)2048 * 2048 * 2;
constexpr size_t WS_PROJ = WS_WPP + (size_t)2048 * 256 * 2;
constexpr size_t WS_HB = WS_PROJ + (size_t)T * NP * 2;
constexpr size_t WS_PB = WS_HB + (size_t)T * 2048 * 2;
constexpr size_t WS_YBR = WS_PB + (size_t)2 * T * 256 * 2;
constexpr size_t WS_SSP = WS_YBR + (size_t)3 * T * 1024 * 2;
constexpr size_t WS_MIX = WS_SSP + (size_t)T * 32 * 4;
constexpr size_t E16 = (size_t)T * 1024 * 2;
constexpr size_t WS_DQ = WS_MIX, WS_DK = WS_DQ + E16, WS_DV = WS_DK + E16, WS_DW = WS_DV + E16, WS_DUT = WS_DW + E16, WS_DKDT = WS_DUT + E16,
                 WS_DQG = WS_DKDT + E16, WS_DATT = WS_DQG + E16, WS_DVNT = WS_DATT + E16 / 2, WS_DST = WS_DVNT + E16, WS_DGL = WS_DST + 2 * E16;
constexpr size_t WS_SX = WS_DGL + 4096, WS_SXDT = WS_SX + E16, WS_SXW = WS_SXDT + E16, WS_SB = WS_SXW + E16, WS_SC = WS_SB + E16 / 4, WS_SBT = WS_SC + E16 / 4,
                 WS_SMM = WS_SBT + E16 / 4, WS_SST = WS_SMM + E16, WS_SACS = WS_SST + 2 * E16;
constexpr size_t WS_GQG = WS_SACS + (size_t)NCH * 16 * 64 * 4, WS_GKN = WS_GQG + E16 / 2, WS_GKNT = WS_GKN + E16 / 2, WS_GVT = WS_GKNT + E16 / 2, WS_GATT = WS_GVT + E16,
                 WS_GST = WS_GATT + E16 / 4, WS_GDEC = WS_GST + 2 * E16;
constexpr size_t WS_END = WS_GDEC + (size_t)NCH * 512 * 4;
constexpr size_t WS_GOUT = WS_MIX;
constexpr size_t WS_MIXB = WS_GOUT + (size_t)T * 2048 * 4;
constexpr size_t WS_PP = WS_MIXB + (size_t)T * 2048 * 2;
constexpr size_t WS_GOUTB = WS_PP + (size_t)T * 2048 * 2;
static_assert(WS_GOUTB + (size_t)T * 2048 * 2 <= WS_END, "alias region");
constexpr size_t WS_BAR = (WS_END + 255) & ~(size_t)255;
constexpr size_t WS_CNTA = WS_BAR + 16384, WS_CNTB = WS_CNTA + 8192, WS_SLOTA = WS_CNTB + 8192, WS_SLOTB = WS_SLOTA + 262144;
constexpr size_t WS_WIN1 = WS_SLOTB + 262144;
constexpr size_t WS_TOTAL = WS_WIN1 + (size_t)NP * 2048 * 2;

struct Params {
    const float* in[28];
    float* out;
    unsigned char* ws;
};

__device__ __forceinline__ float bf2f(bf16_t b) { return __uint_as_float(((unsigned)b) << 16); }
typedef __bf16 bf16v2_t __attribute__((ext_vector_type(2)));
typedef float f32v2_t __attribute__((ext_vector_type(2)));
__device__ __forceinline__ bf16_t f2bf(float f) { const __bf16 b = (__bf16)f; return __builtin_bit_cast(unsigned short, b); }
__device__ __forceinline__ unsigned pk2(float lo, float hi) { const f32v2_t v = {lo, hi}; const bf16v2_t b = __builtin_convertvector(v, bf16v2_t); return __builtin_bit_cast(unsigned, b); }
__device__ __forceinline__ float lo16(unsigned u) { return __uint_as_float(u << 16); }
__device__ __forceinline__ float hi16(unsigned u) { return __uint_as_float(u & 0xffff0000u); }
__device__ __forceinline__ u32x2 pk4(f32x4 v) { u32x2 r; r.x = pk2(v[0], v[1]); r.y = pk2(v[2], v[3]); return r; }
__device__ __forceinline__ f32x4 up4(u32x2 u) { return (f32x4){lo16(u.x), hi16(u.x), lo16(u.y), hi16(u.y)}; }
__device__ __forceinline__ float sigmoidf_(float x) { return __builtin_amdgcn_rcpf(1.0f + __expf(-x)); }
__device__ __forceinline__ float siluf_(float x) { return x * __builtin_amdgcn_rcpf(1.0f + __expf(-x)); }
__device__ __forceinline__ float softplusf_(float x) { return fmaxf(x, 0.f) + __logf(1.0f + __expf(-fabsf(x))); }
__device__ __forceinline__ f32x4 mfma16(bf16x8 a, bf16x8 b, f32x4 c) { return __builtin_amdgcn_mfma_f32_16x16x32_bf16(a, b, c, 0, 0, 0); }
__device__ __forceinline__ bf16x8 ldfrag(const bf16_t* p) { return *(const bf16x8*)p; }
__device__ __forceinline__ unsigned cvt_pk_bf16(float lo, float hi) { return pk2(lo, hi); }


#define PIN16(a, o) asm volatile("" : "+v"(a[(o)+0]), "+v"(a[(o)+1]), "+v"(a[(o)+2]), "+v"(a[(o)+3]), "+v"(a[(o)+4]), "+v"(a[(o)+5]), "+v"(a[(o)+6]), "+v"(a[(o)+7]), \
    "+v"(a[(o)+8]), "+v"(a[(o)+9]), "+v"(a[(o)+10]), "+v"(a[(o)+11]), "+v"(a[(o)+12]), "+v"(a[(o)+13]), "+v"(a[(o)+14]), "+v"(a[(o)+15]))

#define XB_TMO      128
#define XB_XCNT(j)  (256  + 64 * (j))
#define XB_XSUB(j)  (1280 + 64 * (j))
#define XB_XGEN(j)  (2304 + 64 * (j))
#define XB_TOP      3328
#define XB_TOPGEN   3392
#define XCD_BAR_WORDS 3456
#define XB_SPIN_CAP (1u << 22)
__device__ __forceinline__ unsigned xb_ld(unsigned* p)              { return __hip_atomic_load(p, __ATOMIC_RELAXED, __HIP_MEMORY_SCOPE_AGENT); }
__device__ __forceinline__ unsigned xb_add(unsigned* p, unsigned v) { return __hip_atomic_fetch_add(p, v, __ATOMIC_RELAXED, __HIP_MEMORY_SCOPE_AGENT); }
__device__ __forceinline__ unsigned xb_xcc_id() { return (unsigned)__builtin_amdgcn_s_getreg((3 << 11) | 20) & 0xFu; }
#define XB_SPIN(cond, bar) do { unsigned _sp = 0; while (cond) { __builtin_amdgcn_s_sleep(1); \
    if ((++_sp & 255u) == 0u) { if (xb_ld(&(bar)[XB_TMO])) break; if (_sp > XB_SPIN_CAP) { atomicAdd(&(bar)[XB_TMO], 1u); break; } } } } while (0)
struct XcdBarrier { unsigned* bar; unsigned x; volatile LAS unsigned* st; };
__device__ __forceinline__ XcdBarrier xcd_barrier_post(unsigned* bar, volatile LAS unsigned* st) {
    XcdBarrier b; b.bar = bar; b.x = xb_xcc_id(); b.st = st;
    if (threadIdx.x == 0) (void)xb_add(&bar[XB_XCNT(b.x)], 1u);
    return b;
}
__device__ __forceinline__ void xcd_barrier_complete(unsigned* bar, unsigned x, unsigned& nloc, unsigned& nx) {
    const unsigned G = gridDim.x * gridDim.y * gridDim.z;
    unsigned sum, cnt, mine, sp = 0u;
    for (;;) {
        sum = 0u; cnt = 0u; mine = 0u;
#pragma unroll
        for (unsigned j = 0; j < 16; ++j) { const unsigned c = xb_ld(&bar[XB_XCNT(j)]); sum += c; cnt += (c > 0u) ? 1u : 0u; mine = (j == x) ? c : mine; }
        if (sum == G) break;
        __builtin_amdgcn_s_sleep(1);
        if ((++sp & 255u) == 0u) { if (xb_ld(&bar[XB_TMO])) break; if (sp > XB_SPIN_CAP) { atomicAdd(&bar[XB_TMO], 1u); break; } }
    }
    nloc = mine > 0u ? mine : 1u; nx = cnt > 0u ? cnt : 1u;
}
__device__ __forceinline__ void xcd_barrier(const XcdBarrier& b) {
    asm volatile("s_waitcnt vmcnt(0)" ::: "memory");
    __syncthreads();
    if (threadIdx.x == 0) {
        unsigned* bar = b.bar;
        __builtin_amdgcn_s_waitcnt(0);
        unsigned nloc = b.st[0], nx = b.st[1];
        if (nloc == 0u) { xcd_barrier_complete(bar, b.x, nloc, nx); b.st[0] = nloc; b.st[1] = nx; }
        const unsigned old = xb_add(&bar[XB_XSUB(b.x)], 1u);
        const unsigned gen = old / nloc;
        if (old + 1u == (gen + 1u) * nloc) {
            __builtin_amdgcn_fence(__ATOMIC_RELEASE, "agent");
            asm volatile("s_waitcnt vmcnt(0)" ::: "memory");
            const unsigned og = xb_add(&bar[XB_TOP], 1u);
            const unsigned tg = og / nx;
            if (og + 1u == (tg + 1u) * nx) xb_add(&bar[XB_TOPGEN], 1u);
            else XB_SPIN(xb_ld(&bar[XB_TOPGEN]) == tg, bar);
            __builtin_amdgcn_fence(__ATOMIC_ACQUIRE, "agent");
            xb_add(&bar[XB_XGEN(b.x)], 1u);
            asm volatile("s_waitcnt vmcnt(0)" ::: "memory");
        } else {
            XB_SPIN(xb_ld(&bar[XB_XGEN(b.x)]) == gen, bar);
            __builtin_amdgcn_fence(__ATOMIC_ACQUIRE, "agent");
            asm volatile("s_waitcnt vmcnt(0)" ::: "memory");
        }
    }
    __syncthreads();
}

namespace pg8 {
constexpr int BM = 256, BK = 64, HALF = 128, HTB = HALF * BK * 2, STAGE_BYTES = 8 * HTB, NXCD = 8, WGM = 8;
__device__ __forceinline__ int lds_byte(int r, int c) { const int st = (r >> 4) * 2 + (c >> 5), rr = r & 15, cc = c & 31, ob = rr * 64 + cc * 2; return st * 1024 + (ob ^ (((ob >> 9) & 1) << 5)); }
__device__ __forceinline__ void stage_rc(int b, int& R, int& C) { const int st = b / 1024, sb = b % 1024, swz = sb ^ (((sb >> 9) & 1) << 5); R = (st >> 1) * 16 + swz / 64; C = (st & 1) * 32 + (swz % 64) / 2; }
__device__ __forceinline__ int perm32(int rho) { const int n = rho >> 4, i = rho & 15; return 8 * (i >> 2) + 4 * n + (i & 3); }
struct Unit { int pm, pn, z; };
struct Gemm { const bf16_t* A; const bf16_t* Bt; int M, N, K; size_t zA, zB; };
struct StaticOrder {
    int nM, nN, nwg, G, c;
    __device__ void init(int M, int N, int G_, int c_) { nM = M / BM; nN = N / BM; nwg = nM * nN; G = G_; c = c_; }
    __device__ bool next(int i, Unit& u) const {
        const long L = (long)i * G + c; if (L >= nwg) return false;
        int wgid = (int)L; { const int q = nwg / NXCD, r = nwg % NXCD, xcd = wgid % NXCD, off = wgid / NXCD; wgid = (xcd < r ? xcd * (q + 1) : r * (q + 1) + (xcd - r) * q) + off; }
        const int nig = WGM * nN, gid = wgid / nig, fm = gid * WGM, gsz = (nM - fm) < WGM ? (nM - fm) : WGM;
        u.pm = fm + ((wgid % nig) % gsz); u.pn = (wgid % nig) / gsz; u.z = 0; return true;
    }
};
template <int NZ> struct StackOrder : StaticOrder {
    __device__ bool next(int i, Unit& u) const { if (i >= NZ) return false; const bool ok = StaticOrder::next(0, u); u.z = i; return ok; }
};
template <int ACT  > struct EpiBf16 {
    static constexpr bool PERM = true, AFTER_DRAIN = false;
    bf16_t* O; int ldc;
    __device__ __forceinline__ void operator()(const f32x4 (&acc)[2][2][4][2], const Unit& u, int wr, int wc, int fr, int fq) const {
        const int row0 = u.pm * BM + wr * 64 + fr, col0 = u.pn * BM + wc * 32 + 8 * fq;
#pragma unroll
        for (int ai = 0; ai < 2; ++ai)
#pragma unroll
            for (int m = 0; m < 4; ++m) { bf16_t* rowp = O + (size_t)(row0 + ai * HALF + m * 16) * ldc + col0;
#pragma unroll
                for (int bj = 0; bj < 2; ++bj) { f32x4 v0 = acc[ai][bj][m][0], v1 = acc[ai][bj][m][1];
                    if (ACT == 1) {
#pragma unroll
                        for (int j = 0; j < 4; ++j) { float a = fmaxf(v0[j], 0.f), b = fmaxf(v1[j], 0.f); v0[j] = a * a; v1[j] = b * b; } }
                    u32x4 w; w.x = cvt_pk_bf16(v0[0], v0[1]); w.y = cvt_pk_bf16(v0[2], v0[3]); w.z = cvt_pk_bf16(v1[0], v1[1]); w.w = cvt_pk_bf16(v1[2], v1[3]);
                    *(u32x4*)(rowp + bj * HALF) = w; } }
    }
};
struct EpiBranch {
    static constexpr bool PERM = true, AFTER_DRAIN = false;
    float* mix; bf16_t* mixb; const bf16_t* proj;
    template <int Z> __device__ __forceinline__ void run(const f32x4 (&acc)[2][2][4][2], const Unit& u, int wr, int wc, int fr, int fq) const {
        const int row0 = u.pm * BM + wr * 64 + fr, col0 = u.pn * BM + wc * 32 + 8 * fq;
#pragma unroll
        for (int ai = 0; ai < 2; ++ai)
#pragma unroll
            for (int m2 = 0; m2 < 4; m2 += 2) {
                u32x4 graw[2][2]; f32x4 old0[2][2], old1[2][2];
#pragma unroll
                for (int mm = 0; mm < 2; ++mm)
#pragma unroll
                    for (int bj = 0; bj < 2; ++bj) { const int row = row0 + ai * HALF + (m2 + mm) * 16, col = col0 + bj * HALF;
                        graw[mm][bj] = *(const u32x4*)(proj + (size_t)row * NP + C_BR + Z * 2048 + col);
                        if (Z > 0) { const float* mp = mix + (size_t)row * 2048 + col; old0[mm][bj] = *(const f32x4*)mp; old1[mm][bj] = *(const f32x4*)(mp + 4); } }
#pragma unroll
                for (int mm = 0; mm < 2; ++mm)
#pragma unroll
                    for (int bj = 0; bj < 2; ++bj) { const int row = row0 + ai * HALF + (m2 + mm) * 16, col = col0 + bj * HALF;
                        const u32x4 g = graw[mm][bj];
                        f32x4 v0 = acc[ai][bj][m2 + mm][0], v1 = acc[ai][bj][m2 + mm][1];
                        v0[0] *= sigmoidf_(lo16(g.x)); v0[1] *= sigmoidf_(hi16(g.x)); v0[2] *= sigmoidf_(lo16(g.y)); v0[3] *= sigmoidf_(hi16(g.y));
                        v1[0] *= sigmoidf_(lo16(g.z)); v1[1] *= sigmoidf_(hi16(g.z)); v1[2] *= sigmoidf_(lo16(g.w)); v1[3] *= sigmoidf_(hi16(g.w));
                        if (Z > 0) { v0 += old0[mm][bj]; v1 += old1[mm][bj]; }
                        if (Z < 2) { float* mp = mix + (size_t)row * 2048 + col; *(f32x4*)mp = v0; *(f32x4*)(mp + 4) = v1; }
                        else { u32x4 w; w.x = cvt_pk_bf16(v0[0], v0[1]); w.y = cvt_pk_bf16(v0[2], v0[3]); w.z = cvt_pk_bf16(v1[0], v1[1]); w.w = cvt_pk_bf16(v1[2], v1[3]);
                            *(u32x4*)(mixb + (size_t)row * 2048 + col) = w; } }
                asm volatile("" ::: "memory"); }
    }
    __device__ __forceinline__ void operator()(const f32x4 (&acc)[2][2][4][2], const Unit& u, int wr, int wc, int fr, int fq) const {
        if (u.z == 0) run<0>(acc, u, wr, wc, fr, fq); else if (u.z == 1) run<1>(acc, u, wr, wc, fr, fq); else run<2>(acc, u, wr, wc, fr, fq);
    }
};
template <int PLEMODE> struct EpiF32SS {
    static constexpr bool PERM = false, AFTER_DRAIN = false;
    bf16_t* C; float* ssp; const bf16_t* pp;
    __device__ __forceinline__ void operator()(const f32x4 (&acc)[2][2][4][2], const Unit& u, int wr, int wc, int fr, int fq) const {
        const int row0 = u.pm * BM + wr * 64 + fr, col0 = u.pn * BM + wc * 32 + 4 * fq;
#pragma unroll
        for (int ai = 0; ai < 2; ++ai)
#pragma unroll
            for (int m = 0; m < 4; ++m) { const int row = row0 + ai * HALF + m * 16; float s = 0.f;
#pragma unroll
                for (int bj = 0; bj < 2; ++bj)
#pragma unroll
                    for (int n = 0; n < 2; ++n) { const int col = col0 + bj * HALF + n * 16; f32x4 v = acc[ai][bj][m][n];
                        if (PLEMODE) { const f32x4 pv = up4(*(const u32x2*)(pp + (size_t)row * 2048 + col));
#pragma unroll
                            for (int j = 0; j < 4; ++j) v[j] = sigmoidf_(v[j]) * pv[j]; }
                        s += (v[0] * v[0] + v[1] * v[1]) + (v[2] * v[2] + v[3] * v[3]);
                        { u32x2 w; w.x = cvt_pk_bf16(v[0], v[1]); w.y = cvt_pk_bf16(v[2], v[3]); *(u32x2*)(C + (size_t)row * 2048 + col) = w; } }
                s += __shfl_xor(s, 16); s += __shfl_xor(s, 32);
                if (fq == 0) ssp[(size_t)row * 32 + u.pn * 4 + wc] = s; }
    }
};

struct RowStats {
    float* xbuf;
    unsigned* cnt;
    unsigned want;
    __device__ __forceinline__ void run(const f32x4 (&v)[2][2][4][2], const Unit& u, int wr, int wc, int fr, int fq, LAS unsigned char* lds, int wid, int lane) const {
        LAS float* Pt = (LAS float*)lds;
        LAS float* S = (LAS float*)(lds + 8192);
#pragma unroll
        for (int ai = 0; ai < 2; ++ai)
#pragma unroll
            for (int m = 0; m < 4; ++m) { float sq = 0.f;
#pragma unroll
                for (int bj = 0; bj < 2; ++bj)
#pragma unroll
                    for (int n = 0; n < 2; ++n) { const f32x4 x = v[ai][bj][m][n]; sq += (x[0] * x[0] + x[1] * x[1]) + (x[2] * x[2] + x[3] * x[3]); }
                sq += __shfl_xor(sq, 16); sq += __shfl_xor(sq, 32);
                if (fq == 0) Pt[(ai * HALF + wr * 64 + m * 16 + fr) * 4 + wc] = sq; }
        asm volatile("s_waitcnt lgkmcnt(0)" ::: "memory"); __builtin_amdgcn_s_barrier(); asm volatile("" ::: "memory");
        const int row = wid * 32 + (lane & 31);
        if (lane < 32) { const float a = (Pt[row * 4 + 0] + Pt[row * 4 + 1]) + (Pt[row * 4 + 2] + Pt[row * 4 + 3]);
            __hip_atomic_store(xbuf + ((size_t)(u.pm * BM + row) * 8 + u.pn), a, __ATOMIC_RELAXED, __HIP_MEMORY_SCOPE_AGENT); }
        asm volatile("s_waitcnt vmcnt(0)" ::: "memory");
        if (lane == 0) __hip_atomic_fetch_add(cnt + 64 * u.pm, 1u, __ATOMIC_RELAXED, __HIP_MEMORY_SCOPE_AGENT);
        if (wid == 0) { unsigned sp = 0;
            while ((unsigned)__builtin_amdgcn_readfirstlane(__hip_atomic_load(cnt + 64 * u.pm, __ATOMIC_RELAXED, __HIP_MEMORY_SCOPE_AGENT)) < want) { __builtin_amdgcn_s_sleep(2); if (++sp > (1u << 24)) break; }
            __builtin_amdgcn_fence(__ATOMIC_ACQUIRE, "agent"); }
        asm volatile("s_waitcnt vmcnt(0) lgkmcnt(0)" ::: "memory"); __builtin_amdgcn_s_barrier(); asm volatile("" ::: "memory");
        if (lane < 32) { const float* slot = xbuf + (size_t)(u.pm * BM + row) * 8; float sum = 0.f;
#pragma unroll
            for (int t = 0; t < 8; ++t) sum += __hip_atomic_load(slot + t, __ATOMIC_RELAXED, __HIP_MEMORY_SCOPE_AGENT);
            S[row] = rsqrtf(sum * (1.0f / 2048.0f) + EPS); }
        asm volatile("s_waitcnt lgkmcnt(0)" ::: "memory"); __builtin_amdgcn_s_barrier(); asm volatile("" ::: "memory");
    }
};
template <int PLEMODE, int HASNEXT> struct EpiRowFused {
    static constexpr bool PERM = false, AFTER_DRAIN = true;
    const float* xsrc; float* x; bf16_t* hb; const bf16_t* pp; const float* gpost; const float* gnext; RowStats st1, st2;
    __device__ __forceinline__ void fused(f32x4 (&acc)[2][2][4][2], const Unit& u, int wr, int wc, int fr, int fq, LAS unsigned char* lds, int wid, int lane) const {
        const LAS float* S = (const LAS float*)(lds + 8192);
        const int col0 = u.pn * BM + wc * 32 + 4 * fq;
        if (PLEMODE) {
#pragma unroll
            for (int ai = 0; ai < 2; ++ai)
#pragma unroll
                for (int m2 = 0; m2 < 4; m2 += 2) { u32x2 praw[2][2][2];
#pragma unroll
                    for (int mm = 0; mm < 2; ++mm)
#pragma unroll
                        for (int bj = 0; bj < 2; ++bj)
#pragma unroll
                            for (int n = 0; n < 2; ++n) { const int r = ai * HALF + wr * 64 + (m2 + mm) * 16 + fr; praw[mm][bj][n] = *(const u32x2*)(pp + (size_t)(u.pm * BM + r) * 2048 + col0 + bj * HALF + n * 16); }
#pragma unroll
                    for (int mm = 0; mm < 2; ++mm)
#pragma unroll
                        for (int bj = 0; bj < 2; ++bj)
#pragma unroll
                            for (int n = 0; n < 2; ++n) { const f32x4 pv = up4(praw[mm][bj][n]);
#pragma unroll
                                for (int j = 0; j < 4; ++j) acc[ai][bj][m2 + mm][n][j] = sigmoidf_(acc[ai][bj][m2 + mm][n][j]) * pv[j]; }
                    asm volatile("" ::: "memory"); }
        }
        st1.run(acc, u, wr, wc, fr, fq, lds, wid, lane);
        {
            f32x4 wv[2][2];
#pragma unroll
            for (int bj = 0; bj < 2; ++bj)
#pragma unroll
                for (int n = 0; n < 2; ++n) wv[bj][n] = *(const f32x4*)(gpost + col0 + bj * HALF + n * 16);
#pragma unroll
            for (int ai = 0; ai < 2; ++ai)
#pragma unroll
                for (int m = 0; m < 4; ++m) { f32x4 xs[2][2];
                    const int r = ai * HALF + wr * 64 + m * 16 + fr; const size_t off = (size_t)(u.pm * BM + r) * 2048 + col0;
#pragma unroll
                    for (int bj = 0; bj < 2; ++bj)
#pragma unroll
                        for (int n = 0; n < 2; ++n) xs[bj][n] = *(const f32x4*)(xsrc + off + bj * HALF + n * 16);
                    const float rn = S[r];
#pragma unroll
                    for (int bj = 0; bj < 2; ++bj)
#pragma unroll
                        for (int n = 0; n < 2; ++n) { const f32x4 o = xs[bj][n] + acc[ai][bj][m][n] * rn * wv[bj][n]; acc[ai][bj][m][n] = o; *(f32x4*)(x + off + bj * HALF + n * 16) = o; }
                    asm volatile("" ::: "memory"); }
        }
        if (HASNEXT) {
            st2.run(acc, u, wr, wc, fr, fq, lds, wid, lane);
            f32x4 wv[2][2];
#pragma unroll
            for (int bj = 0; bj < 2; ++bj)
#pragma unroll
                for (int n = 0; n < 2; ++n) wv[bj][n] = *(const f32x4*)(gnext + col0 + bj * HALF + n * 16);
#pragma unroll
            for (int ai = 0; ai < 2; ++ai)
#pragma unroll
                for (int m = 0; m < 4; ++m) { const int r = ai * HALF + wr * 64 + m * 16 + fr; const float r2 = S[r]; const size_t off = (size_t)(u.pm * BM + r) * 2048 + col0;
#pragma unroll
                    for (int bj = 0; bj < 2; ++bj)
#pragma unroll
                        for (int n = 0; n < 2; ++n) { const f32x4 o = acc[ai][bj][m][n] * r2 * wv[bj][n];
                            u32x2 pw; pw.x = cvt_pk_bf16(o[0], o[1]); pw.y = cvt_pk_bf16(o[2], o[3]); *(u32x2*)(hb + off + bj * HALF + n * 16) = pw; } }
        }
        asm volatile("s_waitcnt lgkmcnt(0)" ::: "memory"); __builtin_amdgcn_s_barrier(); asm volatile("" ::: "memory");
    }
};

template <class Epi, class Sched>
__device__ __forceinline__ void gemm_phase(LAS unsigned char* lds, const Gemm g, const Sched& S, const Epi& E) {
    int tid_l = threadIdx.x; asm volatile("" : "+v"(tid_l));
    const int tid = tid_l, wid = __builtin_amdgcn_readfirstlane(tid >> 6), lane = tid & 63, wr = wid >> 2, wc = wid & 3, fr = lane & 15, fq = lane >> 4;
    const int K = g.K, nt = K / BK;
    unsigned voffA[2], voffB[2];
#pragma unroll
    for (int i = 0; i < 2; ++i) { int R, C; stage_rc(tid * 16 + i * 8192, R, C); const int Rb = Epi::PERM ? ((R & ~31) + perm32(R & 31)) : R;
        voffA[i] = (unsigned)(R * K + C) * 2u; voffB[i] = (unsigned)(Rb * K + C) * 2u; }
    const size_t kstep = (size_t)(BK * 2);
    const size_t hstep = (size_t)HALF * K * 2;
    const size_t tstep = 2 * hstep;
    const unsigned ldsw = (unsigned)wid * 1024u;
    const int aoff = lds_byte(wr * 64 + fr, fq * 8), boff = lds_byte(wc * 32 + fr, fq * 8);
#define PG8_SA(b, h) (((b) * 2 + (h)) * HTB)
#define PG8_SB(b, h) ((4 + (b) * 2 + (h)) * HTB)
#define PG8_STAGE(bufoff, gbase, voff) do { _Pragma("unroll") for (int _i = 0; _i < 2; ++_i) \
        __builtin_amdgcn_global_load_lds((const unsigned*)((const char*)(gbase) + (voff)[_i]), (LAS unsigned*)(lds + (bufoff) + ldsw + _i * 8192), 16, 0, 0); } while (0)
#define PG8_LDA(dst, b, h) do { _Pragma("unroll") for (int m = 0; m < 4; ++m) _Pragma("unroll") for (int k = 0; k < 2; ++k) dst[m][k] = *(const LAS bf16x8*)(lds + PG8_SA(b, h) + aoff + m * 2048 + k * 1024); } while (0)
#define PG8_LDB(dst, b, h) do { _Pragma("unroll") for (int n = 0; n < 2; ++n) _Pragma("unroll") for (int k = 0; k < 2; ++k) dst[n][k] = *(const LAS bf16x8*)(lds + PG8_SB(b, h) + boff + n * 2048 + k * 1024); } while (0)
#define PG8_MMA(ai, bj, At, Bt) do { __builtin_amdgcn_s_setprio(1); _Pragma("unroll") for (int m = 0; m < 4; ++m) _Pragma("unroll") for (int n = 0; n < 2; ++n) _Pragma("unroll") for (int k = 0; k < 2; ++k) \
        acc[ai][bj][m][n] = __builtin_amdgcn_mfma_f32_16x16x32_bf16(Bt[n][k], At[m][k], acc[ai][bj][m][n], 0, 0, 0); __builtin_amdgcn_s_setprio(0); } while (0)
#define PG8_WAIT_V(n) asm volatile("s_waitcnt vmcnt(" #n ")" ::: "memory")
#define PG8_WAIT_L(n) asm volatile("s_waitcnt lgkmcnt(" #n ")" ::: "memory")
#define PG8_BAR __builtin_amdgcn_s_barrier()
#define PG8_SCHED __builtin_amdgcn_sched_barrier(0)
    Unit cur, nxt; int ui = 0;
    if (!S.next(0, cur)) return;
    f32x4 acc[2][2][4][2];
#pragma unroll
    for (int a = 0; a < 2; ++a)
#pragma unroll
        for (int b = 0; b < 2; ++b)
#pragma unroll
            for (int m = 0; m < 4; ++m)
#pragma unroll
                for (int n = 0; n < 2; ++n) acc[a][b][m][n] = (f32x4){0.f, 0.f, 0.f, 0.f};
    bf16x8 At[4][2], B0[2][2], B1[2][2];
    const char* cA = (const char*)g.A + (size_t)cur.z * g.zA + (size_t)cur.pm * tstep; const char* cB = (const char*)g.Bt + (size_t)cur.z * g.zB + (size_t)cur.pn * tstep;
    PG8_STAGE(PG8_SB(0, 0), cB, voffB); PG8_STAGE(PG8_SA(0, 0), cA, voffA); PG8_STAGE(PG8_SB(0, 1), cB + hstep, voffB); PG8_STAGE(PG8_SA(0, 1), cA + hstep, voffA);
    if (wr == 1) PG8_BAR;
    PG8_WAIT_V(4); PG8_BAR;
    PG8_STAGE(PG8_SB(1, 0), cB + kstep, voffB); PG8_STAGE(PG8_SA(1, 0), cA + kstep, voffA); PG8_STAGE(PG8_SB(1, 1), cB + hstep + kstep, voffB);
    PG8_WAIT_V(6); PG8_BAR;
    for (;;) {
        const bool has_next = S.next(ui + 1, nxt);
        const char* nA = has_next ? (const char*)g.A + (size_t)nxt.z * g.zA + (size_t)nxt.pm * tstep : cA; const char* nB = has_next ? (const char*)g.Bt + (size_t)nxt.z * g.zB + (size_t)nxt.pn * tstep : cB;
        for (int t = 0; t < nt; t += 2) {
            const bool last = (t == nt - 2);
            const char* a1 = cA + (size_t)(t + 1) * kstep;
            const char* a2 = last ? nA : cA + (size_t)(t + 2) * kstep; const char* b2 = last ? nB : cB + (size_t)(t + 2) * kstep;
            const char* a3 = a2 + kstep; const char* b3 = b2 + kstep;
            PG8_LDB(B0, 0, 0); PG8_SCHED; PG8_LDA(At, 0, 0); PG8_STAGE(PG8_SA(1, 1), a1 + hstep, voffA);
            PG8_WAIT_L(8); PG8_BAR; PG8_WAIT_L(0); PG8_MMA(0, 0, At, B0); PG8_BAR; PG8_SCHED;
            PG8_LDB(B1, 0, 1); PG8_STAGE(PG8_SB(0, 0), b2, voffB);
            PG8_BAR; PG8_WAIT_L(0); PG8_MMA(0, 1, At, B1); PG8_BAR;
            PG8_LDA(At, 0, 1); PG8_STAGE(PG8_SA(0, 0), a2, voffA);
            PG8_BAR; PG8_WAIT_L(0); PG8_MMA(1, 0, At, B0); PG8_BAR; PG8_SCHED;
            PG8_STAGE(PG8_SB(0, 1), b2 + hstep, voffB);
            PG8_WAIT_V(6); PG8_BAR; PG8_MMA(1, 1, At, B1); PG8_BAR;
            PG8_LDB(B0, 1, 0); PG8_SCHED; PG8_LDA(At, 1, 0); PG8_STAGE(PG8_SA(0, 1), a2 + hstep, voffA);
            PG8_WAIT_L(8); PG8_BAR; PG8_WAIT_L(0); PG8_MMA(0, 0, At, B0); PG8_BAR; PG8_SCHED;
            PG8_LDB(B1, 1, 1); PG8_STAGE(PG8_SB(1, 0), b3, voffB);
            PG8_BAR; PG8_WAIT_L(0); PG8_MMA(0, 1, At, B1); PG8_BAR;
            PG8_LDA(At, 1, 1); PG8_STAGE(PG8_SA(1, 0), a3, voffA);
            PG8_BAR; PG8_WAIT_L(0); PG8_MMA(1, 0, At, B0); PG8_BAR; PG8_SCHED;
            PG8_STAGE(PG8_SB(1, 1), b3 + hstep, voffB);
            PG8_WAIT_V(6); PG8_BAR; PG8_MMA(1, 1, At, B1); PG8_BAR;
        }
        if constexpr (!Epi::AFTER_DRAIN) E(acc, cur, wr, wc, fr, fq);
        if (!has_next) break;
#pragma unroll
        for (int a = 0; a < 2; ++a)
#pragma unroll
            for (int b = 0; b < 2; ++b)
#pragma unroll
                for (int m = 0; m < 4; ++m)
#pragma unroll
                    for (int n = 0; n < 2; ++n) acc[a][b][m][n] = (f32x4){0.f, 0.f, 0.f, 0.f};
        cur = nxt; cA = nA; cB = nB; ++ui;
    }
    PG8_WAIT_V(0);
    if (wr == 0) PG8_BAR;
    PG8_BAR;
    if constexpr (Epi::AFTER_DRAIN) E.fused(acc, cur, wr, wc, fr, fq, lds, wid, lane);
#undef PG8_SA
#undef PG8_SB
#undef PG8_STAGE
#undef PG8_LDA
#undef PG8_LDB
#undef PG8_MMA
#undef PG8_WAIT_V
#undef PG8_WAIT_L
#undef PG8_BAR
#undef PG8_SCHED
}
}

__device__ void convT(const float* __restrict__ W, int K, int N, bf16_t* __restrict__ Wt, int Npad, float* tile, int bid, int nb) {
    int tid_l = threadIdx.x; asm volatile("" : "+v"(tid_l));
    const int tk = K / 64, tn = Npad / 64, ntiles = tk * tn, tid = tid_l;
    const int r0 = tid >> 4, c4 = (tid & 15) * 4;
    f32x4 cur0 = (f32x4){0.f, 0.f, 0.f, 0.f}, cur1 = cur0, nx0 = cur0, nx1 = cur0;
    int t = bid;
    if (t < ntiles) { const int k0 = (t % tk) * 64, n = (t / tk) * 64 + c4;
        if (n < N) { cur0 = __builtin_nontemporal_load((const f32x4*)(W + (size_t)(k0 + r0) * N + n)); cur1 = __builtin_nontemporal_load((const f32x4*)(W + (size_t)(k0 + r0 + 32) * N + n)); } }
    for (; t < ntiles; t += nb) {
        const int k0 = (t % tk) * 64, n0 = (t / tk) * 64;
        tile[r0 * 65 + c4 + 0] = cur0[0]; tile[r0 * 65 + c4 + 1] = cur0[1]; tile[r0 * 65 + c4 + 2] = cur0[2]; tile[r0 * 65 + c4 + 3] = cur0[3];
        tile[(r0 + 32) * 65 + c4 + 0] = cur1[0]; tile[(r0 + 32) * 65 + c4 + 1] = cur1[1]; tile[(r0 + 32) * 65 + c4 + 2] = cur1[2]; tile[(r0 + 32) * 65 + c4 + 3] = cur1[3];
        asm volatile("s_waitcnt lgkmcnt(0)" ::: "memory"); __builtin_amdgcn_s_barrier(); asm volatile("" ::: "memory");
        { const int t2 = t + nb; nx0 = (f32x4){0.f, 0.f, 0.f, 0.f}; nx1 = nx0;
          if (t2 < ntiles) { const int k2 = (t2 % tk) * 64, n2 = (t2 / tk) * 64 + c4;
              if (n2 < N) { nx0 = __builtin_nontemporal_load((const f32x4*)(W + (size_t)(k2 + r0) * N + n2)); nx1 = __builtin_nontemporal_load((const f32x4*)(W + (size_t)(k2 + r0 + 32) * N + n2)); } } }
        { const int n = tid >> 3, kg = (tid & 7) * 8; u32x4 w;
          w.x = pk2(tile[(kg + 0) * 65 + n], tile[(kg + 1) * 65 + n]); w.y = pk2(tile[(kg + 2) * 65 + n], tile[(kg + 3) * 65 + n]);
          w.z = pk2(tile[(kg + 4) * 65 + n], tile[(kg + 5) * 65 + n]); w.w = pk2(tile[(kg + 6) * 65 + n], tile[(kg + 7) * 65 + n]);
          __builtin_nontemporal_store(w, (u32x4*)(Wt + (size_t)(n0 + n) * K + k0 + kg)); }
        asm volatile("s_waitcnt lgkmcnt(0)" ::: "memory"); __builtin_amdgcn_s_barrier(); asm volatile("" ::: "memory");
        cur0 = nx0; cur1 = nx1;
    }
    __syncthreads();
}

__device__ void row_phase(const float* __restrict__ xin, float* __restrict__ xio, const bf16_t* __restrict__ gout, const float* __restrict__ ssp,
                          const float* __restrict__ gpost, const float* __restrict__ gnext, bf16_t* __restrict__ hb, int mode, int gw, int nw) {
    int tid_l = threadIdx.x; asm volatile("" : "+v"(tid_l));
    const int lane = tid_l & 63;
    for (int row = gw; row < T; row += nw) {
        f32x4 xv[8];
        const size_t rb = (size_t)row * 2048;
        if (mode == 0 || mode == 2) {
#pragma unroll
            for (int i = 0; i < 8; ++i) xv[i] = *(const f32x4*)(xin + rb + (i * 64 + lane) * 4);
        } else {
            float ss = ssp[(size_t)row * 32 + (lane & 31)];
            ss += __shfl_xor(ss, 1); ss += __shfl_xor(ss, 2); ss += __shfl_xor(ss, 4); ss += __shfl_xor(ss, 8); ss += __shfl_xor(ss, 16);
            const float rn = rsqrtf(ss * (1.0f / 2048.0f) + EPS);
#pragma unroll
            for (int i = 0; i < 8; ++i) { const int col = (i * 64 + lane) * 4;
                const f32x4 g = up4(*(const u32x2*)(gout + rb + col)), w = *(const f32x4*)(gpost + col), x0 = *(const f32x4*)(xio + rb + col);
                xv[i] = x0 + g * rn * w; }
        }
        if (mode != 2) {
#pragma unroll
            for (int i = 0; i < 8; ++i) *(f32x4*)(xio + rb + (i * 64 + lane) * 4) = xv[i]; }
        if (gnext) {
            float s2 = 0.f;
#pragma unroll
            for (int i = 0; i < 8; ++i) s2 += (xv[i][0] * xv[i][0] + xv[i][1] * xv[i][1]) + (xv[i][2] * xv[i][2] + xv[i][3] * xv[i][3]);
            s2 += __shfl_xor(s2, 1); s2 += __shfl_xor(s2, 2); s2 += __shfl_xor(s2, 4); s2 += __shfl_xor(s2, 8); s2 += __shfl_xor(s2, 16); s2 += __shfl_xor(s2, 32);
            const float r2 = rsqrtf(s2 * (1.0f / 2048.0f) + EPS);
#pragma unroll
            for (int i = 0; i < 8; ++i) { const int col = (i * 64 + lane) * 4; const f32x4 w = *(const f32x4*)(gnext + col); const f32x4 o = xv[i] * r2 * w;
                *(u32x2*)(hb + rb + col) = pk4(o); }
        }
    }
}

struct Ctx {
    const __attribute__((address_space(4))) Params* P; int layer, bid, nb, tid, wave, lane, r, q, gw, nw;
    unsigned char* ws;
    float* ldsf;
    template <class Tp> __device__ __forceinline__ Tp* W(size_t off) const { return (Tp*)(ws + off); }
    __device__ __forceinline__ const float* in(int i) const { return P->in[i]; }
};
enum { I_X = 0, I_P, I_PREMIX, I_WIN, I_DNCONV, I_DNALOG, I_DNDTB, I_DNNORM, I_SCONVW, I_SCONVB, I_SDTB, I_SALOG, I_SD, I_SNORM, I_GW2, I_GB, I_GNORM, I_WBR, I_WOUT,
       I_POSTMIX, I_PREMLP, I_WUP, I_WDN, I_POSTMLP, I_PLEPRE, I_WPG, I_WPP, I_PLEPOST };

__device__ __forceinline__ void prep_dn_load(const bf16_t* proj, const float* cw, int idx, u32x4 (&raw)[4], int& t, int& ch) {
    if (idx >= 0) { t = idx / 384; const int j = idx - t * 384; ch = j * 8; }
#pragma unroll
    for (int k = 0; k < 4; ++k) { const int tt = t - 3 + k; raw[k] = (u32x4){0u, 0u, 0u, 0u};
        if (tt >= 0) raw[k] = *(const u32x4*)(proj + (size_t)tt * NP + C_DNQ + ch); }
}
__device__ __forceinline__ void prep_dn_finish(const float* cw, bf16_t* dq, bf16_t* dk, bf16_t* dv, const u32x4 (&raw)[4], int t, int ch) {
    float a[8];
#pragma unroll
    for (int e = 0; e < 8; ++e) a[e] = 0.f;
#pragma unroll
    for (int k = 0; k < 4; ++k) {
        const f32x4 w0 = *(const f32x4*)(cw + k * 3072 + ch), w1 = *(const f32x4*)(cw + k * 3072 + ch + 4);
        a[0] += w0[0] * lo16(raw[k].x); a[1] += w0[1] * hi16(raw[k].x); a[2] += w0[2] * lo16(raw[k].y); a[3] += w0[3] * hi16(raw[k].y);
        a[4] += w1[0] * lo16(raw[k].z); a[5] += w1[1] * hi16(raw[k].z); a[6] += w1[2] * lo16(raw[k].w); a[7] += w1[3] * hi16(raw[k].w); }
    float ss = 0.f;
#pragma unroll
    for (int e = 0; e < 8; ++e) { a[e] = siluf_(a[e]); ss += a[e] * a[e]; }
    ss += __shfl_xor(ss, 1); ss += __shfl_xor(ss, 2); ss += __shfl_xor(ss, 4); ss += __shfl_xor(ss, 8);
    float sc = 1.0f;
    if (ch < 2048) { sc = rsqrtf(ss + EPS); if (ch < 1024) sc *= 0.08838834764831845f; }
    u32x4 w; w.x = pk2(a[0] * sc, a[1] * sc); w.y = pk2(a[2] * sc, a[3] * sc); w.z = pk2(a[4] * sc, a[5] * sc); w.w = pk2(a[6] * sc, a[7] * sc);
    bf16_t* dst = (ch < 1024) ? dq : (ch < 2048 ? dk : dv);
    *(u32x4*)(dst + (size_t)t * 1024 + (ch & 1023)) = w;
}
__device__ void prep_dn(const Ctx& c) {
    const bf16_t* proj = c.W<bf16_t>(WS_PROJ);
    const float* cw = c.in(I_DNCONV) + (size_t)c.layer * 4 * 3072;
    bf16_t* dq = c.W<bf16_t>(WS_DQ); bf16_t* dk = c.W<bf16_t>(WS_DK); bf16_t* dv = c.W<bf16_t>(WS_DV);
    const int total = T * 384, stride = c.nw * 64;
    int base = c.gw * 64;
    for (; base + stride < total; base += 2 * stride) {
        u32x4 r0[4], r1[4]; int t0, c0, t1, c1;
        prep_dn_load(proj, cw, base + c.lane, r0, t0, c0);
        prep_dn_load(proj, cw, base + stride + c.lane, r1, t1, c1);
        prep_dn_finish(cw, dq, dk, dv, r0, t0, c0);
        prep_dn_finish(cw, dq, dk, dv, r1, t1, c1);
    }
    if (base < total) { u32x4 r0[4]; int t0, c0; prep_dn_load(proj, cw, base + c.lane, r0, t0, c0); prep_dn_finish(cw, dq, dk, dv, r0, t0, c0); }
}

__device__ void prep_dn_chunk(const Ctx& c, int ck, int half) {
    const bf16_t* proj = c.W<bf16_t>(WS_PROJ);
    const float* cw = c.in(I_DNCONV) + (size_t)c.layer * 4 * 3072;
    bf16_t* dq = c.W<bf16_t>(WS_DQ); bf16_t* dk = c.W<bf16_t>(WS_DK); bf16_t* dv = c.W<bf16_t>(WS_DV);
    for (int it = c.tid; it < 64 * 192; it += 1024) {
        u32x4 r0[4], r1[4]; int t0, c0, t1, c1;
        { const int l = it / 192, j = it - l * 192; t0 = ck * 64 + l; c0 = (j >> 6) * 1024 + half * 512 + (j & 63) * 8; }
        { const int i2 = it + 512, l = i2 / 192, j = i2 - l * 192; t1 = ck * 64 + l; c1 = (j >> 6) * 1024 + half * 512 + (j & 63) * 8; }
        prep_dn_load(proj, cw, -1, r0, t0, c0);
        prep_dn_load(proj, cw, -1, r1, t1, c1);
        prep_dn_finish(cw, dq, dk, dv, r0, t0, c0);
        prep_dn_finish(cw, dq, dk, dv, r1, t1, c1);
    }
}

__device__ void prep_ssd(const Ctx& c, int ck, int blk) {
    const bf16_t* proj = c.W<bf16_t>(WS_PROJ);
    const float* cw = c.in(I_SCONVW) + (size_t)c.layer * 4 * 1536; const float* cb = c.in(I_SCONVB) + (size_t)c.layer * 1536;
    const int tid = c.tid, t0 = ck * 64;
    float* dt_s = c.ldsf; float* acs_s = c.ldsf + 512;
    __syncthreads();
    if (blk < 2) {
        { const int hh = tid >> 6, l = tid & 63, h = blk * 8 + hh;
          const float raw = bf2f(proj[(size_t)(t0 + l) * NP + C_SDT + h]);
          const float dt = softplusf_(raw + c.in(I_SDTB)[c.layer * 16 + h]);
          float a = dt * (-__expf(c.in(I_SALOG)[c.layer * 16 + h]));
#pragma unroll
          for (int d = 1; d < 64; d <<= 1) { const float o = __shfl_up(a, d); if (l >= d) a += o; }
          const float alast = __shfl(a, 63);
          dt_s[tid] = dt; acs_s[tid] = a; c.ldsf[1024 + tid] = dt * __expf(alast - a); }
        __syncthreads();
        { const int h = blk * 8 + (tid >> 6); c.W<float>(WS_SACS)[(size_t)(ck * 16 + h) * 64 + (tid & 63)] = acs_s[tid]; }
        const int ch = blk * 512 + tid, h = ch >> 6, p = ch & 63, hh = tid >> 6;
        const float w0 = cw[ch], w1 = cw[1536 + ch], w2 = cw[2 * 1536 + ch], w3 = cw[3 * 1536 + ch], bb = cb[ch];
        float xm3 = 0.f, xm2 = 0.f, xm1 = 0.f;
        if (t0 > 0) { xm3 = bf2f(proj[(size_t)(t0 - 3) * NP + C_SX + ch]); xm2 = bf2f(proj[(size_t)(t0 - 2) * NP + C_SX + ch]); xm1 = bf2f(proj[(size_t)(t0 - 1) * NP + C_SX + ch]); }
        const float acl = acs_s[hh * 64 + 63];
        bf16_t* sX = c.W<bf16_t>(WS_SX); bf16_t* sXdT = c.W<bf16_t>(WS_SXDT); bf16_t* sXwT = c.W<bf16_t>(WS_SXW);
        float raw[64];
        { unsigned rw[64];
#pragma unroll
          for (int l = 0; l < 64; ++l) rw[l] = proj[(size_t)(t0 + l) * NP + C_SX + ch];
          PIN16(rw, 0); PIN16(rw, 16); PIN16(rw, 32); PIN16(rw, 48);
#pragma unroll
          for (int l = 0; l < 64; ++l) raw[l] = __uint_as_float(rw[l] << 16); }
#pragma unroll
        for (int l0 = 0; l0 < 64; l0 += 8) {
            float xd[8], xw[8];
#pragma unroll
            for (int j = 0; j < 8; ++j) { const int l = l0 + j;
                const float xc = raw[l];
                const float y = w0 * xm3 + w1 * xm2 + w2 * xm1 + w3 * xc + bb; xm3 = xm2; xm2 = xm1; xm1 = xc;
                const float x = siluf_(y);
                sX[(size_t)(t0 + l) * 1024 + ch] = f2bf(x);
                xd[j] = x * dt_s[hh * 64 + l]; xw[j] = x * c.ldsf[1024 + hh * 64 + l]; }
            u32x4 a, b; a.x = pk2(xd[0], xd[1]); a.y = pk2(xd[2], xd[3]); a.z = pk2(xd[4], xd[5]); a.w = pk2(xd[6], xd[7]);
            b.x = pk2(xw[0], xw[1]); b.y = pk2(xw[2], xw[3]); b.z = pk2(xw[4], xw[5]); b.w = pk2(xw[6], xw[7]);
            const size_t o = ((size_t)(ck * 16 + h) * 64 + p) * 64 + l0;
            *(u32x4*)(sXdT + o) = a; *(u32x4*)(sXwT + o) = b;
        }
    } else {
        if (tid >= 256) return;
        const int isC = tid >> 7, cc = (blk - 2) * 128 + (tid & 127), ch = 1024 + isC * 256 + cc;
        const float w0 = cw[ch], w1 = cw[1536 + ch], w2 = cw[2 * 1536 + ch], w3 = cw[3 * 1536 + ch], bb = cb[ch];
        float xm3 = 0.f, xm2 = 0.f, xm1 = 0.f;
        if (t0 > 0) { xm3 = bf2f(proj[(size_t)(t0 - 3) * NP + C_SX + ch]); xm2 = bf2f(proj[(size_t)(t0 - 2) * NP + C_SX + ch]); xm1 = bf2f(proj[(size_t)(t0 - 1) * NP + C_SX + ch]); }
        bf16_t* rowdst = isC ? c.W<bf16_t>(WS_SC) : c.W<bf16_t>(WS_SB);
        bf16_t* sBT = c.W<bf16_t>(WS_SBT);
        const int g = cc >> 7, n = cc & 127;
        float raw[64];
        { unsigned rw[64];
#pragma unroll
          for (int l = 0; l < 64; ++l) rw[l] = proj[(size_t)(t0 + l) * NP + C_SX + ch];
          PIN16(rw, 0); PIN16(rw, 16); PIN16(rw, 32); PIN16(rw, 48);
#pragma unroll
          for (int l = 0; l < 64; ++l) raw[l] = __uint_as_float(rw[l] << 16); }
#pragma unroll
        for (int l0 = 0; l0 < 64; l0 += 8) {
            float xv[8];
#pragma unroll
            for (int j = 0; j < 8; ++j) { const int l = l0 + j;
                const float xc = raw[l];
                const float y = w0 * xm3 + w1 * xm2 + w2 * xm1 + w3 * xc + bb; xm3 = xm2; xm2 = xm1; xm1 = xc;
                const float x = siluf_(y); xv[j] = x;
                rowdst[(size_t)(t0 + l) * 256 + cc] = f2bf(x); }
            if (!isC) { u32x4 a; a.x = pk2(xv[0], xv[1]); a.y = pk2(xv[2], xv[3]); a.z = pk2(xv[4], xv[5]); a.w = pk2(xv[6], xv[7]);
                *(u32x4*)(sBT + ((size_t)(ck * 2 + g) * 128 + n) * 64 + l0) = a; }
        }
    }
}

__device__ void prep_gla(const Ctx& c, int ck, int blk) {
    const bf16_t* proj = c.W<bf16_t>(WS_PROJ);
    const int tid = c.tid, t0 = ck * 64;
    float* lr_s = c.ldsf;
    __syncthreads();
    if (blk >= 10) {
        { const int l = tid >> 3, r2 = (tid & 7) * 2; const unsigned u = *(const unsigned*)(proj + (size_t)(t0 + l) * NP + C_GLR + r2); lr_s[l * 16 + r2] = lo16(u); lr_s[l * 16 + r2 + 1] = hi16(u); }
        __syncthreads();
        if (tid >= 256) return;
        const int ch = (blk - 10) * 256 + tid, h = ch >> 7, k = ch & 127;
        const float* w2 = c.in(I_GW2) + (size_t)c.layer * 16 * 512;
        float w2r[16];
#pragma unroll
        for (int r = 0; r < 16; ++r) w2r[r] = w2[r * 512 + ch];
        const float b2 = c.in(I_GB)[c.layer * 512 + ch];
        bf16_t* gQg = c.W<bf16_t>(WS_GQG); bf16_t* gKn = c.W<bf16_t>(WS_GKN); bf16_t* gKnT = c.W<bf16_t>(WS_GKNT);
        float G = 0.f;
        for (int lh = 0; lh < 64; lh += 32) {
            float qr[32], kr[32];
            { unsigned qw[32], kw[32];
#pragma unroll
              for (int l = 0; l < 32; ++l) { const size_t rb = (size_t)(t0 + lh + l) * NP; qw[l] = proj[rb + C_GQ + ch]; kw[l] = proj[rb + C_GK + ch]; }
              PIN16(qw, 0); PIN16(kw, 0); PIN16(qw, 16); PIN16(kw, 16);
#pragma unroll
              for (int l = 0; l < 32; ++l) { qr[l] = __uint_as_float(qw[l] << 16); kr[l] = __uint_as_float(kw[l] << 16); } }
#pragma unroll
            for (int l0 = 0; l0 < 32; l0 += 8) {
                float kn[8];
#pragma unroll
                for (int j = 0; j < 8; ++j) { const int l = lh + l0 + j;
                    f32x4 xs = (f32x4){b2, 0.f, 0.f, 0.f};
#pragma unroll
                    for (int r4 = 0; r4 < 16; r4 += 4) { const f32x4 lv = *(const f32x4*)(lr_s + l * 16 + r4); const f32x4 wv = (f32x4){w2r[r4], w2r[r4 + 1], w2r[r4 + 2], w2r[r4 + 3]}; xs += lv * wv; }
                    const float x = (xs[0] + xs[1]) + (xs[2] + xs[3]);
                    G += -softplusf_(-x) * (1.0f / 16.0f);
                    const float qv = qr[l0 + j] * 0.08838834764831845f, kv = kr[l0 + j];
                    const size_t o = ((size_t)(ck * 4 + h) * 64 + l) * 128 + k;
                    const float eG = __expf(G); gQg[o] = f2bf(qv * eG); const float kneg = kv * __builtin_amdgcn_rcpf(eG); gKn[o] = f2bf(kneg); kn[j] = kneg; }
                u32x4 a; a.x = pk2(kn[0], kn[1]); a.y = pk2(kn[2], kn[3]); a.z = pk2(kn[4], kn[5]); a.w = pk2(kn[6], kn[7]);
                *(u32x4*)(gKnT + ((size_t)(ck * 4 + h) * 128 + k) * 64 + lh + l0) = a;
            }
        }
        c.W<float>(WS_GDEC)[(size_t)ck * 512 + ch] = __expf(G);
    } else {
        const int ch = (blk - 1) * 512 + tid, h = ch >> 8, v = ch & 255;
        bf16_t* gVT = c.W<bf16_t>(WS_GVT);
        unsigned e[64];
#pragma unroll
        for (int l = 0; l < 64; ++l) e[l] = proj[(size_t)(t0 + l) * NP + C_GV + ch];
        PIN16(e, 0); PIN16(e, 16); PIN16(e, 32); PIN16(e, 48);
#pragma unroll
        for (int l0 = 0; l0 < 64; l0 += 8) {
            u32x4 a; a.x = e[l0] | (e[l0 + 1] << 16); a.y = e[l0 + 2] | (e[l0 + 3] << 16); a.z = e[l0 + 4] | (e[l0 + 5] << 16); a.w = e[l0 + 6] | (e[l0 + 7] << 16);
            *(u32x4*)(gVT + ((size_t)(ck * 4 + h) * 256 + v) * 64 + l0) = a;
        }
    }
}

#define SOLVE_ROW_BEGIN(i) { float a0 = x[i], a1 = 0.f, a2 = 0.f, a3 = 0.f; const float* mr = Ms + (i) * 68;
#define SOLVE_ROW_END(i) x[i] = (a0 + a1) + (a2 + a3); }
__device__ void dn_d1(const Ctx& c, int ip) {
    const bf16_t* proj = c.W<bf16_t>(WS_PROJ);
    const bf16_t* dq = c.W<bf16_t>(WS_DQ); const bf16_t* dk = c.W<bf16_t>(WS_DK); const bf16_t* dv = c.W<bf16_t>(WS_DV);
    const int tid = c.tid, half = tid >> 8, lt = tid & 255, lw = c.wave & 3, r = c.r, q = c.q;
    const int item = ip * 2 + half, ck = item >> 3, h = item & 7, t0 = ck * 64;
    float* Ms = c.ldsf + half * (64 * 68 + 256); float* beta_s = Ms + 64 * 68; float* gc_s = beta_s + 64; float* eg_s = gc_s + 64; float* ekd_s = eg_s + 64;
    const size_t ch = (size_t)(ck * 8 + h);
    __syncthreads();
    if (lt < 64) { const size_t rb = (size_t)(t0 + lt) * NP;
        beta_s[lt] = sigmoidf_(bf2f(proj[rb + C_DNB + h]));
        float g = -__expf(c.in(I_DNALOG)[c.layer * 8 + h]) * softplusf_(bf2f(proj[rb + C_DNA + h]) + c.in(I_DNDTB)[c.layer * 8 + h]);
#pragma unroll
        for (int d = 1; d < 64; d <<= 1) { const float o = __shfl_up(g, d); if ((lt & 63) >= d) g += o; }
        gc_s[lt] = g; eg_s[lt] = __expf(g); ekd_s[lt] = __expf(__shfl(g, 63) - g); }
    __syncthreads();
    {
        const int ib = lw;
        bf16_t* dAtt = c.W<bf16_t>(WS_DATT);
        bf16x8 fki[4], fqi[4];
#pragma unroll
        for (int kk = 0; kk < 4; ++kk) { fki[kk] = ldfrag(dk + (size_t)(t0 + ib * 16 + r) * 1024 + h * 128 + kk * 32 + q * 8); fqi[kk] = ldfrag(dq + (size_t)(t0 + ib * 16 + r) * 1024 + h * 128 + kk * 32 + q * 8); }
#pragma unroll
        for (int jb = 0; jb < 4; ++jb) {
            f32x4 aK = (f32x4){0.f, 0.f, 0.f, 0.f}, aA = aK;
            if (jb <= ib) {
#pragma unroll
                for (int kk = 0; kk < 4; ++kk) {
                    const bf16x8 fkj = ldfrag(dk + (size_t)(t0 + jb * 16 + r) * 1024 + h * 128 + kk * 32 + q * 8);
                    aK = mfma16(fki[kk], fkj, aK);
                    aA = mfma16(fkj, fqi[kk], aA);
                }
#pragma unroll
                for (int j = 0; j < 4; ++j) { const int i = ib * 16 + 4 * q + j, jj = jb * 16 + r;
                    Ms[i * 68 + jj] = (i > jj) ? beta_s[i] * aK[j] * __expf(gc_s[i] - gc_s[jj]) : 0.f; }
            }
            { const int i = ib * 16 + r; f32x4 o;
#pragma unroll
              for (int j = 0; j < 4; ++j) { const int jj = jb * 16 + 4 * q + j; o[j] = (i >= jj) ? aA[j] * __expf(gc_s[i] - gc_s[jj]) : 0.f; }
              *(u32x2*)(dAtt + (ch * 64 + i) * 64 + jb * 16 + 4 * q) = pk4(o); }
        }
    }
    float x[64];
    const int col = lt & 127; const bool isw = lt >= 128;
    const float glast = gc_s[63];
    {
        const bf16_t* src = (isw ? dk : dv) + (size_t)t0 * 1024 + h * 128 + col;
        { unsigned rw[64];
#pragma unroll
          for (int i = 0; i < 64; ++i) rw[i] = src[(size_t)i * 1024];
          PIN16(rw, 0); PIN16(rw, 16); PIN16(rw, 32); PIN16(rw, 48);
#pragma unroll
          for (int i = 0; i < 64; ++i) x[i] = __uint_as_float(rw[i] << 16); }
        if (isw) {
            bf16_t* dKdT = c.W<bf16_t>(WS_DKDT);
#pragma unroll
            for (int l0 = 0; l0 < 64; l0 += 8) { u32x4 a;
                a.x = pk2(x[l0 + 0] * ekd_s[l0 + 0], x[l0 + 1] * ekd_s[l0 + 1]); a.y = pk2(x[l0 + 2] * ekd_s[l0 + 2], x[l0 + 3] * ekd_s[l0 + 3]);
                a.z = pk2(x[l0 + 4] * ekd_s[l0 + 4], x[l0 + 5] * ekd_s[l0 + 5]); a.w = pk2(x[l0 + 6] * ekd_s[l0 + 6], x[l0 + 7] * ekd_s[l0 + 7]);
                *(u32x4*)(dKdT + (ch * 128 + col) * 64 + l0) = a; }
#pragma unroll
            for (int i = 0; i < 64; ++i) x[i] *= beta_s[i] * eg_s[i];
        } else {
            bf16_t* dQg = c.W<bf16_t>(WS_DQG); const bf16_t* qs = dq + (size_t)t0 * 1024 + h * 128 + col;
            unsigned qv[64];
#pragma unroll
            for (int i = 0; i < 64; ++i) qv[i] = qs[(size_t)i * 1024];
            PIN16(qv, 0); PIN16(qv, 16); PIN16(qv, 32); PIN16(qv, 48);
#pragma unroll
            for (int i = 0; i < 64; ++i) dQg[(ch * 64 + i) * 128 + col] = f2bf(__uint_as_float(qv[i] << 16) * eg_s[i]);
#pragma unroll
            for (int i = 0; i < 64; ++i) x[i] *= beta_s[i];
        }
    }
    if (lt == 0) c.W<float>(WS_DGL)[ch] = __expf(glast);
    __syncthreads();
    SOLVE_ROW_BEGIN(1)
    { const f32x4 m = *(const f32x4*)(mr + 0);
      a0 -= m[0] * x[0];
    }
    SOLVE_ROW_END(1)
    SOLVE_ROW_BEGIN(2)
    { const f32x4 m = *(const f32x4*)(mr + 0);
      a0 -= m[0] * x[0];
      a1 -= m[1] * x[1];
    }
    SOLVE_ROW_END(2)
    SOLVE_ROW_BEGIN(3)
    { const f32x4 m = *(const f32x4*)(mr + 0);
      a0 -= m[0] * x[0];
      a1 -= m[1] * x[1];
      a2 -= m[2] * x[2];
    }
    SOLVE_ROW_END(3)
    SOLVE_ROW_BEGIN(4)
    { const f32x4 m = *(const f32x4*)(mr + 0);
      a0 -= m[0] * x[0];
      a1 -= m[1] * x[1];
      a2 -= m[2] * x[2];
      a3 -= m[3] * x[3];
    }
    SOLVE_ROW_END(4)
    SOLVE_ROW_BEGIN(5)
    { const f32x4 m = *(const f32x4*)(mr + 0);
      a0 -= m[0] * x[0];
      a1 -= m[1] * x[1];
      a2 -= m[2] * x[2];
      a3 -= m[3] * x[3];
    }
    { const f32x4 m = *(const f32x4*)(mr + 4);
      a0 -= m[0] * x[4];
    }
    SOLVE_ROW_END(5)
    SOLVE_ROW_BEGIN(6)
    { const f32x4 m = *(const f32x4*)(mr + 0);
      a0 -= m[0] * x[0];
      a1 -= m[1] * x[1];
      a2 -= m[2] * x[2];
      a3 -= m[3] * x[3];
    }
    { const f32x4 m = *(const f32x4*)(mr + 4);
      a0 -= m[0] * x[4];
      a1 -= m[1] * x[5];
    }
    SOLVE_ROW_END(6)
    SOLVE_ROW_BEGIN(7)
    { const f32x4 m = *(const f32x4*)(mr + 0);
      a0 -= m[0] * x[0];
      a1 -= m[1] * x[1];
      a2 -= m[2] * x[2];
      a3 -= m[3] * x[3];
    }
    { const f32x4 m = *(const f32x4*)(mr + 4);
      a0 -= m[0] * x[4];
      a1 -= m[1] * x[5];
      a2 -= m[2] * x[6];
    }
    SOLVE_ROW_END(7)
    SOLVE_ROW_BEGIN(8)
    { const f32x4 m = *(const f32x4*)(mr + 0);
      a0 -= m[0] * x[0];
      a1 -= m[1] * x[1];
      a2 -= m[2] * x[2];
      a3 -= m[3] * x[3];
    }
    { const f32x4 m = *(const f32x4*)(mr + 4);
      a0 -= m[0] * x[4];
      a1 -= m[1] * x[5];
      a2 -= m[2] * x[6];
      a3 -= m[3] * x[7];
    }
    SOLVE_ROW_END(8)
    SOLVE_ROW_BEGIN(9)
    { const f32x4 m = *(const f32x4*)(mr + 0);
      a0 -= m[0] * x[0];
      a1 -= m[1] * x[1];
      a2 -= m[2] * x[2];
      a3 -= m[3] * x[3];
    }
    { const f32x4 m = *(const f32x4*)(mr + 4);
      a0 -= m[0] * x[4];
      a1 -= m[1] * x[5];
      a2 -= m[2] * x[6];
      a3 -= m[3] * x[7];
    }
    { const f32x4 m = *(const f32x4*)(mr + 8);
      a0 -= m[0] * x[8];
    }
    SOLVE_ROW_END(9)
    SOLVE_ROW_BEGIN(10)
    { const f32x4 m = *(const f32x4*)(mr + 0);
      a0 -= m[0] * x[0];
      a1 -= m[1] * x[1];
      a2 -= m[2] * x[2];
      a3 -= m[3] * x[3];
    }
    { const f32x4 m = *(const f32x4*)(mr + 4);
      a0 -= m[0] * x[4];
      a1 -= m[1] * x[5];
      a2 -= m[2] * x[6];
      a3 -= m[3] * x[7];
    }
    { const f32x4 m = *(const f32x4*)(mr + 8);
      a0 -= m[0] * x[8];
      a1 -= m[1] * x[9];
    }
    SOLVE_ROW_END(10)
    SOLVE_ROW_BEGIN(11)
    { const f32x4 m = *(const f32x4*)(mr + 0);
      a0 -= m[0] * x[0];
      a1 -= m[1] * x[1];
      a2 -= m[2] * x[2];
      a3 -= m[3] * x[3];
    }
    { const f32x4 m = *(const f32x4*)(mr + 4);
      a0 -= m[0] * x[4];
      a1 -= m[1] * x[5];
      a2 -= m[2] * x[6];
      a3 -= m[3] * x[7];
    }
    { const f32x4 m = *(const f32x4*)(mr + 8);
      a0 -= m[0] * x[8];
      a1 -= m[1] * x[9];
      a2 -= m[2] * x[10];
    }
    SOLVE_ROW_END(11)
    SOLVE_ROW_BEGIN(12)
    { const f32x4 m = *(const f32x4*)(mr + 0);
      a0 -= m[0] * x[0];
      a1 -= m[1] * x[1];
      a2 -= m[2] * x[2];
      a3 -= m[3] * x[3];
    }
    { const f32x4 m = *(const f32x4*)(mr + 4);
      a0 -= m[0] * x[4];
      a1 -= m[1] * x[5];
      a2 -= m[2] * x[6];
      a3 -= m[3] * x[7];
    }
    { const f32x4 m = *(const f32x4*)(mr + 8);
      a0 -= m[0] * x[8];
      a1 -= m[1] * x[9];
      a2 -= m[2] * x[10];
      a3 -= m[3] * x[11];
    }
    SOLVE_ROW_END(12)
    SOLVE_ROW_BEGIN(13)
    { const f32x4 m = *(const f32x4*)(mr + 0);
      a0 -= m[0] * x[0];
      a1 -= m[1] * x[1];
      a2 -= m[2] * x[2];
      a3 -= m[3] * x[3];
    }
    { const f32x4 m = *(const f32x4*)(mr + 4);
      a0 -= m[0] * x[4];
      a1 -= m[1] * x[5];
      a2 -= m[2] * x[6];
      a3 -= m[3] * x[7];
    }
    { const f32x4 m = *(const f32x4*)(mr + 8);
      a0 -= m[0] * x[8];
      a1 -= m[1] * x[9];
      a2 -= m[2] * x[10];
      a3 -= m[3] * x[11];
    }
    { const f32x4 m = *(const f32x4*)(mr + 12);
      a0 -= m[0] * x[12];
    }
    SOLVE_ROW_END(13)
    SOLVE_ROW_BEGIN(14)
    { const f32x4 m = *(const f32x4*)(mr + 0);
      a0 -= m[0] * x[0];
      a1 -= m[1] * x[1];
      a2 -= m[2] * x[2];
      a3 -= m[3] * x[3];
    }
    { const f32x4 m = *(const f32x4*)(mr + 4);
      a0 -= m[0] * x[4];
      a1 -= m[1] * x[5];
      a2 -= m[2] * x[6];
      a3 -= m[3] * x[7];
    }
    { const f32x4 m = *(const f32x4*)(mr + 8);
      a0 -= m[0] * x[8];
      a1 -= m[1] * x[9];
      a2 -= m[2] * x[10];
      a3 -= m[3] * x[11];
    }
    { const f32x4 m = *(const f32x4*)(mr + 12);
      a0 -= m[0] * x[12];
      a1 -= m[1] * x[13];
    }
    SOLVE_ROW_END(14)
    SOLVE_ROW_BEGIN(15)
    { const f32x4 m = *(const f32x4*)(mr + 0);
      a0 -= m[0] * x[0];
      a1 -= m[1] * x[1];
      a2 -= m[2] * x[2];
      a3 -= m[3] * x[3];
    }
    { const f32x4 m = *(const f32x4*)(mr + 4);
      a0 -= m[0] * x[4];
      a1 -= m[1] * x[5];
      a2 -= m[2] * x[6];
      a3 -= m[3] * x[7];
    }
    { const f32x4 m = *(const f32x4*)(mr + 8);
      a0 -= m[0] * x[8];
      a1 -= m[1] * x[9];
      a2 -= m[2] * x[10];
      a3 -= m[3] * x[11];
    }
    { const f32x4 m = *(const f32x4*)(mr + 12);
      a0 -= m[0] * x[12];
      a1 -= m[1] * x[13];
      a2 -= m[2] * x[14];
    }
    SOLVE_ROW_END(15)
    SOLVE_ROW_BEGIN(16)
    { const f32x4 m = *(const f32x4*)(mr + 0);
      a0 -= m[0] * x[0];
      a1 -= m[1] * x[1];
      a2 -= m[2] * x[2];
      a3 -= m[3] * x[3];
    }
    { const f32x4 m = *(const f32x4*)(mr + 4);
      a0 -= m[0] * x[4];
      a1 -= m[1] * x[5];
      a2 -= m[2] * x[6];
      a3 -= m[3] * x[7];
    }
    { const f32x4 m = *(const f32x4*)(mr + 8);
      a0 -= m[0] * x[8];
      a1 -= m[1] * x[9];
      a2 -= m[2] * x[10];
      a3 -= m[3] * x[11];
    }
    { const f32x4 m = *(const f32x4*)(mr + 12);
      a0 -= m[0] * x[12];
      a1 -= m[1] * x[13];
      a2 -= m[2] * x[14];
      a3 -= m[3] * x[15];
    }
    SOLVE_ROW_END(16)
    SOLVE_ROW_BEGIN(17)
    { const f32x4 m = *(const f32x4*)(mr + 0);
      a0 -= m[0] * x[0];
      a1 -= m[1] * x[1];
      a2 -= m[2] * x[2];
      a3 -= m[3] * x[3];
    }
    { const f32x4 m = *(const f32x4*)(mr + 4);
      a0 -= m[0] * x[4];
      a1 -= m[1] * x[5];
      a2 -= m[2] * x[6];
      a3 -= m[3] * x[7];
    }
    { const f32x4 m = *(const f32x4*)(mr + 8);
      a0 -= m[0] * x[8];
      a1 -= m[1] * x[9];
      a2 -= m[2] * x[10];
      a3 -= m[3] * x[11];
    }
    { const f32x4 m = *(const f32x4*)(mr + 12);
      a0 -= m[0] * x[12];
      a1 -= m[1] * x[13];
      a2 -= m[2] * x[14];
      a3 -= m[3] * x[15];
    }
    { const f32x4 m = *(const f32x4*)(mr + 16);
      a0 -= m[0] * x[16];
    }
    SOLVE_ROW_END(17)
    SOLVE_ROW_BEGIN(18)
    { const f32x4 m = *(const f32x4*)(mr + 0);
      a0 -= m[0] * x[0];
      a1 -= m[1] * x[1];
      a2 -= m[2] * x[2];
      a3 -= m[3] * x[3];
    }
    { const f32x4 m = *(const f32x4*)(mr + 4);
      a0 -= m[0] * x[4];
      a1 -= m[1] * x[5];
      a2 -= m[2] * x[6];
      a3 -= m[3] * x[7];
    }
    { const f32x4 m = *(const f32x4*)(mr + 8);
      a0 -= m[0] * x[8];
      a1 -= m[1] * x[9];
      a2 -= m[2] * x[10];
      a3 -= m[3] * x[11];
    }
    { const f32x4 m = *(const f32x4*)(mr + 12);
      a0 -= m[0] * x[12];
      a1 -= m[1] * x[13];
      a2 -= m[2] * x[14];
      a3 -= m[3] * x[15];
    }
    { const f32x4 m = *(const f32x4*)(mr + 16);
      a0 -= m[0] * x[16];
      a1 -= m[1] * x[17];
    }
    SOLVE_ROW_END(18)
    SOLVE_ROW_BEGIN(19)
    { const f32x4 m = *(const f32x4*)(mr + 0);
      a0 -= m[0] * x[0];
      a1 -= m[1] * x[1];
      a2 -= m[2] * x[2];
      a3 -= m[3] * x[3];
    }
    { const f32x4 m = *(const f32x4*)(mr + 4);
      a0 -= m[0] * x[4];
      a1 -= m[1] * x[5];
      a2 -= m[2] * x[6];
      a3 -= m[3] * x[7];
    }
    { const f32x4 m = *(const f32x4*)(mr + 8);
      a0 -= m[0] * x[8];
      a1 -= m[1] * x[9];
      a2 -= m[2] * x[10];
      a3 -= m[3] * x[11];
    }
    { const f32x4 m = *(const f32x4*)(mr + 12);
      a0 -= m[0] * x[12];
      a1 -= m[1] * x[13];
      a2 -= m[2] * x[14];
      a3 -= m[3] * x[15];
    }
    { const f32x4 m = *(const f32x4*)(mr + 16);
      a0 -= m[0] * x[16];
      a1 -= m[1] * x[17];
      a2 -= m[2] * x[18];
    }
    SOLVE_ROW_END(19)
    SOLVE_ROW_BEGIN(20)
    { const f32x4 m = *(const f32x4*)(mr + 0);
      a0 -= m[0] * x[0];
      a1 -= m[1] * x[1];
      a2 -= m[2] * x[2];
      a3 -= m[3] * x[3];
    }
    { const f32x4 m = *(const f32x4*)(mr + 4);
      a0 -= m[0] * x[4];
      a1 -= m[1] * x[5];
      a2 -= m[2] * x[6];
      a3 -= m[3] * x[7];
    }
    { const f32x4 m = *(const f32x4*)(mr + 8);
      a0 -= m[0] * x[8];
      a1 -= m[1] * x[9];
      a2 -= m[2] * x[10];
      a3 -= m[3] * x[11];
    }
    { const f32x4 m = *(const f32x4*)(mr + 12);
      a0 -= m[0] * x[12];
      a1 -= m[1] * x[13];
      a2 -= m[2] * x[14];
      a3 -= m[3] * x[15];
    }
    { const f32x4 m = *(const f32x4*)(mr + 16);
      a0 -= m[0] * x[16];
      a1 -= m[1] * x[17];
      a2 -= m[2] * x[18];
      a3 -= m[3] * x[19];
    }
    SOLVE_ROW_END(20)
    SOLVE_ROW_BEGIN(21)
    { const f32x4 m = *(const f32x4*)(mr + 0);
      a0 -= m[0] * x[0];
      a1 -= m[1] * x[1];
      a2 -= m[2] * x[2];
      a3 -= m[3] * x[3];
    }
    { const f32x4 m = *(const f32x4*)(mr + 4);
      a0 -= m[0] * x[4];
      a1 -= m[1] * x[5];
      a2 -= m[2] * x[6];
      a3 -= m[3] * x[7];
    }
    { const f32x4 m = *(const f32x4*)(mr + 8);
      a0 -= m[0] * x[8];
      a1 -= m[1] * x[9];
      a2 -= m[2] * x[10];
      a3 -= m[3] * x[11];
    }
    { const f32x4 m = *(const f32x4*)(mr + 12);
      a0 -= m[0] * x[12];
      a1 -= m[1] * x[13];
      a2 -= m[2] * x[14];
      a3 -= m[3] * x[15];
    }
    { const f32x4 m = *(const f32x4*)(mr + 16);
      a0 -= m[0] * x[16];
      a1 -= m[1] * x[17];
      a2 -= m[2] * x[18];
      a3 -= m[3] * x[19];
    }
    { const f32x4 m = *(const f32x4*)(mr + 20);
      a0 -= m[0] * x[20];
    }
    SOLVE_ROW_END(21)
    SOLVE_ROW_BEGIN(22)
    { const f32x4 m = *(const f32x4*)(mr + 0);
      a0 -= m[0] * x[0];
      a1 -= m[1] * x[1];
      a2 -= m[2] * x[2];
      a3 -= m[3] * x[3];
    }
    { const f32x4 m = *(const f32x4*)(mr + 4);
      a0 -= m[0] * x[4];
      a1 -= m[1] * x[5];
      a2 -= m[2] * x[6];
      a3 -= m[3] * x[7];
    }
    { const f32x4 m = *(const f32x4*)(mr + 8);
      a0 -= m[0] * x[8];
      a1 -= m[1] * x[9];
      a2 -= m[2] * x[10];
      a3 -= m[3] * x[11];
    }
    { const f32x4 m = *(const f32x4*)(mr + 12);
      a0 -= m[0] * x[12];
      a1 -= m[1] * x[13];
      a2 -= m[2] * x[14];
      a3 -= m[3] * x[15];
    }
    { const f32x4 m = *(const f32x4*)(mr + 16);
      a0 -= m[0] * x[16];
      a1 -= m[1] * x[17];
      a2 -= m[2] * x[18];
      a3 -= m[3] * x[19];
    }
    { const f32x4 m = *(const f32x4*)(mr + 20);
      a0 -= m[0] * x[20];
      a1 -= m[1] * x[21];
    }
    SOLVE_ROW_END(22)
    SOLVE_ROW_BEGIN(23)
    { const f32x4 m = *(const f32x4*)(mr + 0);
      a0 -= m[0] * x[0];
      a1 -= m[1] * x[1];
      a2 -= m[2] * x[2];
      a3 -= m[3] * x[3];
    }
    { const f32x4 m = *(const f32x4*)(mr + 4);
      a0 -= m[0] * x[4];
      a1 -= m[1] * x[5];
      a2 -= m[2] * x[6];
      a3 -= m[3] * x[7];
    }
    { const f32x4 m = *(const f32x4*)(mr + 8);
      a0 -= m[0] * x[8];
      a1 -= m[1] * x[9];
      a2 -= m[2] * x[10];
      a3 -= m[3] * x[11];
    }
    { const f32x4 m = *(const f32x4*)(mr + 12);
      a0 -= m[0] * x[12];
      a1 -= m[1] * x[13];
      a2 -= m[2] * x[14];
      a3 -= m[3] * x[15];
    }
    { const f32x4 m = *(const f32x4*)(mr + 16);
      a0 -= m[0] * x[16];
      a1 -= m[1] * x[17];
      a2 -= m[2] * x[18];
      a3 -= m[3] * x[19];
    }
    { const f32x4 m = *(const f32x4*)(mr + 20);
      a0 -= m[0] * x[20];
      a1 -= m[1] * x[21];
      a2 -= m[2] * x[22];
    }
    SOLVE_ROW_END(23)
    SOLVE_ROW_BEGIN(24)
    { const f32x4 m = *(const f32x4*)(mr + 0);
      a0 -= m[0] * x[0];
      a1 -= m[1] * x[1];
      a2 -= m[2] * x[2];
      a3 -= m[3] * x[3];
    }
    { const f32x4 m = *(const f32x4*)(mr + 4);
      a0 -= m[0] * x[4];
      a1 -= m[1] * x[5];
      a2 -= m[2] * x[6];
      a3 -= m[3] * x[7];
    }
    { const f32x4 m = *(const f32x4*)(mr + 8);
      a0 -= m[0] * x[8];
      a1 -= m[1] * x[9];
      a2 -= m[2] * x[10];
      a3 -= m[3] * x[11];
    }
    { const f32x4 m = *(const f32x4*)(mr + 12);
      a0 -= m[0] * x[12];
      a1 -= m[1] * x[13];
      a2 -= m[2] * x[14];
      a3 -= m[3] * x[15];
    }
    { const f32x4 m = *(const f32x4*)(mr + 16);
      a0 -= m[0] * x[16];
      a1 -= m[1] * x[17];
      a2 -= m[2] * x[18];
      a3 -= m[3] * x[19];
    }
    { const f32x4 m = *(const f32x4*)(mr + 20);
      a0 -= m[0] * x[20];
      a1 -= m[1] * x[21];
      a2 -= m[2] * x[22];
      a3 -= m[3] * x[23];
    }
    SOLVE_ROW_END(24)
    SOLVE_ROW_BEGIN(25)
    { const f32x4 m = *(const f32x4*)(mr + 0);
      a0 -= m[0] * x[0];
      a1 -= m[1] * x[1];
      a2 -= m[2] * x[2];
      a3 -= m[3] * x[3];
    }
    { const f32x4 m = *(const f32x4*)(mr + 4);
      a0 -= m[0] * x[4];
      a1 -= m[1] * x[5];
      a2 -= m[2] * x[6];
      a3 -= m[3] * x[7];
    }
    { const f32x4 m = *(const f32x4*)(mr + 8);
      a0 -= m[0] * x[8];
      a1 -= m[1] * x[9];
      a2 -= m[2] * x[10];
      a3 -= m[3] * x[11];
    }
    { const f32x4 m = *(const f32x4*)(mr + 12);
      a0 -= m[0] * x[12];
      a1 -= m[1] * x[13];
      a2 -= m[2] * x[14];
      a3 -= m[3] * x[15];
    }
    { const f32x4 m = *(const f32x4*)(mr + 16);
      a0 -= m[0] * x[16];
      a1 -= m[1] * x[17];
      a2 -= m[2] * x[18];
      a3 -= m[3] * x[19];
    }
    { const f32x4 m = *(const f32x4*)(mr + 20);
      a0 -= m[0] * x[20];
      a1 -= m[1] * x[21];
      a2 -= m[2] * x[22];
      a3 -= m[3] * x[23];
    }
    { const f32x4 m = *(const f32x4*)(mr + 24);
      a0 -= m[0] * x[24];
    }
    SOLVE_ROW_END(25)
    SOLVE_ROW_BEGIN(26)
    { const f32x4 m = *(const f32x4*)(mr + 0);
      a0 -= m[0] * x[0];
      a1 -= m[1] * x[1];
      a2 -= m[2] * x[2];
      a3 -= m[3] * x[3];
    }
    { const f32x4 m = *(const f32x4*)(mr + 4);
      a0 -= m[0] * x[4];
      a1 -= m[1] * x[5];
      a2 -= m[2] * x[6];
      a3 -= m[3] * x[7];
    }
    { const f32x4 m = *(const f32x4*)(mr + 8);
      a0 -= m[0] * x[8];
      a1 -= m[1] * x[9];
      a2 -= m[2] * x[10];
      a3 -= m[3] * x[11];
    }
    { const f32x4 m = *(const f32x4*)(mr + 12);
      a0 -= m[0] * x[12];
      a1 -= m[1] * x[13];
      a2 -= m[2] * x[14];
      a3 -= m[3] * x[15];
    }
    { const f32x4 m = *(const f32x4*)(mr + 16);
      a0 -= m[0] * x[16];
      a1 -= m[1] * x[17];
      a2 -= m[2] * x[18];
      a3 -= m[3] * x[19];
    }
    { const f32x4 m = *(const f32x4*)(mr + 20);
      a0 -= m[0] * x[20];
      a1 -= m[1] * x[21];
      a2 -= m[2] * x[22];
      a3 -= m[3] * x[23];
    }
    { const f32x4 m = *(const f32x4*)(mr + 24);
      a0 -= m[0] * x[24];
      a1 -= m[1] * x[25];
    }
    SOLVE_ROW_END(26)
    SOLVE_ROW_BEGIN(27)
    { const f32x4 m = *(const f32x4*)(mr + 0);
      a0 -= m[0] * x[0];
      a1 -= m[1] * x[1];
      a2 -= m[2] * x[2];
      a3 -= m[3] * x[3];
    }
    { const f32x4 m = *(const f32x4*)(mr + 4);
      a0 -= m[0] * x[4];
      a1 -= m[1] * x[5];
      a2 -= m[2] * x[6];
      a3 -= m[3] * x[7];
    }
    { const f32x4 m = *(const f32x4*)(mr + 8);
      a0 -= m[0] * x[8];
      a1 -= m[1] * x[9];
      a2 -= m[2] * x[10];
      a3 -= m[3] * x[11];
    }
    { const f32x4 m = *(const f32x4*)(mr + 12);
      a0 -= m[0] * x[12];
      a1 -= m[1] * x[13];
      a2 -= m[2] * x[14];
      a3 -= m[3] * x[15];
    }
    { const f32x4 m = *(const f32x4*)(mr + 16);
      a0 -= m[0] * x[16];
      a1 -= m[1] * x[17];
      a2 -= m[2] * x[18];
      a3 -= m[3] * x[19];
    }
    { const f32x4 m = *(const f32x4*)(mr + 20);
      a0 -= m[0] * x[20];
      a1 -= m[1] * x[21];
      a2 -= m[2] * x[22];
      a3 -= m[3] * x[23];
    }
    { const f32x4 m = *(const f32x4*)(mr + 24);
      a0 -= m[0] * x[24];
      a1 -= m[1] * x[25];
      a2 -= m[2] * x[26];
    }
    SOLVE_ROW_END(27)
    SOLVE_ROW_BEGIN(28)
    { const f32x4 m = *(const f32x4*)(mr + 0);
      a0 -= m[0] * x[0];
      a1 -= m[1] * x[1];
      a2 -= m[2] * x[2];
      a3 -= m[3] * x[3];
    }
    { const f32x4 m = *(const f32x4*)(mr + 4);
      a0 -= m[0] * x[4];
      a1 -= m[1] * x[5];
      a2 -= m[2] * x[6];
      a3 -= m[3] * x[7];
    }
    { const f32x4 m = *(const f32x4*)(mr + 8);
      a0 -= m[0] * x[8];
      a1 -= m[1] * x[9];
      a2 -= m[2] * x[10];
      a3 -= m[3] * x[11];
    }
    { const f32x4 m = *(const f32x4*)(mr + 12);
      a0 -= m[0] * x[12];
      a1 -= m[1] * x[13];
      a2 -= m[2] * x[14];
      a3 -= m[3] * x[15];
    }
    { const f32x4 m = *(const f32x4*)(mr + 16);
      a0 -= m[0] * x[16];
      a1 -= m[1] * x[17];
      a2 -= m[2] * x[18];
      a3 -= m[3] * x[19];
    }
    { const f32x4 m = *(const f32x4*)(mr + 20);
      a0 -= m[0] * x[20];
      a1 -= m[1] * x[21];
      a2 -= m[2] * x[22];
      a3 -= m[3] * x[23];
    }
    { const f32x4 m = *(const f32x4*)(mr + 24);
      a0 -= m[0] * x[24];
      a1 -= m[1] * x[25];
      a2 -= m[2] * x[26];
      a3 -= m[3] * x[27];
    }
    SOLVE_ROW_END(28)
    SOLVE_ROW_BEGIN(29)
    { const f32x4 m = *(const f32x4*)(mr + 0);
      a0 -= m[0] * x[0];
      a1 -= m[1] * x[1];
      a2 -= m[2] * x[2];
      a3 -= m[3] * x[3];
    }
    { const f32x4 m = *(const f32x4*)(mr + 4);
      a0 -= m[0] * x[4];
      a1 -= m[1] * x[5];
      a2 -= m[2] * x[6];
      a3 -= m[3] * x[7];
    }
    { const f32x4 m = *(const f32x4*)(mr + 8);
      a0 -= m[0] * x[8];
      a1 -= m[1] * x[9];
      a2 -= m[2] * x[10];
      a3 -= m[3] * x[11];
    }
    { const f32x4 m = *(const f32x4*)(mr + 12);
      a0 -= m[0] * x[12];
      a1 -= m[1] * x[13];
      a2 -= m[2] * x[14];
      a3 -= m[3] * x[15];
    }
    { const f32x4 m = *(const f32x4*)(mr + 16);
      a0 -= m[0] * x[16];
      a1 -= m[1] * x[17];
      a2 -= m[2] * x[18];
      a3 -= m[3] * x[19];
    }
    { const f32x4 m = *(const f32x4*)(mr + 20);
      a0 -= m[0] * x[20];
      a1 -= m[1] * x[21];
      a2 -= m[2] * x[22];
      a3 -= m[3] * x[23];
    }
    { const f32x4 m = *(const f32x4*)(mr + 24);
      a0 -= m[0] * x[24];
      a1 -= m[1] * x[25];
      a2 -= m[2] * x[26];
      a3 -= m[3] * x[27];
    }
    { const f32x4 m = *(const f32x4*)(mr + 28);
      a0 -= m[0] * x[28];
    }
    SOLVE_ROW_END(29)
    SOLVE_ROW_BEGIN(30)
    { const f32x4 m = *(const f32x4*)(mr + 0);
      a0 -= m[0] * x[0];
      a1 -= m[1] * x[1];
      a2 -= m[2] * x[2];
      a3 -= m[3] * x[3];
    }
    { const f32x4 m = *(const f32x4*)(mr + 4);
      a0 -= m[0] * x[4];
      a1 -= m[1] * x[5];
      a2 -= m[2] * x[6];
      a3 -= m[3] * x[7];
    }
    { const f32x4 m = *(const f32x4*)(mr + 8);
      a0 -= m[0] * x[8];
      a1 -= m[1] * x[9];
      a2 -= m[2] * x[10];
      a3 -= m[3] * x[11];
    }
    { const f32x4 m = *(const f32x4*)(mr + 12);
      a0 -= m[0] * x[12];
      a1 -= m[1] * x[13];
      a2 -= m[2] * x[14];
      a3 -= m[3] * x[15];
    }
    { const f32x4 m = *(const f32x4*)(mr + 16);
      a0 -= m[0] * x[16];
      a1 -= m[1] * x[17];
      a2 -= m[2] * x[18];
      a3 -= m[3] * x[19];
    }
    { const f32x4 m = *(const f32x4*)(mr + 20);
      a0 -= m[0] * x[20];
      a1 -= m[1] * x[21];
      a2 -= m[2] * x[22];
      a3 -= m[3] * x[23];
    }
    { const f32x4 m = *(const f32x4*)(mr + 24);
      a0 -= m[0] * x[24];
      a1 -= m[1] * x[25];
      a2 -= m[2] * x[26];
      a3 -= m[3] * x[27];
    }
    { const f32x4 m = *(const f32x4*)(mr + 28);
      a0 -= m[0] * x[28];
      a1 -= m[1] * x[29];
    }
    SOLVE_ROW_END(30)
    SOLVE_ROW_BEGIN(31)
    { const f32x4 m = *(const f32x4*)(mr + 0);
      a0 -= m[0] * x[0];
      a1 -= m[1] * x[1];
      a2 -= m[2] * x[2];
      a3 -= m[3] * x[3];
    }
    { const f32x4 m = *(const f32x4*)(mr + 4);
      a0 -= m[0] * x[4];
      a1 -= m[1] * x[5];
      a2 -= m[2] * x[6];
      a3 -= m[3] * x[7];
    }
    { const f32x4 m = *(const f32x4*)(mr + 8);
      a0 -= m[0] * x[8];
      a1 -= m[1] * x[9];
      a2 -= m[2] * x[10];
      a3 -= m[3] * x[11];
    }
    { const f32x4 m = *(const f32x4*)(mr + 12);
      a0 -= m[0] * x[12];
      a1 -= m[1] * x[13];
      a2 -= m[2] * x[14];
      a3 -= m[3] * x[15];
    }
    { const f32x4 m = *(const f32x4*)(mr + 16);
      a0 -= m[0] * x[16];
      a1 -= m[1] * x[17];
      a2 -= m[2] * x[18];
      a3 -= m[3] * x[19];
    }
    { const f32x4 m = *(const f32x4*)(mr + 20);
      a0 -= m[0] * x[20];
      a1 -= m[1] * x[21];
      a2 -= m[2] * x[22];
      a3 -= m[3] * x[23];
    }
    { const f32x4 m = *(const f32x4*)(mr + 24);
      a0 -= m[0] * x[24];
      a1 -= m[1] * x[25];
      a2 -= m[2] * x[26];
      a3 -= m[3] * x[27];
    }
    { const f32x4 m = *(const f32x4*)(mr + 28);
      a0 -= m[0] * x[28];
      a1 -= m[1] * x[29];
      a2 -= m[2] * x[30];
    }
    SOLVE_ROW_END(31)
    SOLVE_ROW_BEGIN(32)
    { const f32x4 m = *(const f32x4*)(mr + 0);
      a0 -= m[0] * x[0];
      a1 -= m[1] * x[1];
      a2 -= m[2] * x[2];
      a3 -= m[3] * x[3];
    }
    { const f32x4 m = *(const f32x4*)(mr + 4);
      a0 -= m[0] * x[4];
      a1 -= m[1] * x[5];
      a2 -= m[2] * x[6];
      a3 -= m[3] * x[7];
    }
    { const f32x4 m = *(const f32x4*)(mr + 8);
      a0 -= m[0] * x[8];
      a1 -= m[1] * x[9];
      a2 -= m[2] * x[10];
      a3 -= m[3] * x[11];
    }
    { const f32x4 m = *(const f32x4*)(mr + 12);
      a0 -= m[0] * x[12];
      a1 -= m[1] * x[13];
      a2 -= m[2] * x[14];
      a3 -= m[3] * x[15];
    }
    { const f32x4 m = *(const f32x4*)(mr + 16);
      a0 -= m[0] * x[16];
      a1 -= m[1] * x[17];
      a2 -= m[2] * x[18];
      a3 -= m[3] * x[19];
    }
    { const f32x4 m = *(const f32x4*)(mr + 20);
      a0 -= m[0] * x[20];
      a1 -= m[1] * x[21];
      a2 -= m[2] * x[22];
      a3 -= m[3] * x[23];
    }
    { const f32x4 m = *(const f32x4*)(mr + 24);
      a0 -= m[0] * x[24];
      a1 -= m[1] * x[25];
      a2 -= m[2] * x[26];
      a3 -= m[3] * x[27];
    }
    { const f32x4 m = *(const f32x4*)(mr + 28);
      a0 -= m[0] * x[28];
      a1 -= m[1] * x[29];
      a2 -= m[2] * x[30];
      a3 -= m[3] * x[31];
    }
    SOLVE_ROW_END(32)
    SOLVE_ROW_BEGIN(33)
    { const f32x4 m = *(const f32x4*)(mr + 0);
      a0 -= m[0] * x[0];
      a1 -= m[1] * x[1];
      a2 -= m[2] * x[2];
      a3 -= m[3] * x[3];
    }
    { const f32x4 m = *(const f32x4*)(mr + 4);
      a0 -= m[0] * x[4];
      a1 -= m[1] * x[5];
      a2 -= m[2] * x[6];
      a3 -= m[3] * x[7];
    }
    { const f32x4 m = *(const f32x4*)(mr + 8);
      a0 -= m[0] * x[8];
      a1 -= m[1] * x[9];
      a2 -= m[2] * x[10];
      a3 -= m[3] * x[11];
    }
    { const f32x4 m = *(const f32x4*)(mr + 12);
      a0 -= m[0] * x[12];
      a1 -= m[1] * x[13];
      a2 -= m[2] * x[14];
      a3 -= m[3] * x[15];
    }
    { const f32x4 m = *(const f32x4*)(mr + 16);
      a0 -= m[0] * x[16];
      a1 -= m[1] * x[17];
      a2 -= m[2] * x[18];
      a3 -= m[3] * x[19];
    }
    { const f32x4 m = *(const f32x4*)(mr + 20);
      a0 -= m[0] * x[20];
      a1 -= m[1] * x[21];
      a2 -= m[2] * x[22];
      a3 -= m[3] * x[23];
    }
    { const f32x4 m = *(const f32x4*)(mr + 24);
      a0 -= m[0] * x[24];
      a1 -= m[1] * x[25];
      a2 -= m[2] * x[26];
      a3 -= m[3] * x[27];
    }
    { const f32x4 m = *(const f32x4*)(mr + 28);
      a0 -= m[0] * x[28];
      a1 -= m[1] * x[29];
      a2 -= m[2] * x[30];
      a3 -= m[3] * x[31];
    }
    { const f32x4 m = *(const f32x4*)(mr + 32);
      a0 -= m[0] * x[32];
    }
    SOLVE_ROW_END(33)
    SOLVE_ROW_BEGIN(34)
    { const f32x4 m = *(const f32x4*)(mr + 0);
      a0 -= m[0] * x[0];
      a1 -= m[1] * x[1];
      a2 -= m[2] * x[2];
      a3 -= m[3] * x[3];
    }
    { const f32x4 m = *(const f32x4*)(mr + 4);
      a0 -= m[0] * x[4];
      a1 -= m[1] * x[5];
      a2 -= m[2] * x[6];
      a3 -= m[3] * x[7];
    }
    { const f32x4 m = *(const f32x4*)(mr + 8);
      a0 -= m[0] * x[8];
      a1 -= m[1] * x[9];
      a2 -= m[2] * x[10];
      a3 -= m[3] * x[11];
    }
    { const f32x4 m = *(const f32x4*)(mr + 12);
      a0 -= m[0] * x[12];
      a1 -= m[1] * x[13];
      a2 -= m[2] * x[14];
      a3 -= m[3] * x[15];
    }
    { const f32x4 m = *(const f32x4*)(mr + 16);
      a0 -= m[0] * x[16];
      a1 -= m[1] * x[17];
      a2 -= m[2] * x[18];
      a3 -= m[3] * x[19];
    }
    { const f32x4 m = *(const f32x4*)(mr + 20);
      a0 -= m[0] * x[20];
      a1 -= m[1] * x[21];
      a2 -= m[2] * x[22];
      a3 -= m[3] * x[23];
    }
    { const f32x4 m = *(const f32x4*)(mr + 24);
      a0 -= m[0] * x[24];
      a1 -= m[1] * x[25];
      a2 -= m[2] * x[26];
      a3 -= m[3] * x[27];
    }
    { const f32x4 m = *(const f32x4*)(mr + 28);
      a0 -= m[0] * x[28];
      a1 -= m[1] * x[29];
      a2 -= m[2] * x[30];
      a3 -= m[3] * x[31];
    }
    { const f32x4 m = *(const f32x4*)(mr + 32);
      a0 -= m[0] * x[32];
      a1 -= m[1] * x[33];
    }
    SOLVE_ROW_END(34)
    SOLVE_ROW_BEGIN(35)
    { const f32x4 m = *(const f32x4*)(mr + 0);
      a0 -= m[0] * x[0];
      a1 -= m[1] * x[1];
      a2 -= m[2] * x[2];
      a3 -= m[3] * x[3];
    }
    { const f32x4 m = *(const f32x4*)(mr + 4);
      a0 -= m[0] * x[4];
      a1 -= m[1] * x[5];
      a2 -= m[2] * x[6];
      a3 -= m[3] * x[7];
    }
    { const f32x4 m = *(const f32x4*)(mr + 8);
      a0 -= m[0] * x[8];
      a1 -= m[1] * x[9];
      a2 -= m[2] * x[10];
      a3 -= m[3] * x[11];
    }
    { const f32x4 m = *(const f32x4*)(mr + 12);
      a0 -= m[0] * x[12];
      a1 -= m[1] * x[13];
      a2 -= m[2] * x[14];
      a3 -= m[3] * x[15];
    }
    { const f32x4 m = *(const f32x4*)(mr + 16);
      a0 -= m[0] * x[16];
      a1 -= m[1] * x[17];
      a2 -= m[2] * x[18];
      a3 -= m[3] * x[19];
    }
    { const f32x4 m = *(const f32x4*)(mr + 20);
      a0 -= m[0] * x[20];
      a1 -= m[1] * x[21];
      a2 -= m[2] * x[22];
      a3 -= m[3] * x[23];
    }
    { const f32x4 m = *(const f32x4*)(mr + 24);
      a0 -= m[0] * x[24];
      a1 -= m[1] * x[25];
      a2 -= m[2] * x[26];
      a3 -= m[3] * x[27];
    }
    { const f32x4 m = *(const f32x4*)(mr + 28);
      a0 -= m[0] * x[28];
      a1 -= m[1] * x[29];
      a2 -= m[2] * x[30];
      a3 -= m[3] * x[31];
    }
    { const f32x4 m = *(const f32x4*)(mr + 32);
      a0 -= m[0] * x[32];
      a1 -= m[1] * x[33];
      a2 -= m[2] * x[34];
    }
    SOLVE_ROW_END(35)
    SOLVE_ROW_BEGIN(36)
    { const f32x4 m = *(const f32x4*)(mr + 0);
      a0 -= m[0] * x[0];
      a1 -= m[1] * x[1];
      a2 -= m[2] * x[2];
      a3 -= m[3] * x[3];
    }
    { const f32x4 m = *(const f32x4*)(mr + 4);
      a0 -= m[0] * x[4];
      a1 -= m[1] * x[5];
      a2 -= m[2] * x[6];
      a3 -= m[3] * x[7];
    }
    { const f32x4 m = *(const f32x4*)(mr + 8);
      a0 -= m[0] * x[8];
      a1 -= m[1] * x[9];
      a2 -= m[2] * x[10];
      a3 -= m[3] * x[11];
    }
    { const f32x4 m = *(const f32x4*)(mr + 12);
      a0 -= m[0] * x[12];
      a1 -= m[1] * x[13];
      a2 -= m[2] * x[14];
      a3 -= m[3] * x[15];
    }
    { const f32x4 m = *(const f32x4*)(mr + 16);
      a0 -= m[0] * x[16];
      a1 -= m[1] * x[17];
      a2 -= m[2] * x[18];
      a3 -= m[3] * x[19];
    }
    { const f32x4 m = *(const f32x4*)(mr + 20);
      a0 -= m[0] * x[20];
      a1 -= m[1] * x[21];
      a2 -= m[2] * x[22];
      a3 -= m[3] * x[23];
    }
    { const f32x4 m = *(const f32x4*)(mr + 24);
      a0 -= m[0] * x[24];
      a1 -= m[1] * x[25];
      a2 -= m[2] * x[26];
      a3 -= m[3] * x[27];
    }
    { const f32x4 m = *(const f32x4*)(mr + 28);
      a0 -= m[0] * x[28];
      a1 -= m[1] * x[29];
      a2 -= m[2] * x[30];
      a3 -= m[3] * x[31];
    }
    { const f32x4 m = *(const f32x4*)(mr + 32);
      a0 -= m[0] * x[32];
      a1 -= m[1] * x[33];
      a2 -= m[2] * x[34];
      a3 -= m[3] * x[35];
    }
    SOLVE_ROW_END(36)
    SOLVE_ROW_BEGIN(37)
    { const f32x4 m = *(const f32x4*)(mr + 0);
      a0 -= m[0] * x[0];
      a1 -= m[1] * x[1];
      a2 -= m[2] * x[2];
      a3 -= m[3] * x[3];
    }
    { const f32x4 m = *(const f32x4*)(mr + 4);
      a0 -= m[0] * x[4];
      a1 -= m[1] * x[5];
      a2 -= m[2] * x[6];
      a3 -= m[3] * x[7];
    }
    { const f32x4 m = *(const f32x4*)(mr + 8);
      a0 -= m[0] * x[8];
      a1 -= m[1] * x[9];
      a2 -= m[2] * x[10];
      a3 -= m[3] * x[11];
    }
    { const f32x4 m = *(const f32x4*)(mr + 12);
      a0 -= m[0] * x[12];
      a1 -= m[1] * x[13];
      a2 -= m[2] * x[14];
      a3 -= m[3] * x[15];
    }
    { const f32x4 m = *(const f32x4*)(mr + 16);
      a0 -= m[0] * x[16];
      a1 -= m[1] * x[17];
      a2 -= m[2] * x[18];
      a3 -= m[3] * x[19];
    }
    { const f32x4 m = *(const f32x4*)(mr + 20);
      a0 -= m[0] * x[20];
      a1 -= m[1] * x[21];
      a2 -= m[2] * x[22];
      a3 -= m[3] * x[23];
    }
    { const f32x4 m = *(const f32x4*)(mr + 24);
      a0 -= m[0] * x[24];
      a1 -= m[1] * x[25];
      a2 -= m[2] * x[26];
      a3 -= m[3] * x[27];
    }
    { const f32x4 m = *(const f32x4*)(mr + 28);
      a0 -= m[0] * x[28];
      a1 -= m[1] * x[29];
      a2 -= m[2] * x[30];
      a3 -= m[3] * x[31];
    }
    { const f32x4 m = *(const f32x4*)(mr + 32);
      a0 -= m[0] * x[32];
      a1 -= m[1] * x[33];
      a2 -= m[2] * x[34];
      a3 -= m[3] * x[35];
    }
    { const f32x4 m = *(const f32x4*)(mr + 36);
      a0 -= m[0] * x[36];
    }
    SOLVE_ROW_END(37)
    SOLVE_ROW_BEGIN(38)
    { const f32x4 m = *(const f32x4*)(mr + 0);
      a0 -= m[0] * x[0];
      a1 -= m[1] * x[1];
      a2 -= m[2] * x[2];
      a3 -= m[3] * x[3];
    }
    { const f32x4 m = *(const f32x4*)(mr + 4);
      a0 -= m[0] * x[4];
      a1 -= m[1] * x[5];
      a2 -= m[2] * x[6];
      a3 -= m[3] * x[7];
    }
    { const f32x4 m = *(const f32x4*)(mr + 8);
      a0 -= m[0] * x[8];
      a1 -= m[1] * x[9];
      a2 -= m[2] * x[10];
      a3 -= m[3] * x[11];
    }
    { const f32x4 m = *(const f32x4*)(mr + 12);
      a0 -= m[0] * x[12];
      a1 -= m[1] * x[13];
      a2 -= m[2] * x[14];
      a3 -= m[3] * x[15];
    }
    { const f32x4 m = *(const f32x4*)(mr + 16);
      a0 -= m[0] * x[16];
      a1 -= m[1] * x[17];
      a2 -= m[2] * x[18];
      a3 -= m[3] * x[19];
    }
    { const f32x4 m = *(const f32x4*)(mr + 20);
      a0 -= m[0] * x[20];
      a1 -= m[1] * x[21];
      a2 -= m[2] * x[22];
      a3 -= m[3] * x[23];
    }
    { const f32x4 m = *(const f32x4*)(mr + 24);
      a0 -= m[0] * x[24];
      a1 -= m[1] * x[25];
      a2 -= m[2] * x[26];
      a3 -= m[3] * x[27];
    }
    { const f32x4 m = *(const f32x4*)(mr + 28);
      a0 -= m[0] * x[28];
      a1 -= m[1] * x[29];
      a2 -= m[2] * x[30];
      a3 -= m[3] * x[31];
    }
    { const f32x4 m = *(const f32x4*)(mr + 32);
      a0 -= m[0] * x[32];
      a1 -= m[1] * x[33];
      a2 -= m[2] * x[34];
      a3 -= m[3] * x[35];
    }
    { const f32x4 m = *(const f32x4*)(mr + 36);
      a0 -= m[0] * x[36];
      a1 -= m[1] * x[37];
    }
    SOLVE_ROW_END(38)
    SOLVE_ROW_BEGIN(39)
    { const f32x4 m = *(const f32x4*)(mr + 0);
      a0 -= m[0] * x[0];
      a1 -= m[1] * x[1];
      a2 -= m[2] * x[2];
      a3 -= m[3] * x[3];
    }
    { const f32x4 m = *(const f32x4*)(mr + 4);
      a0 -= m[0] * x[4];
      a1 -= m[1] * x[5];
      a2 -= m[2] * x[6];
      a3 -= m[3] * x[7];
    }
    { const f32x4 m = *(const f32x4*)(mr + 8);
      a0 -= m[0] * x[8];
      a1 -= m[1] * x[9];
      a2 -= m[2] * x[10];
      a3 -= m[3] * x[11];
    }
    { const f32x4 m = *(const f32x4*)(mr + 12);
      a0 -= m[0] * x[12];
      a1 -= m[1] * x[13];
      a2 -= m[2] * x[14];
      a3 -= m[3] * x[15];
    }
    { const f32x4 m = *(const f32x4*)(mr + 16);
      a0 -= m[0] * x[16];
      a1 -= m[1] * x[17];
      a2 -= m[2] * x[18];
      a3 -= m[3] * x[19];
    }
    { const f32x4 m = *(const f32x4*)(mr + 20);
      a0 -= m[0] * x[20];
      a1 -= m[1] * x[21];
      a2 -= m[2] * x[22];
      a3 -= m[3] * x[23];
    }
    { const f32x4 m = *(const f32x4*)(mr + 24);
      a0 -= m[0] * x[24];
      a1 -= m[1] * x[25];
      a2 -= m[2] * x[26];
      a3 -= m[3] * x[27];
    }
    { const f32x4 m = *(const f32x4*)(mr + 28);
      a0 -= m[0] * x[28];
      a1 -= m[1] * x[29];
      a2 -= m[2] * x[30];
      a3 -= m[3] * x[31];
    }
    { const f32x4 m = *(const f32x4*)(mr + 32);
      a0 -= m[0] * x[32];
      a1 -= m[1] * x[33];
      a2 -= m[2] * x[34];
      a3 -= m[3] * x[35];
    }
    { const f32x4 m = *(const f32x4*)(mr + 36);
      a0 -= m[0] * x[36];
      a1 -= m[1] * x[37];
      a2 -= m[2] * x[38];
    }
    SOLVE_ROW_END(39)
    SOLVE_ROW_BEGIN(40)
    { const f32x4 m = *(const f32x4*)(mr + 0);
      a0 -= m[0] * x[0];
      a1 -= m[1] * x[1];
      a2 -= m[2] * x[2];
      a3 -= m[3] * x[3];
    }
    { const f32x4 m = *(const f32x4*)(mr + 4);
      a0 -= m[0] * x[4];
      a1 -= m[1] * x[5];
      a2 -= m[2] * x[6];
      a3 -= m[3] * x[7];
    }
    { const f32x4 m = *(const f32x4*)(mr + 8);
      a0 -= m[0] * x[8];
      a1 -= m[1] * x[9];
      a2 -= m[2] * x[10];
      a3 -= m[3] * x[11];
    }
    { const f32x4 m = *(const f32x4*)(mr + 12);
      a0 -= m[0] * x[12];
      a1 -= m[1] * x[13];
      a2 -= m[2] * x[14];
      a3 -= m[3] * x[15];
    }
    { const f32x4 m = *(const f32x4*)(mr + 16);
      a0 -= m[0] * x[16];
      a1 -= m[1] * x[17];
      a2 -= m[2] * x[18];
      a3 -= m[3] * x[19];
    }
    { const f32x4 m = *(const f32x4*)(mr + 20);
      a0 -= m[0] * x[20];
      a1 -= m[1] * x[21];
      a2 -= m[2] * x[22];
      a3 -= m[3] * x[23];
    }
    { const f32x4 m = *(const f32x4*)(mr + 24);
      a0 -= m[0] * x[24];
      a1 -= m[1] * x[25];
      a2 -= m[2] * x[26];
      a3 -= m[3] * x[27];
    }
    { const f32x4 m = *(const f32x4*)(mr + 28);
      a0 -= m[0] * x[28];
      a1 -= m[1] * x[29];
      a2 -= m[2] * x[30];
      a3 -= m[3] * x[31];
    }
    { const f32x4 m = *(const f32x4*)(mr + 32);
      a0 -= m[0] * x[32];
      a1 -= m[1] * x[33];
      a2 -= m[2] * x[34];
      a3 -= m[3] * x[35];
    }
    { const f32x4 m = *(const f32x4*)(mr + 36);
      a0 -= m[0] * x[36];
      a1 -= m[1] * x[37];
      a2 -= m[2] * x[38];
      a3 -= m[3] * x[39];
    }
    SOLVE_ROW_END(40)
    SOLVE_ROW_BEGIN(41)
    { const f32x4 m = *(const f32x4*)(mr + 0);
      a0 -= m[0] * x[0];
      a1 -= m[1] * x[1];
      a2 -= m[2] * x[2];
      a3 -= m[3] * x[3];
    }
    { const f32x4 m = *(const f32x4*)(mr + 4);
      a0 -= m[0] * x[4];
      a1 -= m[1] * x[5];
      a2 -= m[2] * x[6];
      a3 -= m[3] * x[7];
    }
    { const f32x4 m = *(const f32x4*)(mr + 8);
      a0 -= m[0] * x[8];
      a1 -= m[1] * x[9];
      a2 -= m[2] * x[10];
      a3 -= m[3] * x[11];
    }
    { const f32x4 m = *(const f32x4*)(mr + 12);
      a0 -= m[0] * x[12];
      a1 -= m[1] * x[13];
      a2 -= m[2] * x[14];
      a3 -= m[3] * x[15];
    }
    { const f32x4 m = *(const f32x4*)(mr + 16);
      a0 -= m[0] * x[16];
      a1 -= m[1] * x[17];
      a2 -= m[2] * x[18];
      a3 -= m[3] * x[19];
    }
    { const f32x4 m = *(const f32x4*)(mr + 20);
      a0 -= m[0] * x[20];
      a1 -= m[1] * x[21];
      a2 -= m[2] * x[22];
      a3 -= m[3] * x[23];
    }
    { const f32x4 m = *(const f32x4*)(mr + 24);
      a0 -= m[0] * x[24];
      a1 -= m[1] * x[25];
      a2 -= m[2] * x[26];
      a3 -= m[3] * x[27];
    }
    { const f32x4 m = *(const f32x4*)(mr + 28);
      a0 -= m[0] * x[28];
      a1 -= m[1] * x[29];
      a2 -= m[2] * x[30];
      a3 -= m[3] * x[31];
    }
    { const f32x4 m = *(const f32x4*)(mr + 32);
      a0 -= m[0] * x[32];
      a1 -= m[1] * x[33];
      a2 -= m[2] * x[34];
      a3 -= m[3] * x[35];
    }
    { const f32x4 m = *(const f32x4*)(mr + 36);
      a0 -= m[0] * x[36];
      a1 -= m[1] * x[37];
      a2 -= m[2] * x[38];
      a3 -= m[3] * x[39];
    }
    { const f32x4 m = *(const f32x4*)(mr + 40);
      a0 -= m[0] * x[40];
    }
    SOLVE_ROW_END(41)
    SOLVE_ROW_BEGIN(42)
    { const f32x4 m = *(const f32x4*)(mr + 0);
      a0 -= m[0] * x[0];
      a1 -= m[1] * x[1];
      a2 -= m[2] * x[2];
      a3 -= m[3] * x[3];
    }
    { const f32x4 m = *(const f32x4*)(mr + 4);
      a0 -= m[0] * x[4];
      a1 -= m[1] * x[5];
      a2 -= m[2] * x[6];
      a3 -= m[3] * x[7];
    }
    { const f32x4 m = *(const f32x4*)(mr + 8);
      a0 -= m[0] * x[8];
      a1 -= m[1] * x[9];
      a2 -= m[2] * x[10];
      a3 -= m[3] * x[11];
    }
    { const f32x4 m = *(const f32x4*)(mr + 12);
      a0 -= m[0] * x[12];
      a1 -= m[1] * x[13];
      a2 -= m[2] * x[14];
      a3 -= m[3] * x[15];
    }
    { const f32x4 m = *(const f32x4*)(mr + 16);
      a0 -= m[0] * x[16];
      a1 -= m[1] * x[17];
      a2 -= m[2] * x[18];
      a3 -= m[3] * x[19];
    }
    { const f32x4 m = *(const f32x4*)(mr + 20);
      a0 -= m[0] * x[20];
      a1 -= m[1] * x[21];
      a2 -= m[2] * x[22];
      a3 -= m[3] * x[23];
    }
    { const f32x4 m = *(const f32x4*)(mr + 24);
      a0 -= m[0] * x[24];
      a1 -= m[1] * x[25];
      a2 -= m[2] * x[26];
      a3 -= m[3] * x[27];
    }
    { const f32x4 m = *(const f32x4*)(mr + 28);
      a0 -= m[0] * x[28];
      a1 -= m[1] * x[29];
      a2 -= m[2] * x[30];
      a3 -= m[3] * x[31];
    }
    { const f32x4 m = *(const f32x4*)(mr + 32);
      a0 -= m[0] * x[32];
      a1 -= m[1] * x[33];
      a2 -= m[2] * x[34];
      a3 -= m[3] * x[35];
    }
    { const f32x4 m = *(const f32x4*)(mr + 36);
      a0 -= m[0] * x[36];
      a1 -= m[1] * x[37];
      a2 -= m[2] * x[38];
      a3 -= m[3] * x[39];
    }
    { const f32x4 m = *(const f32x4*)(mr + 40);
      a0 -= m[0] * x[40];
      a1 -= m[1] * x[41];
    }
    SOLVE_ROW_END(42)
    SOLVE_ROW_BEGIN(43)
    { const f32x4 m = *(const f32x4*)(mr + 0);
      a0 -= m[0] * x[0];
      a1 -= m[1] * x[1];
      a2 -= m[2] * x[2];
      a3 -= m[3] * x[3];
    }
    { const f32x4 m = *(const f32x4*)(mr + 4);
      a0 -= m[0] * x[4];
      a1 -= m[1] * x[5];
      a2 -= m[2] * x[6];
      a3 -= m[3] * x[7];
    }
    { const f32x4 m = *(const f32x4*)(mr + 8);
      a0 -= m[0] * x[8];
      a1 -= m[1] * x[9];
      a2 -= m[2] * x[10];
      a3 -= m[3] * x[11];
    }
    { const f32x4 m = *(const f32x4*)(mr + 12);
      a0 -= m[0] * x[12];
      a1 -= m[1] * x[13];
      a2 -= m[2] * x[14];
      a3 -= m[3] * x[15];
    }
    { const f32x4 m = *(const f32x4*)(mr + 16);
      a0 -= m[0] * x[16];
      a1 -= m[1] * x[17];
      a2 -= m[2] * x[18];
      a3 -= m[3] * x[19];
    }
    { const f32x4 m = *(const f32x4*)(mr + 20);
      a0 -= m[0] * x[20];
      a1 -= m[1] * x[21];
      a2 -= m[2] * x[22];
      a3 -= m[3] * x[23];
    }
    { const f32x4 m = *(const f32x4*)(mr + 24);
      a0 -= m[0] * x[24];
      a1 -= m[1] * x[25];
      a2 -= m[2] * x[26];
      a3 -= m[3] * x[27];
    }
    { const f32x4 m = *(const f32x4*)(mr + 28);
      a0 -= m[0] * x[28];
      a1 -= m[1] * x[29];
      a2 -= m[2] * x[30];
      a3 -= m[3] * x[31];
    }
    { const f32x4 m = *(const f32x4*)(mr + 32);
      a0 -= m[0] * x[32];
      a1 -= m[1] * x[33];
      a2 -= m[2] * x[34];
      a3 -= m[3] * x[35];
    }
    { const f32x4 m = *(const f32x4*)(mr + 36);
      a0 -= m[0] * x[36];
      a1 -= m[1] * x[37];
      a2 -= m[2] * x[38];
      a3 -= m[3] * x[39];
    }
    { const f32x4 m = *(const f32x4*)(mr + 40);
      a0 -= m[0] * x[40];
      a1 -= m[1] * x[41];
      a2 -= m[2] * x[42];
    }
    SOLVE_ROW_END(43)
    SOLVE_ROW_BEGIN(44)
    { const f32x4 m = *(const f32x4*)(mr + 0);
      a0 -= m[0] * x[0];
      a1 -= m[1] * x[1];
      a2 -= m[2] * x[2];
      a3 -= m[3] * x[3];
    }
    { const f32x4 m = *(const f32x4*)(mr + 4);
      a0 -= m[0] * x[4];
      a1 -= m[1] * x[5];
      a2 -= m[2] * x[6];
      a3 -= m[3] * x[7];
    }
    { const f32x4 m = *(const f32x4*)(mr + 8);
      a0 -= m[0] * x[8];
      a1 -= m[1] * x[9];
      a2 -= m[2] * x[10];
      a3 -= m[3] * x[11];
    }
    { const f32x4 m = *(const f32x4*)(mr + 12);
      a0 -= m[0] * x[12];
      a1 -= m[1] * x[13];
      a2 -= m[2] * x[14];
      a3 -= m[3] * x[15];
    }
    { const f32x4 m = *(const f32x4*)(mr + 16);
      a0 -= m[0] * x[16];
      a1 -= m[1] * x[17];
      a2 -= m[2] * x[18];
      a3 -= m[3] * x[19];
    }
    { const f32x4 m = *(const f32x4*)(mr + 20);
      a0 -= m[0] * x[20];
      a1 -= m[1] * x[21];
      a2 -= m[2] * x[22];
      a3 -= m[3] * x[23];
    }
    { const f32x4 m = *(const f32x4*)(mr + 24);
      a0 -= m[0] * x[24];
      a1 -= m[1] * x[25];
      a2 -= m[2] * x[26];
      a3 -= m[3] * x[27];
    }
    { const f32x4 m = *(const f32x4*)(mr + 28);
      a0 -= m[0] * x[28];
      a1 -= m[1] * x[29];
      a2 -= m[2] * x[30];
      a3 -= m[3] * x[31];
    }
    { const f32x4 m = *(const f32x4*)(mr + 32);
      a0 -= m[0] * x[32];
      a1 -= m[1] * x[33];
      a2 -= m[2] * x[34];
      a3 -= m[3] * x[35];
    }
    { const f32x4 m = *(const f32x4*)(mr + 36);
      a0 -= m[0] * x[36];
      a1 -= m[1] * x[37];
      a2 -= m[2] * x[38];
      a3 -= m[3] * x[39];
    }
    { const f32x4 m = *(const f32x4*)(mr + 40);
      a0 -= m[0] * x[40];
      a1 -= m[1] * x[41];
      a2 -= m[2] * x[42];
      a3 -= m[3] * x[43];
    }
    SOLVE_ROW_END(44)
    SOLVE_ROW_BEGIN(45)
    { const f32x4 m = *(const f32x4*)(mr + 0);
      a0 -= m[0] * x[0];
      a1 -= m[1] * x[1];
      a2 -= m[2] * x[2];
      a3 -= m[3] * x[3];
    }
    { const f32x4 m = *(const f32x4*)(mr + 4);
      a0 -= m[0] * x[4];
      a1 -= m[1] * x[5];
      a2 -= m[2] * x[6];
      a3 -= m[3] * x[7];
    }
    { const f32x4 m = *(const f32x4*)(mr + 8);
      a0 -= m[0] * x[8];
      a1 -= m[1] * x[9];
      a2 -= m[2] * x[10];
      a3 -= m[3] * x[11];
    }
    { const f32x4 m = *(const f32x4*)(mr + 12);
      a0 -= m[0] * x[12];
      a1 -= m[1] * x[13];
      a2 -= m[2] * x[14];
      a3 -= m[3] * x[15];
    }
    { const f32x4 m = *(const f32x4*)(mr + 16);
      a0 -= m[0] * x[16];
      a1 -= m[1] * x[17];
      a2 -= m[2] * x[18];
      a3 -= m[3] * x[19];
    }
    { const f32x4 m = *(const f32x4*)(mr + 20);
      a0 -= m[0] * x[20];
      a1 -= m[1] * x[21];
      a2 -= m[2] * x[22];
      a3 -= m[3] * x[23];
    }
    { const f32x4 m = *(const f32x4*)(mr + 24);
      a0 -= m[0] * x[24];
      a1 -= m[1] * x[25];
      a2 -= m[2] * x[26];
      a3 -= m[3] * x[27];
    }
    { const f32x4 m = *(const f32x4*)(mr + 28);
      a0 -= m[0] * x[28];
      a1 -= m[1] * x[29];
      a2 -= m[2] * x[30];
      a3 -= m[3] * x[31];
    }
    { const f32x4 m = *(const f32x4*)(mr + 32);
      a0 -= m[0] * x[32];
      a1 -= m[1] * x[33];
      a2 -= m[2] * x[34];
      a3 -= m[3] * x[35];
    }
    { const f32x4 m = *(const f32x4*)(mr + 36);
      a0 -= m[0] * x[36];
      a1 -= m[1] * x[37];
      a2 -= m[2] * x[38];
      a3 -= m[3] * x[39];
    }
    { const f32x4 m = *(const f32x4*)(mr + 40);
      a0 -= m[0] * x[40];
      a1 -= m[1] * x[41];
      a2 -= m[2] * x[42];
      a3 -= m[3] * x[43];
    }
    { const f32x4 m = *(const f32x4*)(mr + 44);
      a0 -= m[0] * x[44];
    }
    SOLVE_ROW_END(45)
    SOLVE_ROW_BEGIN(46)
    { const f32x4 m = *(const f32x4*)(mr + 0);
      a0 -= m[0] * x[0];
      a1 -= m[1] * x[1];
      a2 -= m[2] * x[2];
      a3 -= m[3] * x[3];
    }
    { const f32x4 m = *(const f32x4*)(mr + 4);
      a0 -= m[0] * x[4];
      a1 -= m[1] * x[5];
      a2 -= m[2] * x[6];
      a3 -= m[3] * x[7];
    }
    { const f32x4 m = *(const f32x4*)(mr + 8);
      a0 -= m[0] * x[8];
      a1 -= m[1] * x[9];
      a2 -= m[2] * x[10];
      a3 -= m[3] * x[11];
    }
    { const f32x4 m = *(const f32x4*)(mr + 12);
      a0 -= m[0] * x[12];
      a1 -= m[1] * x[13];
      a2 -= m[2] * x[14];
      a3 -= m[3] * x[15];
    }
    { const f32x4 m = *(const f32x4*)(mr + 16);
      a0 -= m[0] * x[16];
      a1 -= m[1] * x[17];
      a2 -= m[2] * x[18];
      a3 -= m[3] * x[19];
    }
    { const f32x4 m = *(const f32x4*)(mr + 20);
      a0 -= m[0] * x[20];
      a1 -= m[1] * x[21];
      a2 -= m[2] * x[22];
      a3 -= m[3] * x[23];
    }
    { const f32x4 m = *(const f32x4*)(mr + 24);
      a0 -= m[0] * x[24];
      a1 -= m[1] * x[25];
      a2 -= m[2] * x[26];
      a3 -= m[3] * x[27];
    }
    { const f32x4 m = *(const f32x4*)(mr + 28);
      a0 -= m[0] * x[28];
      a1 -= m[1] * x[29];
      a2 -= m[2] * x[30];
      a3 -= m[3] * x[31];
    }
    { const f32x4 m = *(const f32x4*)(mr + 32);
      a0 -= m[0] * x[32];
      a1 -= m[1] * x[33];
      a2 -= m[2] * x[34];
      a3 -= m[3] * x[35];
    }
    { const f32x4 m = *(const f32x4*)(mr + 36);
      a0 -= m[0] * x[36];
      a1 -= m[1] * x[37];
      a2 -= m[2] * x[38];
      a3 -= m[3] * x[39];
    }
    { const f32x4 m = *(const f32x4*)(mr + 40);
      a0 -= m[0] * x[40];
      a1 -= m[1] * x[41];
      a2 -= m[2] * x[42];
      a3 -= m[3] * x[43];
    }
    { const f32x4 m = *(const f32x4*)(mr + 44);
      a0 -= m[0] * x[44];
      a1 -= m[1] * x[45];
    }
    SOLVE_ROW_END(46)
    SOLVE_ROW_BEGIN(47)
    { const f32x4 m = *(const f32x4*)(mr + 0);
      a0 -= m[0] * x[0];
      a1 -= m[1] * x[1];
      a2 -= m[2] * x[2];
      a3 -= m[3] * x[3];
    }
    { const f32x4 m = *(const f32x4*)(mr + 4);
      a0 -= m[0] * x[4];
      a1 -= m[1] * x[5];
      a2 -= m[2] * x[6];
      a3 -= m[3] * x[7];
    }
    { const f32x4 m = *(const f32x4*)(mr + 8);
      a0 -= m[0] * x[8];
      a1 -= m[1] * x[9];
      a2 -= m[2] * x[10];
      a3 -= m[3] * x[11];
    }
    { const f32x4 m = *(const f32x4*)(mr + 12);
      a0 -= m[0] * x[12];
      a1 -= m[1] * x[13];
      a2 -= m[2] * x[14];
      a3 -= m[3] * x[15];
    }
    { const f32x4 m = *(const f32x4*)(mr + 16);
      a0 -= m[0] * x[16];
      a1 -= m[1] * x[17];
      a2 -= m[2] * x[18];
      a3 -= m[3] * x[19];
    }
    { const f32x4 m = *(const f32x4*)(mr + 20);
      a0 -= m[0] * x[20];
      a1 -= m[1] * x[21];
      a2 -= m[2] * x[22];
      a3 -= m[3] * x[23];
    }
    { const f32x4 m = *(const f32x4*)(mr + 24);
      a0 -= m[0] * x[24];
      a1 -= m[1] * x[25];
      a2 -= m[2] * x[26];
      a3 -= m[3] * x[27];
    }
    { const f32x4 m = *(const f32x4*)(mr + 28);
      a0 -= m[0] * x[28];
      a1 -= m[1] * x[29];
      a2 -= m[2] * x[30];
      a3 -= m[3] * x[31];
    }
    { const f32x4 m = *(const f32x4*)(mr + 32);
      a0 -= m[0] * x[32];
      a1 -= m[1] * x[33];
      a2 -= m[2] * x[34];
      a3 -= m[3] * x[35];
    }
    { const f32x4 m = *(const f32x4*)(mr + 36);
      a0 -= m[0] * x[36];
      a1 -= m[1] * x[37];
      a2 -= m[2] * x[38];
      a3 -= m[3] * x[39];
    }
    { const f32x4 m = *(const f32x4*)(mr + 40);
      a0 -= m[0] * x[40];
      a1 -= m[1] * x[41];
      a2 -= m[2] * x[42];
      a3 -= m[3] * x[43];
    }
    { const f32x4 m = *(const f32x4*)(mr + 44);
      a0 -= m[0] * x[44];
      a1 -= m[1] * x[45];
      a2 -= m[2] * x[46];
    }
    SOLVE_ROW_END(47)
    SOLVE_ROW_BEGIN(48)
    { const f32x4 m = *(const f32x4*)(mr + 0);
      a0 -= m[0] * x[0];
      a1 -= m[1] * x[1];
      a2 -= m[2] * x[2];
      a3 -= m[3] * x[3];
    }
    { const f32x4 m = *(const f32x4*)(mr + 4);
      a0 -= m[0] * x[4];
      a1 -= m[1] * x[5];
      a2 -= m[2] * x[6];
      a3 -= m[3] * x[7];
    }
    { const f32x4 m = *(const f32x4*)(mr + 8);
      a0 -= m[0] * x[8];
      a1 -= m[1] * x[9];
      a2 -= m[2] * x[10];
      a3 -= m[3] * x[11];
    }
    { const f32x4 m = *(const f32x4*)(mr + 12);
      a0 -= m[0] * x[12];
      a1 -= m[1] * x[13];
      a2 -= m[2] * x[14];
      a3 -= m[3] * x[15];
    }
    { const f32x4 m = *(const f32x4*)(mr + 16);
      a0 -= m[0] * x[16];
      a1 -= m[1] * x[17];
      a2 -= m[2] * x[18];
      a3 -= m[3] * x[19];
    }
    { const f32x4 m = *(const f32x4*)(mr + 20);
      a0 -= m[0] * x[20];
      a1 -= m[1] * x[21];
      a2 -= m[2] * x[22];
      a3 -= m[3] * x[23];
    }
    { const f32x4 m = *(const f32x4*)(mr + 24);
      a0 -= m[0] * x[24];
      a1 -= m[1] * x[25];
      a2 -= m[2] * x[26];
      a3 -= m[3] * x[27];
    }
    { const f32x4 m = *(const f32x4*)(mr + 28);
      a0 -= m[0] * x[28];
      a1 -= m[1] * x[29];
      a2 -= m[2] * x[30];
      a3 -= m[3] * x[31];
    }
    { const f32x4 m = *(const f32x4*)(mr + 32);
      a0 -= m[0] * x[32];
      a1 -= m[1] * x[33];
      a2 -= m[2] * x[34];
      a3 -= m[3] * x[35];
    }
    { const f32x4 m = *(const f32x4*)(mr + 36);
      a0 -= m[0] * x[36];
      a1 -= m[1] * x[37];
      a2 -= m[2] * x[38];
      a3 -= m[3] * x[39];
    }
    { const f32x4 m = *(const f32x4*)(mr + 40);
      a0 -= m[0] * x[40];
      a1 -= m[1] * x[41];
      a2 -= m[2] * x[42];
      a3 -= m[3] * x[43];
    }
    { const f32x4 m = *(const f32x4*)(mr + 44);
      a0 -= m[0] * x[44];
      a1 -= m[1] * x[45];
      a2 -= m[2] * x[46];
      a3 -= m[3] * x[47];
    }
    SOLVE_ROW_END(48)
    SOLVE_ROW_BEGIN(49)
    { const f32x4 m = *(const f32x4*)(mr + 0);
      a0 -= m[0] * x[0];
      a1 -= m[1] * x[1];
      a2 -= m[2] * x[2];
      a3 -= m[3] * x[3];
    }
    { const f32x4 m = *(const f32x4*)(mr + 4);
      a0 -= m[0] * x[4];
      a1 -= m[1] * x[5];
      a2 -= m[2] * x[6];
      a3 -= m[3] * x[7];
    }
    { const f32x4 m = *(const f32x4*)(mr + 8);
      a0 -= m[0] * x[8];
      a1 -= m[1] * x[9];
      a2 -= m[2] * x[10];
      a3 -= m[3] * x[11];
    }
    { const f32x4 m = *(const f32x4*)(mr + 12);
      a0 -= m[0] * x[12];
      a1 -= m[1] * x[13];
      a2 -= m[2] * x[14];
      a3 -= m[3] * x[15];
    }
    { const f32x4 m = *(const f32x4*)(mr + 16);
      a0 -= m[0] * x[16];
      a1 -= m[1] * x[17];
      a2 -= m[2] * x[18];
      a3 -= m[3] * x[19];
    }
    { const f32x4 m = *(const f32x4*)(mr + 20);
      a0 -= m[0] * x[20];
      a1 -= m[1] * x[21];
      a2 -= m[2] * x[22];
      a3 -= m[3] * x[23];
    }
    { const f32x4 m = *(const f32x4*)(mr + 24);
      a0 -= m[0] * x[24];
      a1 -= m[1] * x[25];
      a2 -= m[2] * x[26];
      a3 -= m[3] * x[27];
    }
    { const f32x4 m = *(const f32x4*)(mr + 28);
      a0 -= m[0] * x[28];
      a1 -= m[1] * x[29];
      a2 -= m[2] * x[30];
      a3 -= m[3] * x[31];
    }
    { const f32x4 m = *(const f32x4*)(mr + 32);
      a0 -= m[0] * x[32];
      a1 -= m[1] * x[33];
      a2 -= m[2] * x[34];
      a3 -= m[3] * x[35];
    }
    { const f32x4 m = *(const f32x4*)(mr + 36);
      a0 -= m[0] * x[36];
      a1 -= m[1] * x[37];
      a2 -= m[2] * x[38];
      a3 -= m[3] * x[39];
    }
    { const f32x4 m = *(const f32x4*)(mr + 40);
      a0 -= m[0] * x[40];
      a1 -= m[1] * x[41];
      a2 -= m[2] * x[42];
      a3 -= m[3] * x[43];
    }
    { const f32x4 m = *(const f32x4*)(mr + 44);
      a0 -= m[0] * x[44];
      a1 -= m[1] * x[45];
      a2 -= m[2] * x[46];
      a3 -= m[3] * x[47];
    }
    { const f32x4 m = *(const f32x4*)(mr + 48);
      a0 -= m[0] * x[48];
    }
    SOLVE_ROW_END(49)
    SOLVE_ROW_BEGIN(50)
    { const f32x4 m = *(const f32x4*)(mr + 0);
      a0 -= m[0] * x[0];
      a1 -= m[1] * x[1];
      a2 -= m[2] * x[2];
      a3 -= m[3] * x[3];
    }
    { const f32x4 m = *(const f32x4*)(mr + 4);
      a0 -= m[0] * x[4];
      a1 -= m[1] * x[5];
      a2 -= m[2] * x[6];
      a3 -= m[3] * x[7];
    }
    { const f32x4 m = *(const f32x4*)(mr + 8);
      a0 -= m[0] * x[8];
      a1 -= m[1] * x[9];
      a2 -= m[2] * x[10];
      a3 -= m[3] * x[11];
    }
    { const f32x4 m = *(const f32x4*)(mr + 12);
      a0 -= m[0] * x[12];
      a1 -= m[1] * x[13];
      a2 -= m[2] * x[14];
      a3 -= m[3] * x[15];
    }
    { const f32x4 m = *(const f32x4*)(mr + 16);
      a0 -= m[0] * x[16];
      a1 -= m[1] * x[17];
      a2 -= m[2] * x[18];
      a3 -= m[3] * x[19];
    }
    { const f32x4 m = *(const f32x4*)(mr + 20);
      a0 -= m[0] * x[20];
      a1 -= m[1] * x[21];
      a2 -= m[2] * x[22];
      a3 -= m[3] * x[23];
    }
    { const f32x4 m = *(const f32x4*)(mr + 24);
      a0 -= m[0] * x[24];
      a1 -= m[1] * x[25];
      a2 -= m[2] * x[26];
      a3 -= m[3] * x[27];
    }
    { const f32x4 m = *(const f32x4*)(mr + 28);
      a0 -= m[0] * x[28];
      a1 -= m[1] * x[29];
      a2 -= m[2] * x[30];
      a3 -= m[3] * x[31];
    }
    { const f32x4 m = *(const f32x4*)(mr + 32);
      a0 -= m[0] * x[32];
      a1 -= m[1] * x[33];
      a2 -= m[2] * x[34];
      a3 -= m[3] * x[35];
    }
    { const f32x4 m = *(const f32x4*)(mr + 36);
      a0 -= m[0] * x[36];
      a1 -= m[1] * x[37];
      a2 -= m[2] * x[38];
      a3 -= m[3] * x[39];
    }
    { const f32x4 m = *(const f32x4*)(mr + 40);
      a0 -= m[0] * x[40];
      a1 -= m[1] * x[41];
      a2 -= m[2] * x[42];
      a3 -= m[3] * x[43];
    }
    { const f32x4 m = *(const f32x4*)(mr + 44);
      a0 -= m[0] * x[44];
      a1 -= m[1] * x[45];
      a2 -= m[2] * x[46];
      a3 -= m[3] * x[47];
    }
    { const f32x4 m = *(const f32x4*)(mr + 48);
      a0 -= m[0] * x[48];
      a1 -= m[1] * x[49];
    }
    SOLVE_ROW_END(50)
    SOLVE_ROW_BEGIN(51)
    { const f32x4 m = *(const f32x4*)(mr + 0);
      a0 -= m[0] * x[0];
      a1 -= m[1] * x[1];
      a2 -= m[2] * x[2];
      a3 -= m[3] * x[3];
    }
    { const f32x4 m = *(const f32x4*)(mr + 4);
      a0 -= m[0] * x[4];
      a1 -= m[1] * x[5];
      a2 -= m[2] * x[6];
      a3 -= m[3] * x[7];
    }
    { const f32x4 m = *(const f32x4*)(mr + 8);
      a0 -= m[0] * x[8];
      a1 -= m[1] * x[9];
      a2 -= m[2] * x[10];
      a3 -= m[3] * x[11];
    }
    { const f32x4 m = *(const f32x4*)(mr + 12);
      a0 -= m[0] * x[12];
      a1 -= m[1] * x[13];
      a2 -= m[2] * x[14];
      a3 -= m[3] * x[15];
    }
    { const f32x4 m = *(const f32x4*)(mr + 16);
      a0 -= m[0] * x[16];
      a1 -= m[1] * x[17];
      a2 -= m[2] * x[18];
      a3 -= m[3] * x[19];
    }
    { const f32x4 m = *(const f32x4*)(mr + 20);
      a0 -= m[0] * x[20];
      a1 -= m[1] * x[21];
      a2 -= m[2] * x[22];
      a3 -= m[3] * x[23];
    }
    { const f32x4 m = *(const f32x4*)(mr + 24);
      a0 -= m[0] * x[24];
      a1 -= m[1] * x[25];
      a2 -= m[2] * x[26];
      a3 -= m[3] * x[27];
    }
    { const f32x4 m = *(const f32x4*)(mr + 28);
      a0 -= m[0] * x[28];
      a1 -= m[1] * x[29];
      a2 -= m[2] * x[30];
      a3 -= m[3] * x[31];
    }
    { const f32x4 m = *(const f32x4*)(mr + 32);
      a0 -= m[0] * x[32];
      a1 -= m[1] * x[33];
      a2 -= m[2] * x[34];
      a3 -= m[3] * x[35];
    }
    { const f32x4 m = *(const f32x4*)(mr + 36);
      a0 -= m[0] * x[36];
      a1 -= m[1] * x[37];
      a2 -= m[2] * x[38];
      a3 -= m[3] * x[39];
    }
    { const f32x4 m = *(const f32x4*)(mr + 40);
      a0 -= m[0] * x[40];
      a1 -= m[1] * x[41];
      a2 -= m[2] * x[42];
      a3 -= m[3] * x[43];
    }
    { const f32x4 m = *(const f32x4*)(mr + 44);
      a0 -= m[0] * x[44];
      a1 -= m[1] * x[45];
      a2 -= m[2] * x[46];
      a3 -= m[3] * x[47];
    }
    { const f32x4 m = *(const f32x4*)(mr + 48);
      a0 -= m[0] * x[48];
      a1 -= m[1] * x[49];
      a2 -= m[2] * x[50];
    }
    SOLVE_ROW_END(51)
    SOLVE_ROW_BEGIN(52)
    { const f32x4 m = *(const f32x4*)(mr + 0);
      a0 -= m[0] * x[0];
      a1 -= m[1] * x[1];
      a2 -= m[2] * x[2];
      a3 -= m[3] * x[3];
    }
    { const f32x4 m = *(const f32x4*)(mr + 4);
      a0 -= m[0] * x[4];
      a1 -= m[1] * x[5];
      a2 -= m[2] * x[6];
      a3 -= m[3] * x[7];
    }
    { const f32x4 m = *(const f32x4*)(mr + 8);
      a0 -= m[0] * x[8];
      a1 -= m[1] * x[9];
      a2 -= m[2] * x[10];
      a3 -= m[3] * x[11];
    }
    { const f32x4 m = *(const f32x4*)(mr + 12);
      a0 -= m[0] * x[12];
      a1 -= m[1] * x[13];
      a2 -= m[2] * x[14];
      a3 -= m[3] * x[15];
    }
    { const f32x4 m = *(const f32x4*)(mr + 16);
      a0 -= m[0] * x[16];
      a1 -= m[1] * x[17];
      a2 -= m[2] * x[18];
      a3 -= m[3] * x[19];
    }
    { const f32x4 m = *(const f32x4*)(mr + 20);
      a0 -= m[0] * x[20];
      a1 -= m[1] * x[21];
      a2 -= m[2] * x[22];
      a3 -= m[3] * x[23];
    }
    { const f32x4 m = *(const f32x4*)(mr + 24);
      a0 -= m[0] * x[24];
      a1 -= m[1] * x[25];
      a2 -= m[2] * x[26];
      a3 -= m[3] * x[27];
    }
    { const f32x4 m = *(const f32x4*)(mr + 28);
      a0 -= m[0] * x[28];
      a1 -= m[1] * x[29];
      a2 -= m[2] * x[30];
      a3 -= m[3] * x[31];
    }
    { const f32x4 m = *(const f32x4*)(mr + 32);
      a0 -= m[0] * x[32];
      a1 -= m[1] * x[33];
      a2 -= m[2] * x[34];
      a3 -= m[3] * x[35];
    }
    { const f32x4 m = *(const f32x4*)(mr + 36);
      a0 -= m[0] * x[36];
      a1 -= m[1] * x[37];
      a2 -= m[2] * x[38];
      a3 -= m[3] * x[39];
    }
    { const f32x4 m = *(const f32x4*)(mr + 40);
      a0 -= m[0] * x[40];
      a1 -= m[1] * x[41];
      a2 -= m[2] * x[42];
      a3 -= m[3] * x[43];
    }
    { const f32x4 m = *(const f32x4*)(mr + 44);
      a0 -= m[0] * x[44];
      a1 -= m[1] * x[45];
      a2 -= m[2] * x[46];
      a3 -= m[3] * x[47];
    }
    { const f32x4 m = *(const f32x4*)(mr + 48);
      a0 -= m[0] * x[48];
      a1 -= m[1] * x[49];
      a2 -= m[2] * x[50];
      a3 -= m[3] * x[51];
    }
    SOLVE_ROW_END(52)
    SOLVE_ROW_BEGIN(53)
    { const f32x4 m = *(const f32x4*)(mr + 0);
      a0 -= m[0] * x[0];
      a1 -= m[1] * x[1];
      a2 -= m[2] * x[2];
      a3 -= m[3] * x[3];
    }
    { const f32x4 m = *(const f32x4*)(mr + 4);
      a0 -= m[0] * x[4];
      a1 -= m[1] * x[5];
      a2 -= m[2] * x[6];
      a3 -= m[3] * x[7];
    }
    { const f32x4 m = *(const f32x4*)(mr + 8);
      a0 -= m[0] * x[8];
      a1 -= m[1] * x[9];
      a2 -= m[2] * x[10];
      a3 -= m[3] * x[11];
    }
    { const f32x4 m = *(const f32x4*)(mr + 12);
      a0 -= m[0] * x[12];
      a1 -= m[1] * x[13];
      a2 -= m[2] * x[14];
      a3 -= m[3] * x[15];
    }
    { const f32x4 m = *(const f32x4*)(mr + 16);
      a0 -= m[0] * x[16];
      a1 -= m[1] * x[17];
      a2 -= m[2] * x[18];
      a3 -= m[3] * x[19];
    }
    { const f32x4 m = *(const f32x4*)(mr + 20);
      a0 -= m[0] * x[20];
      a1 -= m[1] * x[21];
      a2 -= m[2] * x[22];
      a3 -= m[3] * x[23];
    }
    { const f32x4 m = *(const f32x4*)(mr + 24);
      a0 -= m[0] * x[24];
      a1 -= m[1] * x[25];
      a2 -= m[2] * x[26];
      a3 -= m[3] * x[27];
    }
    { const f32x4 m = *(const f32x4*)(mr + 28);
      a0 -= m[0] * x[28];
      a1 -= m[1] * x[29];
      a2 -= m[2] * x[30];
      a3 -= m[3] * x[31];
    }
    { const f32x4 m = *(const f32x4*)(mr + 32);
      a0 -= m[0] * x[32];
      a1 -= m[1] * x[33];
      a2 -= m[2] * x[34];
      a3 -= m[3] * x[35];
    }
    { const f32x4 m = *(const f32x4*)(mr + 36);
      a0 -= m[0] * x[36];
      a1 -= m[1] * x[37];
      a2 -= m[2] * x[38];
      a3 -= m[3] * x[39];
    }
    { const f32x4 m = *(const f32x4*)(mr + 40);
      a0 -= m[0] * x[40];
      a1 -= m[1] * x[41];
      a2 -= m[2] * x[42];
      a3 -= m[3] * x[43];
    }
    { const f32x4 m = *(const f32x4*)(mr + 44);
      a0 -= m[0] * x[44];
      a1 -= m[1] * x[45];
      a2 -= m[2] * x[46];
      a3 -= m[3] * x[47];
    }
    { const f32x4 m = *(const f32x4*)(mr + 48);
      a0 -= m[0] * x[48];
      a1 -= m[1] * x[49];
      a2 -= m[2] * x[50];
      a3 -= m[3] * x[51];
    }
    { const f32x4 m = *(const f32x4*)(mr + 52);
      a0 -= m[0] * x[52];
    }
    SOLVE_ROW_END(53)
    SOLVE_ROW_BEGIN(54)
    { const f32x4 m = *(const f32x4*)(mr + 0);
      a0 -= m[0] * x[0];
      a1 -= m[1] * x[1];
      a2 -= m[2] * x[2];
      a3 -= m[3] * x[3];
    }
    { const f32x4 m = *(const f32x4*)(mr + 4);
      a0 -= m[0] * x[4];
      a1 -= m[1] * x[5];
      a2 -= m[2] * x[6];
      a3 -= m[3] * x[7];
    }
    { const f32x4 m = *(const f32x4*)(mr + 8);
      a0 -= m[0] * x[8];
      a1 -= m[1] * x[9];
      a2 -= m[2] * x[10];
      a3 -= m[3] * x[11];
    }
    { const f32x4 m = *(const f32x4*)(mr + 12);
      a0 -= m[0] * x[12];
      a1 -= m[1] * x[13];
      a2 -= m[2] * x[14];
      a3 -= m[3] * x[15];
    }
    { const f32x4 m = *(const f32x4*)(mr + 16);
      a0 -= m[0] * x[16];
      a1 -= m[1] * x[17];
      a2 -= m[2] * x[18];
      a3 -= m[3] * x[19];
    }
    { const f32x4 m = *(const f32x4*)(mr + 20);
      a0 -= m[0] * x[20];
      a1 -= m[1] * x[21];
      a2 -= m[2] * x[22];
      a3 -= m[3] * x[23];
    }
    { const f32x4 m = *(const f32x4*)(mr + 24);
      a0 -= m[0] * x[24];
      a1 -= m[1] * x[25];
      a2 -= m[2] * x[26];
      a3 -= m[3] * x[27];
    }
    { const f32x4 m = *(const f32x4*)(mr + 28);
      a0 -= m[0] * x[28];
      a1 -= m[1] * x[29];
      a2 -= m[2] * x[30];
      a3 -= m[3] * x[31];
    }
    { const f32x4 m = *(const f32x4*)(mr + 32);
      a0 -= m[0] * x[32];
      a1 -= m[1] * x[33];
      a2 -= m[2] * x[34];
      a3 -= m[3] * x[35];
    }
    { const f32x4 m = *(const f32x4*)(mr + 36);
      a0 -= m[0] * x[36];
      a1 -= m[1] * x[37];
      a2 -= m[2] * x[38];
      a3 -= m[3] * x[39];
    }
    { const f32x4 m = *(const f32x4*)(mr + 40);
      a0 -= m[0] * x[40];
      a1 -= m[1] * x[41];
      a2 -= m[2] * x[42];
      a3 -= m[3] * x[43];
    }
    { const f32x4 m = *(const f32x4*)(mr + 44);
      a0 -= m[0] * x[44];
      a1 -= m[1] * x[45];
      a2 -= m[2] * x[46];
      a3 -= m[3] * x[47];
    }
    { const f32x4 m = *(const f32x4*)(mr + 48);
      a0 -= m[0] * x[48];
      a1 -= m[1] * x[49];
      a2 -= m[2] * x[50];
      a3 -= m[3] * x[51];
    }
    { const f32x4 m = *(const f32x4*)(mr + 52);
      a0 -= m[0] * x[52];
      a1 -= m[1] * x[53];
    }
    SOLVE_ROW_END(54)
    SOLVE_ROW_BEGIN(55)
    { const f32x4 m = *(const f32x4*)(mr + 0);
      a0 -= m[0] * x[0];
      a1 -= m[1] * x[1];
      a2 -= m[2] * x[2];
      a3 -= m[3] * x[3];
    }
    { const f32x4 m = *(const f32x4*)(mr + 4);
      a0 -= m[0] * x[4];
      a1 -= m[1] * x[5];
      a2 -= m[2] * x[6];
      a3 -= m[3] * x[7];
    }
    { const f32x4 m = *(const f32x4*)(mr + 8);
      a0 -= m[0] * x[8];
      a1 -= m[1] * x[9];
      a2 -= m[2] * x[10];
      a3 -= m[3] * x[11];
    }
    { const f32x4 m = *(const f32x4*)(mr + 12);
      a0 -= m[0] * x[12];
      a1 -= m[1] * x[13];
      a2 -= m[2] * x[14];
      a3 -= m[3] * x[15];
    }
    { const f32x4 m = *(const f32x4*)(mr + 16);
      a0 -= m[0] * x[16];
      a1 -= m[1] * x[17];
      a2 -= m[2] * x[18];
      a3 -= m[3] * x[19];
    }
    { const f32x4 m = *(const f32x4*)(mr + 20);
      a0 -= m[0] * x[20];
      a1 -= m[1] * x[21];
      a2 -= m[2] * x[22];
      a3 -= m[3] * x[23];
    }
    { const f32x4 m = *(const f32x4*)(mr + 24);
      a0 -= m[0] * x[24];
      a1 -= m[1] * x[25];
      a2 -= m[2] * x[26];
      a3 -= m[3] * x[27];
    }
    { const f32x4 m = *(const f32x4*)(mr + 28);
      a0 -= m[0] * x[28];
      a1 -= m[1] * x[29];
      a2 -= m[2] * x[30];
      a3 -= m[3] * x[31];
    }
    { const f32x4 m = *(const f32x4*)(mr + 32);
      a0 -= m[0] * x[32];
      a1 -= m[1] * x[33];
      a2 -= m[2] * x[34];
      a3 -= m[3] * x[35];
    }
    { const f32x4 m = *(const f32x4*)(mr + 36);
      a0 -= m[0] * x[36];
      a1 -= m[1] * x[37];
      a2 -= m[2] * x[38];
      a3 -= m[3] * x[39];
    }
    { const f32x4 m = *(const f32x4*)(mr + 40);
      a0 -= m[0] * x[40];
      a1 -= m[1] * x[41];
      a2 -= m[2] * x[42];
      a3 -= m[3] * x[43];
    }
    { const f32x4 m = *(const f32x4*)(mr + 44);
      a0 -= m[0] * x[44];
      a1 -= m[1] * x[45];
      a2 -= m[2] * x[46];
      a3 -= m[3] * x[47];
    }
    { const f32x4 m = *(const f32x4*)(mr + 48);
      a0 -= m[0] * x[48];
      a1 -= m[1] * x[49];
      a2 -= m[2] * x[50];
      a3 -= m[3] * x[51];
    }
    { const f32x4 m = *(const f32x4*)(mr + 52);
      a0 -= m[0] * x[52];
      a1 -= m[1] * x[53];
      a2 -= m[2] * x[54];
    }
    SOLVE_ROW_END(55)
    SOLVE_ROW_BEGIN(56)
    { const f32x4 m = *(const f32x4*)(mr + 0);
      a0 -= m[0] * x[0];
      a1 -= m[1] * x[1];
      a2 -= m[2] * x[2];
      a3 -= m[3] * x[3];
    }
    { const f32x4 m = *(const f32x4*)(mr + 4);
      a0 -= m[0] * x[4];
      a1 -= m[1] * x[5];
      a2 -= m[2] * x[6];
      a3 -= m[3] * x[7];
    }
    { const f32x4 m = *(const f32x4*)(mr + 8);
      a0 -= m[0] * x[8];
      a1 -= m[1] * x[9];
      a2 -= m[2] * x[10];
      a3 -= m[3] * x[11];
    }
    { const f32x4 m = *(const f32x4*)(mr + 12);
      a0 -= m[0] * x[12];
      a1 -= m[1] * x[13];
      a2 -= m[2] * x[14];
      a3 -= m[3] * x[15];
    }
    { const f32x4 m = *(const f32x4*)(mr + 16);
      a0 -= m[0] * x[16];
      a1 -= m[1] * x[17];
      a2 -= m[2] * x[18];
      a3 -= m[3] * x[19];
    }
    { const f32x4 m = *(const f32x4*)(mr + 20);
      a0 -= m[0] * x[20];
      a1 -= m[1] * x[21];
      a2 -= m[2] * x[22];
      a3 -= m[3] * x[23];
    }
    { const f32x4 m = *(const f32x4*)(mr + 24);
      a0 -= m[0] * x[24];
      a1 -= m[1] * x[25];
      a2 -= m[2] * x[26];
      a3 -= m[3] * x[27];
    }
    { const f32x4 m = *(const f32x4*)(mr + 28);
      a0 -= m[0] * x[28];
      a1 -= m[1] * x[29];
      a2 -= m[2] * x[30];
      a3 -= m[3] * x[31];
    }
    { const f32x4 m = *(const f32x4*)(mr + 32);
      a0 -= m[0] * x[32];
      a1 -= m[1] * x[33];
      a2 -= m[2] * x[34];
      a3 -= m[3] * x[35];
    }
    { const f32x4 m = *(const f32x4*)(mr + 36);
      a0 -= m[0] * x[36];
      a1 -= m[1] * x[37];
      a2 -= m[2] * x[38];
      a3 -= m[3] * x[39];
    }
    { const f32x4 m = *(const f32x4*)(mr + 40);
      a0 -= m[0] * x[40];
      a1 -= m[1] * x[41];
      a2 -= m[2] * x[42];
      a3 -= m[3] * x[43];
    }
    { const f32x4 m = *(const f32x4*)(mr + 44);
      a0 -= m[0] * x[44];
      a1 -= m[1] * x[45];
      a2 -= m[2] * x[46];
      a3 -= m[3] * x[47];
    }
    { const f32x4 m = *(const f32x4*)(mr + 48);
      a0 -= m[0] * x[48];
      a1 -= m[1] * x[49];
      a2 -= m[2] * x[50];
      a3 -= m[3] * x[51];
    }
    { const f32x4 m = *(const f32x4*)(mr + 52);
      a0 -= m[0] * x[52];
      a1 -= m[1] * x[53];
      a2 -= m[2] * x[54];
      a3 -= m[3] * x[55];
    }
    SOLVE_ROW_END(56)
    SOLVE_ROW_BEGIN(57)
    { const f32x4 m = *(const f32x4*)(mr + 0);
      a0 -= m[0] * x[0];
      a1 -= m[1] * x[1];
      a2 -= m[2] * x[2];
      a3 -= m[3] * x[3];
    }
    { const f32x4 m = *(const f32x4*)(mr + 4);
      a0 -= m[0] * x[4];
      a1 -= m[1] * x[5];
      a2 -= m[2] * x[6];
      a3 -= m[3] * x[7];
    }
    { const f32x4 m = *(const f32x4*)(mr + 8);
      a0 -= m[0] * x[8];
      a1 -= m[1] * x[9];
      a2 -= m[2] * x[10];
      a3 -= m[3] * x[11];
    }
    { const f32x4 m = *(const f32x4*)(mr + 12);
      a0 -= m[0] * x[12];
      a1 -= m[1] * x[13];
      a2 -= m[2] * x[14];
      a3 -= m[3] * x[15];
    }
    { const f32x4 m = *(const f32x4*)(mr + 16);
      a0 -= m[0] * x[16];
      a1 -= m[1] * x[17];
      a2 -= m[2] * x[18];
      a3 -= m[3] * x[19];
    }
    { const f32x4 m = *(const f32x4*)(mr + 20);
      a0 -= m[0] * x[20];
      a1 -= m[1] * x[21];
      a2 -= m[2] * x[22];
      a3 -= m[3] * x[23];
    }
    { const f32x4 m = *(const f32x4*)(mr + 24);
      a0 -= m[0] * x[24];
      a1 -= m[1] * x[25];
      a2 -= m[2] * x[26];
      a3 -= m[3] * x[27];
    }
    { const f32x4 m = *(const f32x4*)(mr + 28);
      a0 -= m[0] * x[28];
      a1 -= m[1] * x[29];
      a2 -= m[2] * x[30];
      a3 -= m[3] * x[31];
    }
    { const f32x4 m = *(const f32x4*)(mr + 32);
      a0 -= m[0] * x[32];
      a1 -= m[1] * x[33];
      a2 -= m[2] * x[34];
      a3 -= m[3] * x[35];
    }
    { const f32x4 m = *(const f32x4*)(mr + 36);
      a0 -= m[0] * x[36];
      a1 -= m[1] * x[37];
      a2 -= m[2] * x[38];
      a3 -= m[3] * x[39];
    }
    { const f32x4 m = *(const f32x4*)(mr + 40);
      a0 -= m[0] * x[40];
      a1 -= m[1] * x[41];
      a2 -= m[2] * x[42];
      a3 -= m[3] * x[43];
    }
    { const f32x4 m = *(const f32x4*)(mr + 44);
      a0 -= m[0] * x[44];
      a1 -= m[1] * x[45];
      a2 -= m[2] * x[46];
      a3 -= m[3] * x[47];
    }
    { const f32x4 m = *(const f32x4*)(mr + 48);
      a0 -= m[0] * x[48];
      a1 -= m[1] * x[49];
      a2 -= m[2] * x[50];
      a3 -= m[3] * x[51];
    }
    { const f32x4 m = *(const f32x4*)(mr + 52);
      a0 -= m[0] * x[52];
      a1 -= m[1] * x[53];
      a2 -= m[2] * x[54];
      a3 -= m[3] * x[55];
    }
    { const f32x4 m = *(const f32x4*)(mr + 56);
      a0 -= m[0] * x[56];
    }
    SOLVE_ROW_END(57)
    SOLVE_ROW_BEGIN(58)
    { const f32x4 m = *(const f32x4*)(mr + 0);
      a0 -= m[0] * x[0];
      a1 -= m[1] * x[1];
      a2 -= m[2] * x[2];
      a3 -= m[3] * x[3];
    }
    { const f32x4 m = *(const f32x4*)(mr + 4);
      a0 -= m[0] * x[4];
      a1 -= m[1] * x[5];
      a2 -= m[2] * x[6];
      a3 -= m[3] * x[7];
    }
    { const f32x4 m = *(const f32x4*)(mr + 8);
      a0 -= m[0] * x[8];
      a1 -= m[1] * x[9];
      a2 -= m[2] * x[10];
      a3 -= m[3] * x[11];
    }
    { const f32x4 m = *(const f32x4*)(mr + 12);
      a0 -= m[0] * x[12];
      a1 -= m[1] * x[13];
      a2 -= m[2] * x[14];
      a3 -= m[3] * x[15];
    }
    { const f32x4 m = *(const f32x4*)(mr + 16);
      a0 -= m[0] * x[16];
      a1 -= m[1] * x[17];
      a2 -= m[2] * x[18];
      a3 -= m[3] * x[19];
    }
    { const f32x4 m = *(const f32x4*)(mr + 20);
      a0 -= m[0] * x[20];
      a1 -= m[1] * x[21];
      a2 -= m[2] * x[22];
      a3 -= m[3] * x[23];
    }
    { const f32x4 m = *(const f32x4*)(mr + 24);
      a0 -= m[0] * x[24];
      a1 -= m[1] * x[25];
      a2 -= m[2] * x[26];
      a3 -= m[3] * x[27];
    }
    { const f32x4 m = *(const f32x4*)(mr + 28);
      a0 -= m[0] * x[28];
      a1 -= m[1] * x[29];
      a2 -= m[2] * x[30];
      a3 -= m[3] * x[31];
    }
    { const f32x4 m = *(const f32x4*)(mr + 32);
      a0 -= m[0] * x[32];
      a1 -= m[1] * x[33];
      a2 -= m[2] * x[34];
      a3 -= m[3] * x[35];
    }
    { const f32x4 m = *(const f32x4*)(mr + 36);
      a0 -= m[0] * x[36];
      a1 -= m[1] * x[37];
      a2 -= m[2] * x[38];
      a3 -= m[3] * x[39];
    }
    { const f32x4 m = *(const f32x4*)(mr + 40);
      a0 -= m[0] * x[40];
      a1 -= m[1] * x[41];
      a2 -= m[2] * x[42];
      a3 -= m[3] * x[43];
    }
    { const f32x4 m = *(const f32x4*)(mr + 44);
      a0 -= m[0] * x[44];
      a1 -= m[1] * x[45];
      a2 -= m[2] * x[46];
      a3 -= m[3] * x[47];
    }
    { const f32x4 m = *(const f32x4*)(mr + 48);
      a0 -= m[0] * x[48];
      a1 -= m[1] * x[49];
      a2 -= m[2] * x[50];
      a3 -= m[3] * x[51];
    }
    { const f32x4 m = *(const f32x4*)(mr + 52);
      a0 -= m[0] * x[52];
      a1 -= m[1] * x[53];
      a2 -= m[2] * x[54];
      a3 -= m[3] * x[55];
    }
    { const f32x4 m = *(const f32x4*)(mr + 56);
      a0 -= m[0] * x[56];
      a1 -= m[1] * x[57];
    }
    SOLVE_ROW_END(58)
    SOLVE_ROW_BEGIN(59)
    { const f32x4 m = *(const f32x4*)(mr + 0);
      a0 -= m[0] * x[0];
      a1 -= m[1] * x[1];
      a2 -= m[2] * x[2];
      a3 -= m[3] * x[3];
    }
    { const f32x4 m = *(const f32x4*)(mr + 4);
      a0 -= m[0] * x[4];
      a1 -= m[1] * x[5];
      a2 -= m[2] * x[6];
      a3 -= m[3] * x[7];
    }
    { const f32x4 m = *(const f32x4*)(mr + 8);
      a0 -= m[0] * x[8];
      a1 -= m[1] * x[9];
      a2 -= m[2] * x[10];
      a3 -= m[3] * x[11];
    }
    { const f32x4 m = *(const f32x4*)(mr + 12);
      a0 -= m[0] * x[12];
      a1 -= m[1] * x[13];
      a2 -= m[2] * x[14];
      a3 -= m[3] * x[15];
    }
    { const f32x4 m = *(const f32x4*)(mr + 16);
      a0 -= m[0] * x[16];
      a1 -= m[1] * x[17];
      a2 -= m[2] * x[18];
      a3 -= m[3] * x[19];
    }
    { const f32x4 m = *(const f32x4*)(mr + 20);
      a0 -= m[0] * x[20];
      a1 -= m[1] * x[21];
      a2 -= m[2] * x[22];
      a3 -= m[3] * x[23];
    }
    { const f32x4 m = *(const f32x4*)(mr + 24);
      a0 -= m[0] * x[24];
      a1 -= m[1] * x[25];
      a2 -= m[2] * x[26];
      a3 -= m[3] * x[27];
    }
    { const f32x4 m = *(const f32x4*)(mr + 28);
      a0 -= m[0] * x[28];
      a1 -= m[1] * x[29];
      a2 -= m[2] * x[30];
      a3 -= m[3] * x[31];
    }
    { const f32x4 m = *(const f32x4*)(mr + 32);
      a0 -= m[0] * x[32];
      a1 -= m[1] * x[33];
      a2 -= m[2] * x[34];
      a3 -= m[3] * x[35];
    }
    { const f32x4 m = *(const f32x4*)(mr + 36);
      a0 -= m[0] * x[36];
      a1 -= m[1] * x[37];
      a2 -= m[2] * x[38];
      a3 -= m[3] * x[39];
    }
    { const f32x4 m = *(const f32x4*)(mr + 40);
      a0 -= m[0] * x[40];
      a1 -= m[1] * x[41];
      a2 -= m[2] * x[42];
      a3 -= m[3] * x[43];
    }
    { const f32x4 m = *(const f32x4*)(mr + 44);
      a0 -= m[0] * x[44];
      a1 -= m[1] * x[45];
      a2 -= m[2] * x[46];
      a3 -= m[3] * x[47];
    }
    { const f32x4 m = *(const f32x4*)(mr + 48);
      a0 -= m[0] * x[48];
      a1 -= m[1] * x[49];
      a2 -= m[2] * x[50];
      a3 -= m[3] * x[51];
    }
    { const f32x4 m = *(const f32x4*)(mr + 52);
      a0 -= m[0] * x[52];
      a1 -= m[1] * x[53];
      a2 -= m[2] * x[54];
      a3 -= m[3] * x[55];
    }
    { const f32x4 m = *(const f32x4*)(mr + 56);
      a0 -= m[0] * x[56];
      a1 -= m[1] * x[57];
      a2 -= m[2] * x[58];
    }
    SOLVE_ROW_END(59)
    SOLVE_ROW_BEGIN(60)
    { const f32x4 m = *(const f32x4*)(mr + 0);
      a0 -= m[0] * x[0];
      a1 -= m[1] * x[1];
      a2 -= m[2] * x[2];
      a3 -= m[3] * x[3];
    }
    { const f32x4 m = *(const f32x4*)(mr + 4);
      a0 -= m[0] * x[4];
      a1 -= m[1] * x[5];
      a2 -= m[2] * x[6];
      a3 -= m[3] * x[7];
    }
    { const f32x4 m = *(const f32x4*)(mr + 8);
      a0 -= m[0] * x[8];
      a1 -= m[1] * x[9];
      a2 -= m[2] * x[10];
      a3 -= m[3] * x[11];
    }
    { const f32x4 m = *(const f32x4*)(mr + 12);
      a0 -= m[0] * x[12];
      a1 -= m[1] * x[13];
      a2 -= m[2] * x[14];
      a3 -= m[3] * x[15];
    }
    { const f32x4 m = *(const f32x4*)(mr + 16);
      a0 -= m[0] * x[16];
      a1 -= m[1] * x[17];
      a2 -= m[2] * x[18];
      a3 -= m[3] * x[19];
    }
    { const f32x4 m = *(const f32x4*)(mr + 20);
      a0 -= m[0] * x[20];
      a1 -= m[1] * x[21];
      a2 -= m[2] * x[22];
      a3 -= m[3] * x[23];
    }
    { const f32x4 m = *(const f32x4*)(mr + 24);
      a0 -= m[0] * x[24];
      a1 -= m[1] * x[25];
      a2 -= m[2] * x[26];
      a3 -= m[3] * x[27];
    }
    { const f32x4 m = *(const f32x4*)(mr + 28);
      a0 -= m[0] * x[28];
      a1 -= m[1] * x[29];
      a2 -= m[2] * x[30];
      a3 -= m[3] * x[31];
    }
    { const f32x4 m = *(const f32x4*)(mr + 32);
      a0 -= m[0] * x[32];
      a1 -= m[1] * x[33];
      a2 -= m[2] * x[34];
      a3 -= m[3] * x[35];
    }
    { const f32x4 m = *(const f32x4*)(mr + 36);
      a0 -= m[0] * x[36];
      a1 -= m[1] * x[37];
      a2 -= m[2] * x[38];
      a3 -= m[3] * x[39];
    }
    { const f32x4 m = *(const f32x4*)(mr + 40);
      a0 -= m[0] * x[40];
      a1 -= m[1] * x[41];
      a2 -= m[2] * x[42];
      a3 -= m[3] * x[43];
    }
    { const f32x4 m = *(const f32x4*)(mr + 44);
      a0 -= m[0] * x[44];
      a1 -= m[1] * x[45];
      a2 -= m[2] * x[46];
      a3 -= m[3] * x[47];
    }
    { const f32x4 m = *(const f32x4*)(mr + 48);
      a0 -= m[0] * x[48];
      a1 -= m[1] * x[49];
      a2 -= m[2] * x[50];
      a3 -= m[3] * x[51];
    }
    { const f32x4 m = *(const f32x4*)(mr + 52);
      a0 -= m[0] * x[52];
      a1 -= m[1] * x[53];
      a2 -= m[2] * x[54];
      a3 -= m[3] * x[55];
    }
    { const f32x4 m = *(const f32x4*)(mr + 56);
      a0 -= m[0] * x[56];
      a1 -= m[1] * x[57];
      a2 -= m[2] * x[58];
      a3 -= m[3] * x[59];
    }
    SOLVE_ROW_END(60)
    SOLVE_ROW_BEGIN(61)
    { const f32x4 m = *(const f32x4*)(mr + 0);
      a0 -= m[0] * x[0];
      a1 -= m[1] * x[1];
      a2 -= m[2] * x[2];
      a3 -= m[3] * x[3];
    }
    { const f32x4 m = *(const f32x4*)(mr + 4);
      a0 -= m[0] * x[4];
      a1 -= m[1] * x[5];
      a2 -= m[2] * x[6];
      a3 -= m[3] * x[7];
    }
    { const f32x4 m = *(const f32x4*)(mr + 8);
      a0 -= m[0] * x[8];
      a1 -= m[1] * x[9];
      a2 -= m[2] * x[10];
      a3 -= m[3] * x[11];
    }
    { const f32x4 m = *(const f32x4*)(mr + 12);
      a0 -= m[0] * x[12];
      a1 -= m[1] * x[13];
      a2 -= m[2] * x[14];
      a3 -= m[3] * x[15];
    }
    { const f32x4 m = *(const f32x4*)(mr + 16);
      a0 -= m[0] * x[16];
      a1 -= m[1] * x[17];
      a2 -= m[2] * x[18];
      a3 -= m[3] * x[19];
    }
    { const f32x4 m = *(const f32x4*)(mr + 20);
      a0 -= m[0] * x[20];
      a1 -= m[1] * x[21];
      a2 -= m[2] * x[22];
      a3 -= m[3] * x[23];
    }
    { const f32x4 m = *(const f32x4*)(mr + 24);
      a0 -= m[0] * x[24];
      a1 -= m[1] * x[25];
      a2 -= m[2] * x[26];
      a3 -= m[3] * x[27];
    }
    { const f32x4 m = *(const f32x4*)(mr + 28);
      a0 -= m[0] * x[28];
      a1 -= m[1] * x[29];
      a2 -= m[2] * x[30];
      a3 -= m[3] * x[31];
    }
    { const f32x4 m = *(const f32x4*)(mr + 32);
      a0 -= m[0] * x[32];
      a1 -= m[1] * x[33];
      a2 -= m[2] * x[34];
      a3 -= m[3] * x[35];
    }
    { const f32x4 m = *(const f32x4*)(mr + 36);
      a0 -= m[0] * x[36];
      a1 -= m[1] * x[37];
      a2 -= m[2] * x[38];
      a3 -= m[3] * x[39];
    }
    { const f32x4 m = *(const f32x4*)(mr + 40);
      a0 -= m[0] * x[40];
      a1 -= m[1] * x[41];
      a2 -= m[2] * x[42];
      a3 -= m[3] * x[43];
    }
    { const f32x4 m = *(const f32x4*)(mr + 44);
      a0 -= m[0] * x[44];
      a1 -= m[1] * x[45];
      a2 -= m[2] * x[46];
      a3 -= m[3] * x[47];
    }
    { const f32x4 m = *(const f32x4*)(mr + 48);
      a0 -= m[0] * x[48];
      a1 -= m[1] * x[49];
      a2 -= m[2] * x[50];
      a3 -= m[3] * x[51];
    }
    { const f32x4 m = *(const f32x4*)(mr + 52);
      a0 -= m[0] * x[52];
      a1 -= m[1] * x[53];
      a2 -= m[2] * x[54];
      a3 -= m[3] * x[55];
    }
    { const f32x4 m = *(const f32x4*)(mr + 56);
      a0 -= m[0] * x[56];
      a1 -= m[1] * x[57];
      a2 -= m[2] * x[58];
      a3 -= m[3] * x[59];
    }
    { const f32x4 m = *(const f32x4*)(mr + 60);
      a0 -= m[0] * x[60];
    }
    SOLVE_ROW_END(61)
    SOLVE_ROW_BEGIN(62)
    { const f32x4 m = *(const f32x4*)(mr + 0);
      a0 -= m[0] * x[0];
      a1 -= m[1] * x[1];
      a2 -= m[2] * x[2];
      a3 -= m[3] * x[3];
    }
    { const f32x4 m = *(const f32x4*)(mr + 4);
      a0 -= m[0] * x[4];
      a1 -= m[1] * x[5];
      a2 -= m[2] * x[6];
      a3 -= m[3] * x[7];
    }
    { const f32x4 m = *(const f32x4*)(mr + 8);
      a0 -= m[0] * x[8];
      a1 -= m[1] * x[9];
      a2 -= m[2] * x[10];
      a3 -= m[3] * x[11];
    }
    { const f32x4 m = *(const f32x4*)(mr + 12);
      a0 -= m[0] * x[12];
      a1 -= m[1] * x[13];
      a2 -= m[2] * x[14];
      a3 -= m[3] * x[15];
    }
    { const f32x4 m = *(const f32x4*)(mr + 16);
      a0 -= m[0] * x[16];
      a1 -= m[1] * x[17];
      a2 -= m[2] * x[18];
      a3 -= m[3] * x[19];
    }
    { const f32x4 m = *(const f32x4*)(mr + 20);
      a0 -= m[0] * x[20];
      a1 -= m[1] * x[21];
      a2 -= m[2] * x[22];
      a3 -= m[3] * x[23];
    }
    { const f32x4 m = *(const f32x4*)(mr + 24);
      a0 -= m[0] * x[24];
      a1 -= m[1] * x[25];
      a2 -= m[2] * x[26];
      a3 -= m[3] * x[27];
    }
    { const f32x4 m = *(const f32x4*)(mr + 28);
      a0 -= m[0] * x[28];
      a1 -= m[1] * x[29];
      a2 -= m[2] * x[30];
      a3 -= m[3] * x[31];
    }
    { const f32x4 m = *(const f32x4*)(mr + 32);
      a0 -= m[0] * x[32];
      a1 -= m[1] * x[33];
      a2 -= m[2] * x[34];
      a3 -= m[3] * x[35];
    }
    { const f32x4 m = *(const f32x4*)(mr + 36);
      a0 -= m[0] * x[36];
      a1 -= m[1] * x[37];
      a2 -= m[2] * x[38];
      a3 -= m[3] * x[39];
    }
    { const f32x4 m = *(const f32x4*)(mr + 40);
      a0 -= m[0] * x[40];
      a1 -= m[1] * x[41];
      a2 -= m[2] * x[42];
      a3 -= m[3] * x[43];
    }
    { const f32x4 m = *(const f32x4*)(mr + 44);
      a0 -= m[0] * x[44];
      a1 -= m[1] * x[45];
      a2 -= m[2] * x[46];
      a3 -= m[3] * x[47];
    }
    { const f32x4 m = *(const f32x4*)(mr + 48);
      a0 -= m[0] * x[48];
      a1 -= m[1] * x[49];
      a2 -= m[2] * x[50];
      a3 -= m[3] * x[51];
    }
    { const f32x4 m = *(const f32x4*)(mr + 52);
      a0 -= m[0] * x[52];
      a1 -= m[1] * x[53];
      a2 -= m[2] * x[54];
      a3 -= m[3] * x[55];
    }
    { const f32x4 m = *(const f32x4*)(mr + 56);
      a0 -= m[0] * x[56];
      a1 -= m[1] * x[57];
      a2 -= m[2] * x[58];
      a3 -= m[3] * x[59];
    }
    { const f32x4 m = *(const f32x4*)(mr + 60);
      a0 -= m[0] * x[60];
      a1 -= m[1] * x[61];
    }
    SOLVE_ROW_END(62)
    SOLVE_ROW_BEGIN(63)
    { const f32x4 m = *(const f32x4*)(mr + 0);
      a0 -= m[0] * x[0];
      a1 -= m[1] * x[1];
      a2 -= m[2] * x[2];
      a3 -= m[3] * x[3];
    }
    { const f32x4 m = *(const f32x4*)(mr + 4);
      a0 -= m[0] * x[4];
      a1 -= m[1] * x[5];
      a2 -= m[2] * x[6];
      a3 -= m[3] * x[7];
    }
    { const f32x4 m = *(const f32x4*)(mr + 8);
      a0 -= m[0] * x[8];
      a1 -= m[1] * x[9];
      a2 -= m[2] * x[10];
      a3 -= m[3] * x[11];
    }
    { const f32x4 m = *(const f32x4*)(mr + 12);
      a0 -= m[0] * x[12];
      a1 -= m[1] * x[13];
      a2 -= m[2] * x[14];
      a3 -= m[3] * x[15];
    }
    { const f32x4 m = *(const f32x4*)(mr + 16);
      a0 -= m[0] * x[16];
      a1 -= m[1] * x[17];
      a2 -= m[2] * x[18];
      a3 -= m[3] * x[19];
    }
    { const f32x4 m = *(const f32x4*)(mr + 20);
      a0 -= m[0] * x[20];
      a1 -= m[1] * x[21];
      a2 -= m[2] * x[22];
      a3 -= m[3] * x[23];
    }
    { const f32x4 m = *(const f32x4*)(mr + 24);
      a0 -= m[0] * x[24];
      a1 -= m[1] * x[25];
      a2 -= m[2] * x[26];
      a3 -= m[3] * x[27];
    }
    { const f32x4 m = *(const f32x4*)(mr + 28);
      a0 -= m[0] * x[28];
      a1 -= m[1] * x[29];
      a2 -= m[2] * x[30];
      a3 -= m[3] * x[31];
    }
    { const f32x4 m = *(const f32x4*)(mr + 32);
      a0 -= m[0] * x[32];
      a1 -= m[1] * x[33];
      a2 -= m[2] * x[34];
      a3 -= m[3] * x[35];
    }
    { const f32x4 m = *(const f32x4*)(mr + 36);
      a0 -= m[0] * x[36];
      a1 -= m[1] * x[37];
      a2 -= m[2] * x[38];
      a3 -= m[3] * x[39];
    }
    { const f32x4 m = *(const f32x4*)(mr + 40);
      a0 -= m[0] * x[40];
      a1 -= m[1] * x[41];
      a2 -= m[2] * x[42];
      a3 -= m[3] * x[43];
    }
    { const f32x4 m = *(const f32x4*)(mr + 44);
      a0 -= m[0] * x[44];
      a1 -= m[1] * x[45];
      a2 -= m[2] * x[46];
      a3 -= m[3] * x[47];
    }
    { const f32x4 m = *(const f32x4*)(mr + 48);
      a0 -= m[0] * x[48];
      a1 -= m[1] * x[49];
      a2 -= m[2] * x[50];
      a3 -= m[3] * x[51];
    }
    { const f32x4 m = *(const f32x4*)(mr + 52);
      a0 -= m[0] * x[52];
      a1 -= m[1] * x[53];
      a2 -= m[2] * x[54];
      a3 -= m[3] * x[55];
    }
    { const f32x4 m = *(const f32x4*)(mr + 56);
      a0 -= m[0] * x[56];
      a1 -= m[1] * x[57];
      a2 -= m[2] * x[58];
      a3 -= m[3] * x[59];
    }
    { const f32x4 m = *(const f32x4*)(mr + 60);
      a0 -= m[0] * x[60];
      a1 -= m[1] * x[61];
      a2 -= m[2] * x[62];
    }
    SOLVE_ROW_END(63)
    if (isw) { bf16_t* dW = c.W<bf16_t>(WS_DW);
#pragma unroll
        for (int i = 0; i < 64; ++i) dW[(ch * 64 + i) * 128 + col] = f2bf(x[i]);
    } else { bf16_t* dUT = c.W<bf16_t>(WS_DUT);
#pragma unroll
        for (int l0 = 0; l0 < 64; l0 += 8) { u32x4 a; a.x = pk2(x[l0], x[l0 + 1]); a.y = pk2(x[l0 + 2], x[l0 + 3]); a.z = pk2(x[l0 + 4], x[l0 + 5]); a.w = pk2(x[l0 + 6], x[l0 + 7]);
            *(u32x4*)(dUT + (ch * 128 + col) * 64 + l0) = a; } }
}

__device__ void ssd_mm(const Ctx& c, int ck, int g, int lb) {
    const bf16_t* sB = c.W<bf16_t>(WS_SB); const bf16_t* sC = c.W<bf16_t>(WS_SC); const float* sAcs = c.W<float>(WS_SACS); bf16_t* sMm = c.W<bf16_t>(WS_SMM);
    const int r = c.r, q = c.q, t0 = ck * 64;
    f32x4 cb[4];
#pragma unroll
    for (int sb = 0; sb < 4; ++sb) { f32x4 a = (f32x4){0.f, 0.f, 0.f, 0.f};
#pragma unroll
        for (int k0 = 0; k0 < 128; k0 += 32)
            a = mfma16(ldfrag(sB + (size_t)(t0 + sb * 16 + r) * 256 + g * 128 + k0 + q * 8), ldfrag(sC + (size_t)(t0 + lb * 16 + r) * 256 + g * 128 + k0 + q * 8), a);
        cb[sb] = a; }
    const int l = lb * 16 + r;
    for (int hh = 0; hh < 8; ++hh) { const int h = g * 8 + hh; const float* ac = sAcs + (size_t)(ck * 16 + h) * 64; const float al = ac[l];
#pragma unroll
        for (int sb = 0; sb < 4; ++sb) { const f32x4 as = *(const f32x4*)(ac + sb * 16 + 4 * q); f32x4 o;
#pragma unroll
            for (int j = 0; j < 4; ++j) { const int s = sb * 16 + 4 * q + j; o[j] = (s <= l) ? cb[sb][j] * __expf(al - as[j]) : 0.f; }
            *(u32x2*)(sMm + ((size_t)(ck * 16 + h) * 64 + l) * 64 + sb * 16 + 4 * q) = pk4(o); } }
}
__device__ void ssd_s1(const Ctx& c, int ck, int h) {
    const bf16_t* sXw = c.W<bf16_t>(WS_SXW); const bf16_t* sBT = c.W<bf16_t>(WS_SBT); bf16_t* sSt = c.W<bf16_t>(WS_SST);
    const int r = c.r, q = c.q, g = h >> 3; const size_t chh = (size_t)(ck * 16 + h);
    bf16x8 xw[4][2];
#pragma unroll
    for (int pb = 0; pb < 4; ++pb)
#pragma unroll
        for (int kk = 0; kk < 2; ++kk) xw[pb][kk] = ldfrag(sXw + (chh * 64 + pb * 16 + r) * 64 + kk * 32 + q * 8);
#pragma unroll
    for (int nb = 0; nb < 8; ++nb) { bf16x8 bt[2];
#pragma unroll
        for (int kk = 0; kk < 2; ++kk) bt[kk] = ldfrag(sBT + ((size_t)(ck * 2 + g) * 128 + nb * 16 + r) * 64 + kk * 32 + q * 8);
#pragma unroll
        for (int pb = 0; pb < 4; ++pb) { f32x4 a = (f32x4){0.f, 0.f, 0.f, 0.f};
#pragma unroll
            for (int kk = 0; kk < 2; ++kk) a = mfma16(bt[kk], xw[pb][kk], a);
            *(u32x2*)(sSt + (chh * 64 + pb * 16 + r) * 128 + nb * 16 + 4 * q) = pk4(a); } }
}
__device__ void gla_attn(const Ctx& c, int ck, int h, int ib) {
    const bf16_t* gQg = c.W<bf16_t>(WS_GQG); const bf16_t* gKn = c.W<bf16_t>(WS_GKN); bf16_t* gAtt = c.W<bf16_t>(WS_GATT);
    const int r = c.r, q = c.q; const size_t chh = (size_t)(ck * 4 + h); const int i = ib * 16 + r;
#pragma unroll
    for (int jb = 0; jb < 4; ++jb) { f32x4 a = (f32x4){0.f, 0.f, 0.f, 0.f};
        if (jb <= ib) {
#pragma unroll
            for (int k0 = 0; k0 < 128; k0 += 32)
                a = mfma16(ldfrag(gKn + (chh * 64 + jb * 16 + r) * 128 + k0 + q * 8), ldfrag(gQg + (chh * 64 + i) * 128 + k0 + q * 8), a);
        }
#pragma unroll
        for (int j = 0; j < 4; ++j) { const int jj = jb * 16 + 4 * q + j; if (jj > i) a[j] = 0.f; }
        *(u32x2*)(gAtt + (chh * 64 + i) * 64 + jb * 16 + 4 * q) = pk4(a); }
}
__device__ void gla_g1(const Ctx& c, int ck, int h, int vq) {
    const bf16_t* gVT = c.W<bf16_t>(WS_GVT); const bf16_t* gKnT = c.W<bf16_t>(WS_GKNT); bf16_t* gSt = c.W<bf16_t>(WS_GST); const float* gDec = c.W<float>(WS_GDEC);
    const int r = c.r, q = c.q; const size_t chh = (size_t)(ck * 4 + h);
    bf16x8 vt[4][2];
#pragma unroll
    for (int vb = 0; vb < 4; ++vb)
#pragma unroll
        for (int kk = 0; kk < 2; ++kk) vt[vb][kk] = ldfrag(gVT + (chh * 256 + (vq * 4 + vb) * 16 + r) * 64 + kk * 32 + q * 8);
#pragma unroll
    for (int kb = 0; kb < 8; ++kb) { bf16x8 kt[2];
#pragma unroll
        for (int kk = 0; kk < 2; ++kk) kt[kk] = ldfrag(gKnT + (chh * 128 + kb * 16 + r) * 64 + kk * 32 + q * 8);
        const f32x4 d = *(const f32x4*)(gDec + (size_t)ck * 512 + h * 128 + kb * 16 + 4 * q);
#pragma unroll
        for (int vb = 0; vb < 4; ++vb) { f32x4 a = (f32x4){0.f, 0.f, 0.f, 0.f};
#pragma unroll
            for (int kk = 0; kk < 2; ++kk) a = mfma16(kt[kk], vt[vb][kk], a);
            a = a * d;
            *(u32x2*)(gSt + (chh * 256 + (vq * 4 + vb) * 16 + r) * 128 + kb * 16 + 4 * q) = pk4(a); } }
}

__device__ void scan_ssd(const Ctx& c, int idx) {
    bf16_t* sSt = c.W<bf16_t>(WS_SST); const float* sAcs = c.W<float>(WS_SACS);
    const size_t e4 = (size_t)idx * 4; const int h = (int)(e4 >> 13);
    f32x4 S = (f32x4){0.f, 0.f, 0.f, 0.f};
#pragma unroll 4
    for (int ck = 0; ck < NCH; ++ck) { u32x2* ad = (u32x2*)(sSt + (size_t)ck * 131072 + e4);
        const f32x4 st = up4(__builtin_nontemporal_load(ad)); const float d = __expf(sAcs[(size_t)(ck * 16 + h) * 64 + 63]);
        __builtin_nontemporal_store(pk4(S), ad); S = S * d + st; }
}
__device__ void scan_gla(const Ctx& c, int idx) {
    bf16_t* gSt = c.W<bf16_t>(WS_GST); const float* gDec = c.W<float>(WS_GDEC);
    const size_t e4 = (size_t)idx * 4; const int h = (int)(e4 >> 15), k4 = (int)(e4 & 127);
    f32x4 S = (f32x4){0.f, 0.f, 0.f, 0.f};
#pragma unroll 4
    for (int ck = 0; ck < NCH; ++ck) { u32x2* ad = (u32x2*)(gSt + (size_t)ck * 131072 + e4);
        const f32x4 st = up4(__builtin_nontemporal_load(ad)); const f32x4 d = *(const f32x4*)(gDec + (size_t)ck * 512 + h * 128 + k4);
        __builtin_nontemporal_store(pk4(S), ad); S = S * d + st; }
}
struct DnStage { bf16x8 f[4]; u32x2 u; float gl; };
__device__ __forceinline__ void dn_stage_load(DnStage& S, const bf16_t* dW, const bf16_t* dUT, const bf16_t* dKdT, const float* dGl, int ck, int h, int vs, int wave, int r, int q) {
    const int cc = ck < NCH ? ck : NCH - 1; const size_t ch = (size_t)(cc * 8 + h);
    if (wave < 4) {
#pragma unroll
        for (int kk = 0; kk < 4; ++kk) S.f[kk] = ldfrag(dW + (ch * 64 + wave * 16 + r) * 128 + kk * 32 + q * 8);
        S.u = *(const u32x2*)(dUT + (ch * 128 + vs * 16 + r) * 64 + wave * 16 + 4 * q);
    } else {
#pragma unroll
        for (int t = 0; t < 2; ++t)
#pragma unroll
            for (int kk = 0; kk < 2; ++kk) S.f[t * 2 + kk] = ldfrag(dKdT + (ch * 128 + ((wave - 4) * 2 + t) * 16 + r) * 64 + kk * 32 + q * 8);
        S.gl = dGl[ch];
    }
}
__device__ __forceinline__ void dn_step(const DnStage& S, f32x4 (&Sacc)[2], bf16_t* ST, bf16_t* VN, bf16_t* dVnT, bf16_t* dST, int ck, int h, int vs, int wave, int r, int q) {
    const size_t ch = (size_t)(ck * 8 + h);
    if (wave < 4) {
        bf16x8 sf[4];
#pragma unroll
        for (int kk = 0; kk < 4; ++kk) sf[kk] = *(const bf16x8*)(ST + r * 136 + kk * 32 + q * 8);
        f32x4 a = (f32x4){0.f, 0.f, 0.f, 0.f};
#pragma unroll
        for (int kk = 0; kk < 4; ++kk) a = mfma16(S.f[kk], sf[kk], a);
        const f32x4 vn = up4(S.u) - a; const u32x2 pv = pk4(vn);
        *(u32x2*)(VN + r * 72 + wave * 16 + 4 * q) = pv;
        *(u32x2*)(dVnT + (ch * 128 + vs * 16 + r) * 64 + wave * 16 + 4 * q) = pv;
    }
    asm volatile("s_waitcnt lgkmcnt(0)" ::: "memory"); __builtin_amdgcn_s_barrier(); asm volatile("" ::: "memory");
    if (wave >= 4) {
        bf16x8 vf[2];
#pragma unroll
        for (int kk = 0; kk < 2; ++kk) vf[kk] = *(const bf16x8*)(VN + r * 72 + kk * 32 + q * 8);
#pragma unroll
        for (int t = 0; t < 2; ++t) { const int kb = (wave - 4) * 2 + t;
            f32x4 a = Sacc[t] * S.gl;
#pragma unroll
            for (int kk = 0; kk < 2; ++kk) a = mfma16(S.f[t * 2 + kk], vf[kk], a);
            Sacc[t] = a; const u32x2 ps = pk4(a);
            *(u32x2*)(ST + r * 136 + kb * 16 + 4 * q) = ps;
            if (ck + 1 < NCH) *(u32x2*)(dST + (((size_t)(ck + 1) * 8 + h) * 128 + vs * 16 + r) * 128 + kb * 16 + 4 * q) = ps; }
    }
    asm volatile("s_waitcnt lgkmcnt(0)" ::: "memory"); __builtin_amdgcn_s_barrier(); asm volatile("" ::: "memory");
}
__device__ void dn_seq(const Ctx& c, int h, int vs) {
    const bf16_t* dW = c.W<bf16_t>(WS_DW); const bf16_t* dUT = c.W<bf16_t>(WS_DUT); const bf16_t* dKdT = c.W<bf16_t>(WS_DKDT); const float* dGl = c.W<float>(WS_DGL);
    bf16_t* dVnT = c.W<bf16_t>(WS_DVNT); bf16_t* dST = c.W<bf16_t>(WS_DST);
    bf16_t* ST = (bf16_t*)c.ldsf; bf16_t* VN = ST + 16 * 136;
    const int wave = c.wave, r = c.r, q = c.q;
    f32x4 Sacc[2]; Sacc[0] = (f32x4){0.f, 0.f, 0.f, 0.f}; Sacc[1] = Sacc[0];
    __syncthreads();
    { u32x2 z; z.x = 0u; z.y = 0u; *(u32x2*)(ST + r * 136 + wave * 16 + 4 * q) = z;
      *(u32x2*)(dST + ((size_t)h * 128 + vs * 16 + r) * 128 + wave * 16 + 4 * q) = z; }
    __syncthreads();
    DnStage s0, s1, s2, s3, s4, s5;
#define DL(S, cc) dn_stage_load(S, dW, dUT, dKdT, dGl, cc, h, vs, wave, r, q)
#define DS(S, cc) dn_step(S, Sacc, ST, VN, dVnT, dST, cc, h, vs, wave, r, q)
    DL(s0, 0); DL(s1, 1); DL(s2, 2); DL(s3, 3); DL(s4, 4);
    for (int ck = 0; ck < 126; ck += 6) {
        DL(s5, ck + 5);  DS(s0, ck);
        DL(s0, ck + 6);  DS(s1, ck + 1);
        DL(s1, ck + 7);  DS(s2, ck + 2);
        DL(s2, ck + 8);  DS(s3, ck + 3);
        DL(s3, ck + 9);  DS(s4, ck + 4);
        DL(s4, ck + 10); DS(s5, ck + 5);
    }
    DS(s0, 126); DS(s1, 127);
#undef DL
#undef DS
}

__device__ void dn_d3(const Ctx& c, int ck, int h, int ib) {
    const bf16_t* proj = c.W<bf16_t>(WS_PROJ);
    const bf16_t* dQg = c.W<bf16_t>(WS_DQG); const bf16_t* dAtt = c.W<bf16_t>(WS_DATT); const bf16_t* dST = c.W<bf16_t>(WS_DST); const bf16_t* dVnT = c.W<bf16_t>(WS_DVNT);
    bf16_t* y = c.W<bf16_t>(WS_YBR);
    const int r = c.r, q = c.q, i = ib * 16 + r, t = ck * 64 + i; const size_t ch = (size_t)(ck * 8 + h);
    bf16x8 bq[4], ba[2];
#pragma unroll
    for (int kk = 0; kk < 4; ++kk) bq[kk] = ldfrag(dQg + (ch * 64 + i) * 128 + kk * 32 + q * 8);
#pragma unroll
    for (int kk = 0; kk < 2; ++kk) ba[kk] = ldfrag(dAtt + (ch * 64 + i) * 64 + kk * 32 + q * 8);
    f32x4 acc[8]; float ss = 0.f;
    bf16x8 fa[2][6];
#pragma unroll
    for (int kk = 0; kk < 4; ++kk) fa[0][kk] = ldfrag(dST + (ch * 128 + r) * 128 + kk * 32 + q * 8);
#pragma unroll
    for (int kk = 0; kk < 2; ++kk) fa[0][4 + kk] = ldfrag(dVnT + (ch * 128 + r) * 64 + kk * 32 + q * 8);
#pragma unroll
    for (int vb = 0; vb < 8; ++vb) { f32x4 a = (f32x4){0.f, 0.f, 0.f, 0.f};
        if (vb + 1 < 8) {
#pragma unroll
            for (int kk = 0; kk < 4; ++kk) fa[(vb + 1) & 1][kk] = ldfrag(dST + (ch * 128 + (vb + 1) * 16 + r) * 128 + kk * 32 + q * 8);
#pragma unroll
            for (int kk = 0; kk < 2; ++kk) fa[(vb + 1) & 1][4 + kk] = ldfrag(dVnT + (ch * 128 + (vb + 1) * 16 + r) * 64 + kk * 32 + q * 8); }
#pragma unroll
        for (int kk = 0; kk < 4; ++kk) a = mfma16(fa[vb & 1][kk], bq[kk], a);
#pragma unroll
        for (int kk = 0; kk < 2; ++kk) a = mfma16(fa[vb & 1][4 + kk], ba[kk], a);
        acc[vb] = a; ss += (a[0] * a[0] + a[1] * a[1]) + (a[2] * a[2] + a[3] * a[3]); }
    ss += __shfl_xor(ss, 16); ss += __shfl_xor(ss, 32);
    const float rn = rsqrtf(ss * (1.0f / 128.0f) + EPS);
    const float* nw = c.in(I_DNNORM) + c.layer * 128;
#pragma unroll
    for (int vb = 0; vb < 8; ++vb) { const int v0 = vb * 16 + 4 * q;
        const f32x4 g = up4(*(const u32x2*)(proj + (size_t)t * NP + C_DNG + h * 128 + v0)); const f32x4 w = *(const f32x4*)(nw + v0); f32x4 o;
#pragma unroll
        for (int j = 0; j < 4; ++j) o[j] = acc[vb][j] * rn * w[j] * siluf_(g[j]);
        *(u32x2*)(y + (size_t)t * 1024 + h * 128 + v0) = pk4(o); }
}
__device__ void ssd_s3(const Ctx& c, int ck, int g) {
    const bf16_t* proj = c.W<bf16_t>(WS_PROJ);
    const bf16_t* sC = c.W<bf16_t>(WS_SC); const bf16_t* sMm = c.W<bf16_t>(WS_SMM); const bf16_t* sSt = c.W<bf16_t>(WS_SST); const bf16_t* sXdT = c.W<bf16_t>(WS_SXDT);
    const bf16_t* sX = c.W<bf16_t>(WS_SX); const float* sAcs = c.W<float>(WS_SACS);
    bf16_t* y = c.W<bf16_t>(WS_YBR) + (size_t)T * 1024;
    const int r = c.r, q = c.q, lb = c.wave & 3, hq = c.wave >> 2, l = lb * 16 + r, t = ck * 64 + l;
    float* ssx = c.ldsf;
    bf16x8 bc[4];
#pragma unroll
    for (int kk = 0; kk < 4; ++kk) bc[kk] = ldfrag(sC + (size_t)t * 256 + g * 128 + kk * 32 + q * 8);
    f32x4 acc[4][4]; float ss = 0.f;
#pragma unroll
    for (int hh = 0; hh < 4; ++hh) { const int h = g * 8 + hq * 4 + hh; const size_t chh = (size_t)(ck * 16 + h);
        const float el = __expf(sAcs[chh * 64 + l]); const float dsk = c.in(I_SD)[c.layer * 16 + h];
        bf16x8 bm[2];
#pragma unroll
        for (int kk = 0; kk < 2; ++kk) bm[kk] = ldfrag(sMm + (chh * 64 + l) * 64 + kk * 32 + q * 8);
#pragma unroll
        for (int p2 = 0; p2 < 4; p2 += 2) {
            bf16x8 fs[2][4], fx[2][2]; u32x2 xr[2], zr[2];
#pragma unroll
            for (int t = 0; t < 2; ++t) { const int pb = p2 + t;
#pragma unroll
                for (int kk = 0; kk < 4; ++kk) fs[t][kk] = ldfrag(sSt + (chh * 64 + pb * 16 + r) * 128 + kk * 32 + q * 8);
#pragma unroll
                for (int kk = 0; kk < 2; ++kk) fx[t][kk] = ldfrag(sXdT + (chh * 64 + pb * 16 + r) * 64 + kk * 32 + q * 8);
                xr[t] = *(const u32x2*)(sX + (size_t)t * 0 + (size_t)(ck * 64 + l) * 1024 + h * 64 + pb * 16 + 4 * q);
                zr[t] = *(const u32x2*)(proj + (size_t)(ck * 64 + l) * NP + C_SZ + h * 64 + pb * 16 + 4 * q); }
            asm volatile("" ::: "memory");
#pragma unroll
            for (int t = 0; t < 2; ++t) { const int pb = p2 + t; f32x4 a = (f32x4){0.f, 0.f, 0.f, 0.f};
#pragma unroll
                for (int kk = 0; kk < 4; ++kk) a = mfma16(fs[t][kk], bc[kk], a);
                a = a * el;
#pragma unroll
                for (int kk = 0; kk < 2; ++kk) a = mfma16(fx[t][kk], bm[kk], a);
                const f32x4 xv = up4(xr[t]), zv = up4(zr[t]);
#pragma unroll
                for (int j = 0; j < 4; ++j) { a[j] = (a[j] + dsk * xv[j]) * siluf_(zv[j]); ss += a[j] * a[j]; }
                acc[hh][pb] = a; } } }
    ss += __shfl_xor(ss, 16); ss += __shfl_xor(ss, 32);
    __syncthreads();
    if (q == 0) ssx[l * 2 + hq] = ss;
    __syncthreads();
    const float rn = rsqrtf((ssx[l * 2] + ssx[l * 2 + 1]) * (1.0f / 512.0f) + EPS);
    const float* nw = c.in(I_SNORM) + c.layer * 1024 + g * 512;
    f32x4 wn[4][4];
#pragma unroll
    for (int hh = 0; hh < 4; ++hh)
#pragma unroll
        for (int pb = 0; pb < 4; ++pb) wn[hh][pb] = *(const f32x4*)(nw + (hq * 4 + hh) * 64 + pb * 16 + 4 * q);
    asm volatile("" ::: "memory");
#pragma unroll
    for (int hh = 0; hh < 4; ++hh)
#pragma unroll
        for (int pb = 0; pb < 4; ++pb) { const int p0 = pb * 16 + 4 * q, hl = hq * 4 + hh;
            const f32x4 o = acc[hh][pb] * rn * wn[hh][pb];
            *(u32x2*)(y + (size_t)t * 1024 + (g * 8 + hl) * 64 + p0) = pk4(o); }
}
__device__ void gla_g3(const Ctx& c, int ck, int h, int ib) {
    const bf16_t* proj = c.W<bf16_t>(WS_PROJ);
    const bf16_t* gQg = c.W<bf16_t>(WS_GQG); const bf16_t* gAtt = c.W<bf16_t>(WS_GATT); const bf16_t* gSt = c.W<bf16_t>(WS_GST); const bf16_t* gVT = c.W<bf16_t>(WS_GVT);
    bf16_t* y = c.W<bf16_t>(WS_YBR) + (size_t)2 * T * 1024;
    const int r = c.r, q = c.q, i = ib * 16 + r, t = ck * 64 + i; const size_t chh = (size_t)(ck * 4 + h);
    bf16x8 bq[4], ba[2];
#pragma unroll
    for (int kk = 0; kk < 4; ++kk) bq[kk] = ldfrag(gQg + (chh * 64 + i) * 128 + kk * 32 + q * 8);
#pragma unroll
    for (int kk = 0; kk < 2; ++kk) ba[kk] = ldfrag(gAtt + (chh * 64 + i) * 64 + kk * 32 + q * 8);
    f32x4 acc[16]; float ss = 0.f;
    bf16x8 fa[2][6];
#pragma unroll
    for (int kk = 0; kk < 4; ++kk) fa[0][kk] = ldfrag(gSt + (chh * 256 + r) * 128 + kk * 32 + q * 8);
#pragma unroll
    for (int kk = 0; kk < 2; ++kk) fa[0][4 + kk] = ldfrag(gVT + (chh * 256 + r) * 64 + kk * 32 + q * 8);
#pragma unroll
    for (int vb = 0; vb < 16; ++vb) { f32x4 a = (f32x4){0.f, 0.f, 0.f, 0.f};
        if (vb + 1 < 16) {
#pragma unroll
            for (int kk = 0; kk < 4; ++kk) fa[(vb + 1) & 1][kk] = ldfrag(gSt + (chh * 256 + (vb + 1) * 16 + r) * 128 + kk * 32 + q * 8);
#pragma unroll
            for (int kk = 0; kk < 2; ++kk) fa[(vb + 1) & 1][4 + kk] = ldfrag(gVT + (chh * 256 + (vb + 1) * 16 + r) * 64 + kk * 32 + q * 8); }
#pragma unroll
        for (int kk = 0; kk < 4; ++kk) a = mfma16(fa[vb & 1][kk], bq[kk], a);
#pragma unroll
        for (int kk = 0; kk < 2; ++kk) a = mfma16(fa[vb & 1][4 + kk], ba[kk], a);
        acc[vb] = a; ss += (a[0] * a[0] + a[1] * a[1]) + (a[2] * a[2] + a[3] * a[3]); }
    ss += __shfl_xor(ss, 16); ss += __shfl_xor(ss, 32);
    const float rn = rsqrtf(ss * (1.0f / 256.0f) + EPS);
    const float* nw = c.in(I_GNORM) + c.layer * 256;
#pragma unroll
    for (int vb = 0; vb < 16; ++vb) { const int v0 = vb * 16 + 4 * q;
        const f32x4 g = up4(*(const u32x2*)(proj + (size_t)t * NP + C_GO + h * 256 + v0)); const f32x4 w = *(const f32x4*)(nw + v0); f32x4 o;
#pragma unroll
        for (int j = 0; j < 4; ++j) o[j] = acc[vb][j] * rn * w[j] * siluf_(g[j]);
        *(u32x2*)(y + (size_t)t * 1024 + h * 256 + v0) = pk4(o); }
}

constexpr int PH_PER_LAYER = 10, N_PHASES = 2 * PH_PER_LAYER + 1;

__device__ __forceinline__ void run_phase(int ph, unsigned char* ldsraw) {
    const __attribute__((address_space(4))) Params* Pk = (const __attribute__((address_space(4))) Params*)__builtin_amdgcn_kernarg_segment_ptr();
    asm volatile("" : "+s"(Pk));
    int bid_ = blockIdx.x, nb_ = gridDim.x, tid_ = threadIdx.x; asm volatile("" : "+s"(bid_), "+s"(nb_), "+v"(tid_));
    Ctx c; c.P = Pk; c.layer = ph == 0 ? 0 : (ph - 1) / PH_PER_LAYER; c.bid = bid_; c.nb = nb_; c.tid = tid_; c.wave = __builtin_amdgcn_readfirstlane(c.tid >> 6); c.lane = c.tid & 63;
    c.r = c.lane & 15; c.q = c.lane >> 4; c.gw = c.bid * 8 + c.wave; c.nw = c.nb * 8; c.ws = Pk->ws; c.ldsf = (float*)ldsraw;
    LAS unsigned char* lds3 = (LAS unsigned char*)ldsraw;
    const int L = c.layer;
    const int lp = ph == 0 ? -1 : (ph - 1) % PH_PER_LAYER;
    float* xio = Pk->out; float* gout = c.W<float>(WS_GOUT); bf16_t* hb = c.W<bf16_t>(WS_HB);
    pg8::RowStats stA{c.W<float>(WS_SLOTA), c.W<unsigned>(WS_CNTA), 0u}, stB{c.W<float>(WS_SLOTB), c.W<unsigned>(WS_CNTB), 0u};
    switch (lp) {
    case -1: {
        row_phase(c.in(I_X), xio, nullptr, nullptr, nullptr, c.in(I_PREMIX), hb, 2, c.gw, c.nw);
        const float* p = c.in(I_P); bf16_t* pb = c.W<bf16_t>(WS_PB); const size_t n4 = (size_t)2 * T * 256 / 4;
        for (size_t i = (size_t)c.bid * 512 + c.tid; i < n4; i += (size_t)c.nb * 512) { const f32x4 v = __builtin_nontemporal_load((const f32x4*)(p + i * 4)); *(u32x2*)(pb + i * 4) = pk4(v); }
        convT(c.in(I_WIN), 2048, INT, c.W<bf16_t>(WS_WIN), NP, c.ldsf, c.bid, c.nb);
    } break;
    case 0: {
        pg8::Gemm g{hb, c.W<bf16_t>(L == 0 ? WS_WIN : WS_WIN1), T, NP, 2048, 0, 0}; pg8::StaticOrder S; S.init(T, NP, c.nb, c.bid);
        pg8::EpiBf16<0> E{c.W<bf16_t>(WS_PROJ), NP};
        pg8::gemm_phase(lds3, g, S, E);
    } break;
    case 1: {
        for (int cb0 = c.bid; cb0 < 256; cb0 += c.nb) { int cb = cb0; asm volatile("" : "+s"(cb));
            { int t2 = c.tid; asm volatile("" : "+v"(t2)); c.tid = t2; c.wave = __builtin_amdgcn_readfirstlane(t2 >> 6); c.lane = t2 & 63; c.r = c.lane & 15; c.q = c.lane >> 4; }
            const int ck = cb >> 1, half = cb & 1;
            prep_dn_chunk(c, ck, half);
            prep_ssd(c, ck, half);
            prep_ssd(c, ck, 2 + half);
            prep_gla(c, ck, 10 + half);
            prep_gla(c, ck, 1 + half);
            __syncthreads();
            dn_d1(c, ck * 4 + half * 2); dn_d1(c, ck * 4 + half * 2 + 1);
            if (c.wave < 4) ssd_mm(c, ck, half, c.wave);
            ssd_s1(c, ck, half * 8 + c.wave);
            gla_attn(c, ck, half * 2 + (c.wave >> 2), c.wave & 3);
            gla_g1(c, ck, half * 2 + (c.wave >> 2), c.wave & 3);
            __syncthreads();
        }
    } break;
    case 2: break;
    case 3: {
        if (c.bid < 64) { dn_seq(c, c.bid & 7, c.bid >> 3);
#if PROBE == 2
            dn_seq(c, c.bid & 7, c.bid >> 3);
#endif
        }
        else { const int nbs = c.nb - 64, b2 = c.bid - 64;
            for (int idx = b2 * 512 + c.tid; idx < 65536; idx += nbs * 512) { if (idx < 32768) scan_ssd(c, idx); else scan_gla(c, idx - 32768); }
            float* tile = c.ldsf;
            for (int b = 0; b < 3; ++b) convT(c.in(I_WBR) + ((size_t)L * 3 + b) * 1024 * 2048, 1024, 2048, c.W<bf16_t>(WS_WBR) + (size_t)b * 2048 * 1024, 2048, tile, b2, nbs);
            convT(c.in(I_WOUT) + (size_t)L * 2048 * 2048, 2048, 2048, c.W<bf16_t>(WS_WOUT), 2048, tile, b2, nbs);
            convT(c.in(I_WUP) + (size_t)L * 2048 * 8192, 2048, 8192, c.W<bf16_t>(WS_WUP), 8192, tile, b2, nbs);
            convT(c.in(I_WDN) + (size_t)L * 8192 * 2048, 8192, 2048, c.W<bf16_t>(WS_WDN), 2048, tile, b2, nbs);
            convT(c.in(I_WPG) + (size_t)L * 2048 * 2048, 2048, 2048, c.W<bf16_t>(WS_WPG), 2048, tile, b2, nbs);
            convT(c.in(I_WPP) + (size_t)L * 256 * 2048, 256, 2048, c.W<bf16_t>(WS_WPP), 2048, tile, b2, nbs);
            if (L == 0) convT(c.in(I_WIN) + (size_t)2048 * INT, 2048, INT, c.W<bf16_t>(WS_WIN1), NP, tile, b2, nbs);
        }
    } break;
    case 4: {
        for (int it = c.bid; it < 256; it += c.nb) ssd_s3(c, it >> 1, it & 1);
        for (int it = c.gw; it < 4096; it += c.nw) dn_d3(c, it >> 5, (it >> 2) & 7, it & 3);
        for (int it = c.gw; it < 2048; it += c.nw) gla_g3(c, it >> 4, (it >> 2) & 3, it & 3);
    } break;
    case 5: {
        pg8::StackOrder<3> S; S.init(T, 2048, c.nb, c.bid);
        pg8::Gemm g{c.W<bf16_t>(WS_YBR), c.W<bf16_t>(WS_WBR), T, 2048, 1024, (size_t)T * 1024 * 2, (size_t)2048 * 1024 * 2};
        pg8::EpiBranch E{gout, c.W<bf16_t>(WS_MIXB), c.W<bf16_t>(WS_PROJ)}; pg8::gemm_phase(lds3, g, S, E);
    } break;
    case 6: {
        pg8::Gemm g{c.W<bf16_t>(WS_MIXB), c.W<bf16_t>(WS_WOUT), T, 2048, 2048, 0, 0}; pg8::StaticOrder S; S.init(T, 2048, c.nb, c.bid);
        stA.want = 64u * (unsigned)(3 * L + 1); stB.want = stA.want;
        pg8::EpiRowFused<0, 1> E{L == 0 ? c.in(I_X) : (const float*)xio, xio, hb, nullptr, c.in(I_POSTMIX) + L * 2048, c.in(I_PREMLP) + L * 2048, stA, stB}; pg8::gemm_phase(lds3, g, S, E);
    } break;
    case 7: {
        pg8::Gemm g{hb, c.W<bf16_t>(WS_WUP), T, DFF, 2048, 0, 0}; pg8::StaticOrder S; S.init(T, DFF, c.nb, c.bid);
        pg8::EpiBf16<1> E{c.W<bf16_t>(WS_PROJ), DFF}; pg8::gemm_phase(lds3, g, S, E);
    } break;
    case 8: {
        { pg8::Gemm g{c.W<bf16_t>(WS_PROJ), c.W<bf16_t>(WS_WDN), T, 2048, DFF, 0, 0}; pg8::StaticOrder S; S.init(T, 2048, c.nb, c.bid);
          stA.want = 64u * (unsigned)(3 * L + 2); stB.want = stA.want;
          pg8::EpiRowFused<0, 1> E{xio, xio, hb, nullptr, c.in(I_POSTMLP) + L * 2048, c.in(I_PLEPRE) + L * 2048, stA, stB}; pg8::gemm_phase(lds3, g, S, E); }
        { pg8::Gemm g{c.W<bf16_t>(WS_PB) + (size_t)L * T * 256, c.W<bf16_t>(WS_WPP), T, 2048, 256, 0, 0}; pg8::StaticOrder S; S.init(T, 2048, c.nb, c.bid);
          pg8::EpiBf16<0> E{c.W<bf16_t>(WS_PP), 2048}; pg8::gemm_phase(lds3, g, S, E); }
    } break;
    case 9: {
        pg8::Gemm g{hb, c.W<bf16_t>(WS_WPG), T, 2048, 2048, 0, 0}; pg8::StaticOrder S; S.init(T, 2048, c.nb, c.bid);
        stA.want = 64u * (unsigned)(3 * L + 3); stB.want = stA.want;
        if (L == 0) { pg8::EpiRowFused<1, 1> E{xio, xio, hb, c.W<bf16_t>(WS_PP), c.in(I_PLEPOST), c.in(I_PREMIX) + 2048, stA, stB}; pg8::gemm_phase(lds3, g, S, E); }
        else { pg8::EpiRowFused<1, 0> E{xio, xio, hb, c.W<bf16_t>(WS_PP), c.in(I_PLEPOST) + 2048, nullptr, stA, stB}; pg8::gemm_phase(lds3, g, S, E); }
    } break;
    }
}

__global__ void __launch_bounds__(512, 2) mega(Params P, int ph_lo, int ph_hi) {
    extern __shared__ __attribute__((aligned(16))) unsigned char lds[];
    cg::grid_group grid = cg::this_grid();
    if (ph_lo < 0) grid.sync();
    volatile LAS unsigned* st = (volatile LAS unsigned*)((LAS unsigned char*)lds + 131072);
    if (threadIdx.x < 4) st[threadIdx.x] = 0u;
    __syncthreads();
    XcdBarrier bar = xcd_barrier_post((unsigned*)(P.ws + WS_BAR), st);
    for (int ph = ph_lo; ph < ph_hi; ++ph) {
        run_phase(ph, lds);
#if PROBE >= 20
        if (ph >= 1 && (ph - 1) % PH_PER_LAYER == PROBE - 20) { xcd_barrier(bar); run_phase(ph, lds); }
#endif
        if (ph + 1 < ph_hi && !(ph >= 1 && (ph - 1) % PH_PER_LAYER == 2)) xcd_barrier(bar);
    }
}

extern "C" void kernel_launch(void* const* d_in, const int* in_sizes, int n_in, void* d_out, int out_size, void* d_ws, size_t ws_size, hipStream_t stream) {
    static int grid = 0;
    constexpr int LDS_BYTES = 131072 + 64;
    if (grid == 0) {
        if (ws_size < WS_TOTAL) { fprintf(stderr, "kernel_launch: workspace too small: %zu < %zu\n", ws_size, (size_t)WS_TOTAL); grid = -1; return; }
        int dev = 0, cus = 0, per_cu = 0;
        hipGetDevice(&dev); hipDeviceGetAttribute(&cus, hipDeviceAttributeMultiprocessorCount, dev);
        if (hipFuncSetAttribute((const void*)mega, hipFuncAttributeMaxDynamicSharedMemorySize, LDS_BYTES) != hipSuccess) { fprintf(stderr, "hipFuncSetAttribute failed\n"); grid = -1; return; }
        hipOccupancyMaxActiveBlocksPerMultiprocessor(&per_cu, (const void*)mega, 512, LDS_BYTES);
        if (per_cu < 1) { fprintf(stderr, "occupancy query says %d blocks per CU\n", per_cu); per_cu = 1; }
        (void)hipGetLastError();
        grid = cus;
    }
    if (grid < 0) return;
    Params P{};
    for (int i = 0; i < 28; ++i) P.in[i] = (const float*)d_in[i];
    P.out = (float*)d_out; P.ws = (unsigned char*)d_ws;
    (void)hipMemsetAsync((unsigned char*)d_ws + WS_BAR, 0, 32768, stream);
#if SINGLE_LAUNCH
    { int lo = 0, hi = N_PHASES; void* args[] = {&P, &lo, &hi};
      hipError_t e = hipLaunchCooperativeKernel((const void*)mega, dim3(grid), dim3(512), args, LDS_BYTES, stream);
      if (e != hipSuccess) fprintf(stderr, "cooperative launch failed: %s\n", hipGetErrorString(e)); }
#else
    for (int ph = 0; ph < N_PHASES; ++ph) { int lo = ph, hi = ph + 1; void* args[] = {&P, &lo, &hi};
        hipError_t e = hipLaunchCooperativeKernel((const void*)mega, dim3(grid), dim3(512), args, LDS_BYTES, stream);
        if (e != hipSuccess) { fprintf(stderr, "cooperative launch failed: %s\n", hipGetErrorString(e)); break; } }
#endif
}
```

```cpp
#include <hip/hip_runtime.h>
#include <hip/hip_cooperative_groups.h>
#include <cstdio>
namespace cg = cooperative_groups;

#ifndef PROBE
#define PROBE 0
#endif
#ifndef SINGLE_LAUNCH
#define SINGLE_LAUNCH 1
#endif

#define LAS __attribute__((address_space(3)))
typedef unsigned short bf16_t;
typedef short bf16x8 __attribute__((ext_vector_type(8)));
typedef float f32x4 __attribute__((ext_vector_type(4)));
typedef unsigned u32x4 __attribute__((ext_vector_type(4)));
typedef unsigned u32x2 __attribute__((ext_vector_type(2)));

constexpr int T = 8192, DM = 2048, NP = 16128, INT = 15920, DFF = 8192, PLE = 256;
constexpr int NCH = 128;
constexpr float EPS = 1e-6f;
constexpr int C_DNQ = 0, C_DNB = 3072, C_DNA = 3080, C_DNG = 3088;
constexpr int C_SZ = 4112, C_SX = 5136, C_SDT = 6672;
constexpr int C_GQ = 6688, C_GK = 7200, C_GV = 7712, C_GLR = 8736, C_GO = 8752, C_BR = 9776;

constexpr size_t al256(size_t x) { return (x + 255) & ~(size_t)255; }
constexpr size_t WS_WIN = 0;
constexpr size_t WS_WBR = WS_WIN + (size_t)NP * 2048 * 2;
constexpr size_t WS_WOUT = WS_WBR + (size_t)3 * 2048 * 1024 * 2;
constexpr size_t WS_WUP = WS_WOUT + (size_t)2048 * 2048 * 2;
constexpr size_t WS_WDN = WS_WUP + (size_t)8192 * 2048 * 2;
constexpr size_t WS_WPG = WS_WDN + (size_t)2048 * 8192 * 2;
constexpr size_t WS_WPP = WS_WPG + (size_t)2048 * 2048 * 2;
constexpr size_t WS_PROJ = WS_WPP + (size_t)2048 * 256 * 2;
constexpr size_t WS_HB = WS_PROJ + (size_t)T * NP * 2;
constexpr size_t WS_PB = WS_HB + (size_t)T * 2048 * 2;
constexpr size_t WS_YBR = WS_PB + (size_t)2 * T * 256 * 2;
constexpr size_t WS_SSP = WS_YBR + (size_t)3 * T * 1024 * 2;
constexpr size_t WS_MIX = WS_SSP + (size_t)T * 32 * 4;
constexpr size_t E16 = (size_t)T * 1024 * 2;
constexpr size_t WS_DQ = WS_MIX, WS_DK = WS_DQ + E16, WS_DV = WS_DK + E16, WS_DW = WS_DV + E16, WS_DUT = WS_DW + E16, WS_DKDT = WS_DUT + E16,
                 WS_DQG = WS_DKDT + E16, WS_DATT = WS_DQG + E16, WS_DVNT = WS_DATT + E16 / 2, WS_DST = WS_DVNT + E16, WS_DGL = WS_DST + 2 * E16;
constexpr size_t WS_SX = WS_DGL + 4096, WS_SXDT = WS_SX + E16, WS_SXW = WS_SXDT + E16, WS_SB = WS_SXW + E16, WS_SC = WS_SB + E16 / 4, WS_SBT = WS_SC + E16 / 4,
                 WS_SMM = WS_SBT + E16 / 4, WS_SST = WS_SMM + E16, WS_SACS = WS_SST + 2 * E16;
constexpr size_t WS_GQG = WS_SACS + (size_t)NCH * 16 * 64 * 4, WS_GKN = WS_GQG + E16 / 2, WS_GKNT = WS_GKN + E16 / 2, WS_GVT = WS_GKNT + E16 / 2, WS_GATT = WS_GVT + E16,
                 WS_GST = WS_GATT + E16 / 4, WS_GDEC = WS_GST + 2 * E16;
constexpr size_t WS_END = WS_GDEC + (size_t)NCH * 512 * 4;
constexpr size_t WS_GOUT = WS_MIX;
constexpr size_t WS_MIXB = WS_GOUT + (size_t)T * 2048 * 4;
constexpr size_t WS_PP = WS_MIXB + (size_t)T * 2048 * 2;
constexpr size_t WS_GOUTB = WS_PP + (size_t)T * 2048 * 2;
static_assert(WS_GOUTB + (size_t)T * 2048 * 2 <= WS_END, "alias region");
constexpr size_t WS_BAR = (WS_END + 255) & ~(size_t)255;
constexpr size_t WS_CNTA = WS_BAR + 16384, WS_CNTB = WS_CNTA + 8192, WS_SLOTA = WS_CNTB + 8192, WS_SLOTB = WS_SLOTA + 262144;
constexpr size_t WS_WIN1 = WS_SLOTB + 262144;
constexpr size_t WS_TOTAL = WS_WIN1 + (size_t)NP * 2048 * 2;

struct Params {
    const float* in[28];
    float* out;
    unsigned char* ws;
};

__device__ __forceinline__ float bf2f(bf16_t b) { return __uint_as_float(((unsigned)b) << 16); }
typedef __bf16 bf16v2_t __attribute__((ext_vector_type(2)));
typedef float f32v2_t __attribute__((ext_vector_type(2)));
__device__ __forceinline__ bf16_t f2bf(float f) { const __bf16 b = (__bf16)f; return __builtin_bit_cast(unsigned short, b); }
__device__ __forceinline__ unsigned pk2(float lo, float hi) { const f32v2_t v = {lo, hi}; const bf16v2_t b = __builtin_convertvector(v, bf16v2_t); return __builtin_bit_cast(unsigned, b); }
__device__ __forceinline__ float lo16(unsigned u) { return __uint_as_float(u << 16); }
__device__ __forceinline__ float hi16(unsigned u) { return __uint_as_float(u & 0xffff0000u); }
__device__ __forceinline__ u32x2 pk4(f32x4 v) { u32x2 r; r.x = pk2(v[0], v[1]); r.y = pk2(v[2], v[3]); return r; }
__device__ __forceinline__ f32x4 up4(u32x2 u) { return (f32x4){lo16(u.x), hi16(u.x), lo16(u.y), hi16(u.y)}; }
__device__ __forceinline__ float sigmoidf_(float x) { return __builtin_amdgcn_rcpf(1.0f + __expf(-x)); }
__device__ __forceinline__ float siluf_(float x) { return x * __builtin_amdgcn_rcpf(1.0f + __expf(-x)); }
__device__ __forceinline__ float softplusf_(float x) { return fmaxf(x, 0.f) + __logf(1.0f + __expf(-fabsf(x))); }
__device__ __forceinline__ f32x4 mfma16(bf16x8 a, bf16x8 b, f32x4 c) { return __builtin_amdgcn_mfma_f32_16x16x32_bf16(a, b, c, 0, 0, 0); }
__device__ __forceinline__ bf16x8 ldfrag(const bf16_t* p) { return *(const bf16x8*)p; }
__device__ __forceinline__ unsigned cvt_pk_bf16(float lo, float hi) { return pk2(lo, hi); }


#define PIN16(a, o) asm volatile("" : "+v"(a[(o)+0]), "+v"(a[(o)+1]), "+v"(a[(o)+2]), "+v"(a[(o)+3]), "+v"(a[(o)+4]), "+v"(a[(o)+5]), "+v"(a[(o)+6]), "+v"(a[(o)+7]), \
    "+v"(a[(o)+8]), "+v"(a[(o)+9]), "+v"(a[(o)+10]), "+v"(a[(o)+11]), "+v"(a[(o)+12]), "+v"(a[(o)+13]), "+v"(a[(o)+14]), "+v"(a[(o)+15]))

#define XB_TMO      128
#define XB_XCNT(j)  (256  + 64 * (j))
#define XB_XSUB(j)  (1280 + 64 * (j))
#define XB_XGEN(j)  (2304 + 64 * (j))
#define XB_TOP      3328
#define XB_TOPGEN   3392
#define XCD_BAR_WORDS 3456
#define XB_SPIN_CAP (1u << 22)
__device__ __forceinline__ unsigned xb_ld(unsigned* p)              { return __hip_atomic_load(p, __ATOMIC_RELAXED, __HIP_MEMORY_SCOPE_AGENT); }
__device__ __forceinline__ unsigned xb_add(unsigned* p, unsigned v) { return __hip_atomic_fetch_add(p, v, __ATOMIC_RELAXED, __HIP_MEMORY_SCOPE_AGENT); }
__device__ __forceinline__ unsigned xb_xcc_id() { return (unsigned)__builtin_amdgcn_s_getreg((3 << 11) | 20) & 0xFu; }
#define XB_SPIN(cond, bar) do { unsigned _sp = 0; while (cond) { __builtin_amdgcn_s_sleep(1); \
    if ((++_sp & 255u) == 0u) { if (xb_ld(&(bar)[XB_TMO])) break; if (_sp > XB_SPIN_CAP) { atomicAdd(&(bar)[XB_TMO], 1u); break; } } } } while (0)
struct XcdBarrier { unsigned* bar; unsigned x; volatile LAS unsigned* st; };
__device__ __forceinline__ XcdBarrier xcd_barrier_post(unsigned* bar, volatile LAS unsigned* st) {
    XcdBarrier b; b.bar = bar; b.x = xb_xcc_id(); b.st = st;
    if (threadIdx.x == 0) (void)xb_add(&bar[XB_XCNT(b.x)], 1u);
    return b;
}
__device__ __forceinline__ void xcd_barrier_complete(unsigned* bar, unsigned x, unsigned& nloc, unsigned& nx) {
    const unsigned G = gridDim.x * gridDim.y * gridDim.z;
    unsigned sum, cnt, mine, sp = 0u;
    for (;;) {
        sum = 0u; cnt = 0u; mine = 0u;
#pragma unroll
        for (unsigned j = 0; j < 16; ++j) { const unsigned c = xb_ld(&bar[XB_XCNT(j)]); sum += c; cnt += (c > 0u) ? 1u : 0u; mine = (j == x) ? c : mine; }
        if (sum == G) break;
        __builtin_amdgcn_s_sleep(1);
        if ((++sp & 255u) == 0u) { if (xb_ld(&bar[XB_TMO])) break; if (sp > XB_SPIN_CAP) { atomicAdd(&bar[XB_TMO], 1u); break; } }
    }
    nloc = mine > 0u ? mine : 1u; nx = cnt > 0u ? cnt : 1u;
}
__device__ __forceinline__ void xcd_barrier(const XcdBarrier& b) {
    asm volatile("s_waitcnt vmcnt(0)" ::: "memory");
    __syncthreads();
    if (threadIdx.x == 0) {
        unsigned* bar = b.bar;
        __builtin_amdgcn_s_waitcnt(0);
        unsigned nloc = b.st[0], nx = b.st[1];
        if (nloc == 0u) { xcd_barrier_complete(bar, b.x, nloc, nx); b.st[0] = nloc; b.st[1] = nx; }
        const unsigned old = xb_add(&bar[XB_XSUB(b.x)], 1u);
        const unsigned gen = old / nloc;
        if (old + 1u == (gen + 1u) * nloc) {
            __builtin_amdgcn_fence(__ATOMIC_RELEASE, "agent");
            asm volatile("s_waitcnt vmcnt(0)" ::: "memory");
            const unsigned og = xb_add(&bar[XB_TOP], 1u);
            const unsigned tg = og / nx;
            if (og + 1u == (tg + 1u) * nx) xb_add(&bar[XB_TOPGEN], 1u);
            else XB_SPIN(xb_ld(&bar[XB_TOPGEN]) == tg, bar);
            __builtin_amdgcn_fence(__ATOMIC_ACQUIRE, "agent");
            xb_add(&bar[XB_XGEN(b.x)], 1u);
            asm volatile("s_waitcnt vmcnt(0)" ::: "memory");
        } else {
            XB_SPIN(xb_ld(&bar[XB_XGEN(b.x)]) == gen, bar);
            __builtin_amdgcn_fence(__ATOMIC_ACQUIRE, "agent");
            asm volatile("s_waitcnt vmcnt(0)" ::: "memory");
        }
    }
    __syncthreads();
}

namespace pg8 {
constexpr int BM = 256, BK = 64, HALF = 128, HTB = HALF * BK * 2, STAGE_BYTES = 8 * HTB, NXCD = 8, WGM = 8;
__device__ __forceinline__ int lds_byte(int r, int c) { const int st = (r >> 4) * 2 + (c >> 5), rr = r & 15, cc = c & 31, ob = rr * 64 + cc * 2; return st * 1024 + (ob ^ (((ob >> 9) & 1) << 5)); }
__device__ __forceinline__ void stage_rc(int b, int& R, int& C) { const int st = b / 1024, sb = b % 1024, swz = sb ^ (((sb >> 9) & 1) << 5); R = (st >> 1) * 16 + swz / 64; C = (st & 1) * 32 + (swz % 64) / 2; }
__device__ __forceinline__ int perm32(int rho) { const int n = rho >> 4, i = rho & 15; return 8 * (i >> 2) + 4 * n + (i & 3); }
struct Unit { int pm, pn, z; };
struct Gemm { const bf16_t* A; const bf16_t* Bt; int M, N, K; size_t zA, zB; };
struct StaticOrder {
    int nM, nN, nwg, G, c;
    __device__ void init(int M, int N, int G_, int c_) { nM = M / BM; nN = N / BM; nwg = nM * nN; G = G_; c = c_; }
    __device__ bool next(int i, Unit& u) const {
        const long L = (long)i * G + c; if (L >= nwg) return false;
        int wgid = (int)L; { const int q = nwg / NXCD, r = nwg % NXCD, xcd = wgid % NXCD, off = wgid / NXCD; wgid = (xcd < r ? xcd * (q + 1) : r * (q + 1) + (xcd - r) * q) + off; }
        const int nig = WGM * nN, gid = wgid / nig, fm = gid * WGM, gsz = (nM - fm) < WGM ? (nM - fm) : WGM;
        u.pm = fm + ((wgid % nig) % gsz); u.pn = (wgid % nig) / gsz; u.z = 0; return true;
    }
};
template <int NZ> struct StackOrder : StaticOrder {
    __device__ bool next(int i, Unit& u) const { if (i >= NZ) return false; const bool ok = StaticOrder::next(0, u); u.z = i; return ok; }
};
template <int ACT  > struct EpiBf16 {
    static constexpr bool PERM = true, AFTER_DRAIN = false;
    bf16_t* O; int ldc;
    __device__ __forceinline__ void operator()(const f32x4 (&acc)[2][2][4][2], const Unit& u, int wr, int wc, int fr, int fq) const {
        const int row0 = u.pm * BM + wr * 64 + fr, col0 = u.pn * BM + wc * 32 + 8 * fq;
#pragma unroll
        for (int ai = 0; ai < 2; ++ai)
#pragma unroll
            for (int m = 0; m < 4; ++m) { bf16_t* rowp = O + (size_t)(row0 + ai * HALF + m * 16) * ldc + col0;
#pragma unroll
                for (int bj = 0; bj < 2; ++bj) { f32x4 v0 = acc[ai][bj][m][0], v1 = acc[ai][bj][m][1];
                    if (ACT == 1) {
#pragma unroll
                        for (int j = 0; j < 4; ++j) { float a = fmaxf(v0[j], 0.f), b = fmaxf(v1[j], 0.f); v0[j] = a * a; v1[j] = b * b; } }
                    u32x4 w; w.x = cvt_pk_bf16(v0[0], v0[1]); w.y = cvt_pk_bf16(v0[2], v0[3]); w.z = cvt_pk_bf16(v1[0], v1[1]); w.w = cvt_pk_bf16(v1[2], v1[3]);
                    *(u32x4*)(rowp + bj * HALF) = w; } }
    }
};
struct EpiBranch {
    static constexpr bool PERM = true, AFTER_DRAIN = false;
    float* mix; bf16_t* mixb; const bf16_t* proj;
    template <int Z> __device__ __forceinline__ void run(const f32x4 (&acc)[2][2][4][2], const Unit& u, int wr, int wc, int fr, int fq) const {
        const int row0 = u.pm * BM + wr * 64 + fr, col0 = u.pn * BM + wc * 32 + 8 * fq;
#pragma unroll
        for (int ai = 0; ai < 2; ++ai)
#pragma unroll
            for (int m2 = 0; m2 < 4; m2 += 2) {
                u32x4 graw[2][2]; f32x4 old0[2][2], old1[2][2];
#pragma unroll
                for (int mm = 0; mm < 2; ++mm)
#pragma unroll
                    for (int bj = 0; bj < 2; ++bj) { const int row = row0 + ai * HALF + (m2 + mm) * 16, col = col0 + bj * HALF;
                        graw[mm][bj] = *(const u32x4*)(proj + (size_t)row * NP + C_BR + Z * 2048 + col);
                        if (Z > 0) { const float* mp = mix + (size_t)row * 2048 + col; old0[mm][bj] = *(const f32x4*)mp; old1[mm][bj] = *(const f32x4*)(mp + 4); } }
#pragma unroll
                for (int mm = 0; mm < 2; ++mm)
#pragma unroll
                    for (int bj = 0; bj < 2; ++bj) { const int row = row0 + ai * HALF + (m2 + mm) * 16, col = col0 + bj * HALF;
                        const u32x4 g = graw[mm][bj];
                        f32x4 v0 = acc[ai][bj][m2 + mm][0], v1 = acc[ai][bj][m2 + mm][1];
                        v0[0] *= sigmoidf_(lo16(g.x)); v0[1] *= sigmoidf_(hi16(g.x)); v0[2] *= sigmoidf_(lo16(g.y)); v0[3] *= sigmoidf_(hi16(g.y));
                        v1[0] *= sigmoidf_(lo16(g.z)); v1[1] *= sigmoidf_(hi16(g.z)); v1[2] *= sigmoidf_(lo16(g.w)); v1[3] *= sigmoidf_(hi16(g.w));
                        if (Z > 0) { v0 += old0[mm][bj]; v1 += old1[mm][bj]; }
                        if (Z < 2) { float* mp = mix + (size_t)row * 2048 + col; *(f32x4*)mp = v0; *(f32x4*)(mp + 4) = v1; }
                        else { u32x4 w; w.x = cvt_pk_bf16(v0[0], v0[1]); w.y = cvt_pk_bf16(v0[2], v0[3]); w.z = cvt_pk_bf16(v1[0], v1[1]); w.w = cvt_pk_bf16(v1[2], v1[3]);
                            *(u32x4*)(mixb + (size_t)row * 2048 + col) = w; } }
                asm volatile("" ::: "memory"); }
    }
    __device__ __forceinline__ void operator()(const f32x4 (&acc)[2][2][4][2], const Unit& u, int wr, int wc, int fr, int fq) const {
        if (u.z == 0) run<0>(acc, u, wr, wc, fr, fq); else if (u.z == 1) run<1>(acc, u, wr, wc, fr, fq); else run<2>(acc, u, wr, wc, fr, fq);
    }
};
template <int PLEMODE> struct EpiF32SS {
    static constexpr bool PERM = false, AFTER_DRAIN = false;
    bf16_t* C; float* ssp; const bf16_t* pp;
    __device__ __forceinline__ void operator()(const f32x4 (&acc)[2][2][4][2], const Unit& u, int wr, int wc, int fr, int fq) const {
        const int row0 = u.pm * BM + wr * 64 + fr, col0 = u.pn * BM + wc * 32 + 4 * fq;
#pragma unroll
        for (int ai = 0; ai < 2; ++ai)
#pragma unroll
            for (int m = 0; m < 4; ++m) { const int row = row0 + ai * HALF + m * 16; float s = 0.f;
#pragma unroll
                for (int bj = 0; bj < 2; ++bj)
#pragma unroll
                    for (int n = 0; n < 2; ++n) { const int col = col0 + bj * HALF + n * 16; f32x4 v = acc[ai][bj][m][n];
                        if (PLEMODE) { const f32x4 pv = up4(*(const u32x2*)(pp + (size_t)row * 2048 + col));
#pragma unroll
                            for (int j = 0; j < 4; ++j) v[j] = sigmoidf_(v[j]) * pv[j]; }
                        s += (v[0] * v[0] + v[1] * v[1]) + (v[2] * v[2] + v[3] * v[3]);
                        { u32x2 w; w.x = cvt_pk_bf16(v[0], v[1]); w.y = cvt_pk_bf16(v[2], v[3]); *(u32x2*)(C + (size_t)row * 2048 + col) = w; } }
                s += __shfl_xor(s, 16); s += __shfl_xor(s, 32);
                if (fq == 0) ssp[(size_t)row * 32 + u.pn * 4 + wc] = s; }
    }
};

struct RowStats {
    float* xbuf;
    unsigned* cnt;
    unsigned want;
    __device__ __forceinline__ void run(const f32x4 (&v)[2][2][4][2], const Unit& u, int wr, int wc, int fr, int fq, LAS unsigned char* lds, int wid, int lane) const {
        LAS float* Pt = (LAS float*)lds;
        LAS float* S = (LAS float*)(lds + 8192);
#pragma unroll
        for (int ai = 0; ai < 2; ++ai)
#pragma unroll
            for (int m = 0; m < 4; ++m) { float sq = 0.f;
#pragma unroll
                for (int bj = 0; bj < 2; ++bj)
#pragma unroll
                    for (int n = 0; n < 2; ++n) { const f32x4 x = v[ai][bj][m][n]; sq += (x[0] * x[0] + x[1] * x[1]) + (x[2] * x[2] + x[3] * x[3]); }
                sq += __shfl_xor(sq, 16); sq += __shfl_xor(sq, 32);
                if (fq == 0) Pt[(ai * HALF + wr * 64 + m * 16 + fr) * 4 + wc] = sq; }
        asm volatile("s_waitcnt lgkmcnt(0)" ::: "memory"); __builtin_amdgcn_s_barrier(); asm volatile("" ::: "memory");
        const int row = wid * 32 + (lane & 31);
        if (lane < 32) { const float a = (Pt[row * 4 + 0] + Pt[row * 4 + 1]) + (Pt[row * 4 + 2] + Pt[row * 4 + 3]);
            __hip_atomic_store(xbuf + ((size_t)(u.pm * BM + row) * 8 + u.pn), a, __ATOMIC_RELAXED, __HIP_MEMORY_SCOPE_AGENT); }
        asm volatile("s_waitcnt vmcnt(0)" ::: "memory");
        if (lane == 0) __hip_atomic_fetch_add(cnt + 64 * u.pm, 1u, __ATOMIC_RELAXED, __HIP_MEMORY_SCOPE_AGENT);
        if (wid == 0) { unsigned sp = 0;
            while ((unsigned)__builtin_amdgcn_readfirstlane(__hip_atomic_load(cnt + 64 * u.pm, __ATOMIC_RELAXED, __HIP_MEMORY_SCOPE_AGENT)) < want) { __builtin_amdgcn_s_sleep(2); if (++sp > (1u << 24)) break; }
            __builtin_amdgcn_fence(__ATOMIC_ACQUIRE, "agent"); }
        asm volatile("s_waitcnt vmcnt(0) lgkmcnt(0)" ::: "memory"); __builtin_amdgcn_s_barrier(); asm volatile("" ::: "memory");
        if (lane < 32) { const float* slot = xbuf + (size_t)(u.pm * BM + row) * 8; float sum = 0.f;
#pragma unroll
            for (int t = 0; t < 8; ++t) sum += __hip_atomic_load(slot + t, __ATOMIC_RELAXED, __HIP_MEMORY_SCOPE_AGENT);
            S[row] = rsqrtf(sum * (1.0f / 2048.0f) + EPS); }
        asm volatile("s_waitcnt lgkmcnt(0)" ::: "memory"); __builtin_amdgcn_s_barrier(); asm volatile("" ::: "memory");
    }
};
template <int PLEMODE, int HASNEXT> struct EpiRowFused {
    static constexpr bool PERM = false, AFTER_DRAIN = true;
    const float* xsrc; float* x; bf16_t* hb; const bf16_t* pp; const float* gpost; const float* gnext; RowStats st1, st2;
    __device__ __forceinline__ void fused(f32x4 (&acc)[2][2][4][2], const Unit& u, int wr, int wc, int fr, int fq, LAS unsigned char* lds, int wid, int lane) const {
        const LAS float* S = (const LAS float*)(lds + 8192);
        const int col0 = u.pn * BM + wc * 32 + 4 * fq;
        if (PLEMODE) {
#pragma unroll
            for (int ai = 0; ai < 2; ++ai)
#pragma unroll
                for (int m2 = 0; m2 < 4; m2 += 2) { u32x2 praw[2][2][2];
#pragma unroll
                    for (int mm = 0; mm < 2; ++mm)
#pragma unroll
                        for (int bj = 0; bj < 2; ++bj)
#pragma unroll
                            for (int n = 0; n < 2; ++n) { const int r = ai * HALF + wr * 64 + (m2 + mm) * 16 + fr; praw[mm][bj][n] = *(const u32x2*)(pp + (size_t)(u.pm * BM + r) * 2048 + col0 + bj * HALF + n * 16); }
#pragma unroll
                    for (int mm = 0; mm < 2; ++mm)
#pragma unroll
                        for (int bj = 0; bj < 2; ++bj)
#pragma unroll
                            for (int n = 0; n < 2; ++n) { const f32x4 pv = up4(praw[mm][bj][n]);
#pragma unroll
                                for (int j = 0; j < 4; ++j) acc[ai][bj][m2 + mm][n][j] = sigmoidf_(acc[ai][bj][m2 + mm][n][j]) * pv[j]; }
                    asm volatile("" ::: "memory"); }
        }
        st1.run(acc, u, wr, wc, fr, fq, lds, wid, lane);
        {
            f32x4 wv[2][2];
#pragma unroll
            for (int bj = 0; bj < 2; ++bj)
#pragma unroll
                for (int n = 0; n < 2; ++n) wv[bj][n] = *(const f32x4*)(gpost + col0 + bj * HALF + n * 16);
#pragma unroll
            for (int ai = 0; ai < 2; ++ai)
#pragma unroll
                for (int m = 0; m < 4; ++m) { f32x4 xs[2][2];
                    const int r = ai * HALF + wr * 64 + m * 16 + fr; const size_t off = (size_t)(u.pm * BM + r) * 2048 + col0;
#pragma unroll
                    for (int bj = 0; bj < 2; ++bj)
#pragma unroll
                        for (int n = 0; n < 2; ++n) xs[bj][n] = *(const f32x4*)(xsrc + off + bj * HALF + n * 16);
                    const float rn = S[r];
#pragma unroll
                    for (int bj = 0; bj < 2; ++bj)
#pragma unroll
                        for (int n = 0; n < 2; ++n) { const f32x4 o = xs[bj][n] + acc[ai][bj][m][n] * rn * wv[bj][n]; acc[ai][bj][m][n] = o; *(f32x4*)(x + off + bj * HALF + n * 16) = o; }
                    asm volatile("" ::: "memory"); }
        }
        if (HASNEXT) {
            st2.run(acc, u, wr, wc, fr, fq, lds, wid, lane);
            f32x4 wv[2][2];
#pragma unroll
            for (int bj = 0; bj < 2; ++bj)
#pragma unroll
                for (int n = 0; n < 2; ++n) wv[bj][n] = *(const f32x4*)(gnext + col0 + bj * HALF + n * 16);
#pragma unroll
            for (int ai = 0; ai < 2; ++ai)
#pragma unroll
                for (int m = 0; m < 4; ++m) { const int r = ai * HALF + wr * 64 + m * 16 + fr; const float r2 = S[r]; const size_t off = (size_t)(u.pm * BM + r) * 2048 + col0;
#pragma unroll
                    for (int bj = 0; bj < 2; ++bj)
#pragma unroll
                        for (int n = 0; n < 2; ++n) { const f32x4 o = acc[ai][bj][m][n] * r2 * wv[bj][n];
                            u32x2 pw; pw.x = cvt_pk_bf16(o[0], o[1]); pw.y = cvt_pk_bf16(o[2], o[3]); *(u32x2*)(hb + off + bj * HALF + n * 16) = pw; } }
        }
        asm volatile("s_waitcnt lgkmcnt(0)" ::: "memory"); __builtin_amdgcn_s_barrier(); asm volatile("" ::: "memory");
    }
};

template <class Epi, class Sched>
__device__ __forceinline__ void gemm_phase(LAS unsigned char* lds, const Gemm g, const Sched& S, const Epi& E) {
    int tid_l = threadIdx.x; asm volatile("" : "+v"(tid_l));
    const int tid = tid_l, wid = __builtin_amdgcn_readfirstlane(tid >> 6), lane = tid & 63, wr = wid >> 2, wc = wid & 3, fr = lane & 15, fq = lane >> 4;
    const int K = g.K, nt = K / BK;
    unsigned voffA[2], voffB[2];
#pragma unroll
    for (int i = 0; i < 2; ++i) { int R, C; stage_rc(tid * 16 + i * 8192, R, C); const int Rb = Epi::PERM ? ((R & ~31) + perm32(R & 31)) : R;
        voffA[i] = (unsigned)(R * K + C) * 2u; voffB[i] = (unsigned)(Rb * K + C) * 2u; }
    const size_t kstep = (size_t)(BK * 2);
    const size_t hstep = (size_t)HALF * K * 2;
    const size_t tstep = 2 * hstep;
    const unsigned ldsw = (unsigned)wid * 1024u;
    const int aoff = lds_byte(wr * 64 + fr, fq * 8), boff = lds_byte(wc * 32 + fr, fq * 8);
#define PG8_SA(b, h) (((b) * 2 + (h)) * HTB)
#define PG8_SB(b, h) ((4 + (b) * 2 + (h)) * HTB)
#define PG8_STAGE(bufoff, gbase, voff) do { _Pragma("unroll") for (int _i = 0; _i < 2; ++_i) \
        __builtin_amdgcn_global_load_lds((const unsigned*)((const char*)(gbase) + (voff)[_i]), (LAS unsigned*)(lds + (bufoff) + ldsw + _i * 8192), 16, 0, 0); } while (0)
#define PG8_LDA(dst, b, h) do { _Pragma("unroll") for (int m = 0; m < 4; ++m) _Pragma("unroll") for (int k = 0; k < 2; ++k) dst[m][k] = *(const LAS bf16x8*)(lds + PG8_SA(b, h) + aoff + m * 2048 + k * 1024); } while (0)
#define PG8_LDB(dst, b, h) do { _Pragma("unroll") for (int n = 0; n < 2; ++n) _Pragma("unroll") for (int k = 0; k < 2; ++k) dst[n][k] = *(const LAS bf16x8*)(lds + PG8_SB(b, h) + boff + n * 2048 + k * 1024); } while (0)
#define PG8_MMA(ai, bj, At, Bt) do { __builtin_amdgcn_s_setprio(1); _Pragma("unroll") for (int m = 0; m < 4; ++m) _Pragma("unroll") for (int n = 0; n < 2; ++n) _Pragma("unroll") for (int k = 0; k < 2; ++k) \
        acc[ai][bj][m][n] = __builtin_amdgcn_mfma_f32_16x16x32_bf16(Bt[n][k], At[m][k], acc[ai][bj][m][n], 0, 0, 0); __builtin_amdgcn_s_setprio(0); } while (0)
#define PG8_WAIT_V(n) asm volatile("s_waitcnt vmcnt(" #n ")" ::: "memory")
#define PG8_WAIT_L(n) asm volatile("s_waitcnt lgkmcnt(" #n ")" ::: "memory")
#define PG8_BAR __builtin_amdgcn_s_barrier()
#define PG8_SCHED __builtin_amdgcn_sched_barrier(0)
    Unit cur, nxt; int ui = 0;
    if (!S.next(0, cur)) return;
    f32x4 acc[2][2][4][2];
#pragma unroll
    for (int a = 0; a < 2; ++a)
#pragma unroll
        for (int b = 0; b < 2; ++b)
#pragma unroll
            for (int m = 0; m < 4; ++m)
#pragma unroll
                for (int n = 0; n < 2; ++n) acc[a][b][m][n] = (f32x4){0.f, 0.f, 0.f, 0.f};
    bf16x8 At[4][2], B0[2][2], B1[2][2];
    const char* cA = (const char*)g.A + (size_t)cur.z * g.zA + (size_t)cur.pm * tstep; const char* cB = (const char*)g.Bt + (size_t)cur.z * g.zB + (size_t)cur.pn * tstep;
    PG8_STAGE(PG8_SB(0, 0), cB, voffB); PG8_STAGE(PG8_SA(0, 0), cA, voffA); PG8_STAGE(PG8_SB(0, 1), cB + hstep, voffB); PG8_STAGE(PG8_SA(0, 1), cA + hstep, voffA);
    if (wr == 1) PG8_BAR;
    PG8_WAIT_V(4); PG8_BAR;
    PG8_STAGE(PG8_SB(1, 0), cB + kstep, voffB); PG8_STAGE(PG8_SA(1, 0), cA + kstep, voffA); PG8_STAGE(PG8_SB(1, 1), cB + hstep + kstep, voffB);
    PG8_WAIT_V(6); PG8_BAR;
    for (;;) {
        const bool has_next = S.next(ui + 1, nxt);
        const char* nA = has_next ? (const char*)g.A + (size_t)nxt.z * g.zA + (size_t)nxt.pm * tstep : cA; const char* nB = has_next ? (const char*)g.Bt + (size_t)nxt.z * g.zB + (size_t)nxt.pn * tstep : cB;
        for (int t = 0; t < nt; t += 2) {
            const bool last = (t == nt - 2);
            const char* a1 = cA + (size_t)(t + 1) * kstep;
            const char* a2 = last ? nA : cA + (size_t)(t + 2) * kstep; const char* b2 = last ? nB : cB + (size_t)(t + 2) * kstep;
            const char* a3 = a2 + kstep; const char* b3 = b2 + kstep;
            PG8_LDB(B0, 0, 0); PG8_SCHED; PG8_LDA(At, 0, 0); PG8_STAGE(PG8_SA(1, 1), a1 + hstep, voffA);
            PG8_WAIT_L(8); PG8_BAR; PG8_WAIT_L(0); PG8_MMA(0, 0, At, B0); PG8_BAR; PG8_SCHED;
            PG8_LDB(B1, 0, 1); PG8_STAGE(PG8_SB(0, 0), b2, voffB);
            PG8_BAR; PG8_WAIT_L(0); PG8_MMA(0, 1, At, B1); PG8_BAR;
            PG8_LDA(At, 0, 1); PG8_STAGE(PG8_SA(0, 0), a2, voffA);
            PG8_BAR; PG8_WAIT_L(0); PG8_MMA(1, 0, At, B0); PG8_BAR; PG8_SCHED;
            PG8_STAGE(PG8_SB(0, 1), b2 + hstep, voffB);
            PG8_WAIT_V(6); PG8_BAR; PG8_MMA(1, 1, At, B1); PG8_BAR;
            PG8_LDB(B0, 1, 0); PG8_SCHED; PG8_LDA(At, 1, 0); PG8_STAGE(PG8_SA(0, 1), a2 + hstep, voffA);
            PG8_WAIT_L(8); PG8_BAR; PG8_WAIT_L(0); PG8_MMA(0, 0, At, B0); PG8_BAR; PG8_SCHED;
            PG8_LDB(B1, 1, 1); PG8_STAGE(PG8_SB(1, 0), b3, voffB);
            PG8_BAR; PG8_WAIT_L(0); PG8_MMA(0, 1, At, B1); PG8_BAR;
            PG8_LDA(At, 1, 1); PG8_STAGE(PG8_SA(1, 0), a3, voffA);
            PG8_BAR; PG8_WAIT_L(0); PG8_MMA(1, 0, At, B0); PG8_BAR; PG8_SCHED;
            PG8_STAGE(PG8_SB(1, 1), b3 + hstep, voffB);
            PG8_WAIT_V(6); PG8_BAR; PG8_MMA(1, 1, At, B1); PG8_BAR;
        }
        if constexpr (!Epi::AFTER_DRAIN) E(acc, cur, wr, wc, fr, fq);
        if (!has_next) break;
#pragma unroll
        for (int a = 0; a < 2; ++a)
#pragma unroll
            for (int b = 0; b < 2; ++b)
#pragma unroll
                for (int m = 0; m < 4; ++m)
#pragma unroll
                    for (int n = 0; n < 2; ++n) acc[a][b][m][n] = (f32x4){0.f, 0.f, 0.f, 0.f};
        cur = nxt; cA = nA; cB = nB; ++ui;
    }
    PG8_WAIT_V(0);
    if (wr == 0) PG8_BAR;
    PG8_BAR;
    if constexpr (Epi::AFTER_DRAIN) E.fused(acc, cur, wr, wc, fr, fq, lds, wid, lane);
#undef PG8_SA
#undef PG8_SB
#undef PG8_STAGE
#undef PG8_LDA
#undef PG8_LDB
#undef PG8_MMA
#undef PG8_WAIT_V
#undef PG8_WAIT_L
#undef PG8_BAR
#undef PG8_SCHED
}
}

__device__ void convT(const float* __restrict__ W, int K, int N, bf16_t* __restrict__ Wt, int Npad, float* tile, int bid, int nb) {
    int tid_l = threadIdx.x; asm volatile("" : "+v"(tid_l));
    const int tk = K / 64, tn = Npad / 64, ntiles = tk * tn, tid = tid_l;
    const int r0 = tid >> 4, c4 = (tid & 15) * 4;
    f32x4 cur0 = (f32x4){0.f, 0.f, 0.f, 0.f}, cur1 = cur0, nx0 = cur0, nx1 = cur0;
    int t = bid;
    if (t < ntiles) { const int k0 = (t % tk) * 64, n = (t / tk) * 64 + c4;
        if (n < N) { cur0 = __builtin_nontemporal_load((const f32x4*)(W + (size_t)(k0 + r0) * N + n)); cur1 = __builtin_nontemporal_load((const f32x4*)(W + (size_t)(k0 + r0 + 32) * N + n)); } }
    for (; t < ntiles; t += nb) {
        const int k0 = (t % tk) * 64, n0 = (t / tk) * 64;
        tile[r0 * 65 + c4 + 0] = cur0[0]; tile[r0 * 65 + c4 + 1] = cur0[1]; tile[r0 * 65 + c4 + 2] = cur0[2]; tile[r0 * 65 + c4 + 3] = cur0[3];
        tile[(r0 + 32) * 65 + c4 + 0] = cur1[0]; tile[(r0 + 32) * 65 + c4 + 1] = cur1[1]; tile[(r0 + 32) * 65 + c4 + 2] = cur1[2]; tile[(r0 + 32) * 65 + c4 + 3] = cur1[3];
        asm volatile("s_waitcnt lgkmcnt(0)" ::: "memory"); __builtin_amdgcn_s_barrier(); asm volatile("" ::: "memory");
        { const int t2 = t + nb; nx0 = (f32x4){0.f, 0.f, 0.f, 0.f}; nx1 = nx0;
          if (t2 < ntiles) { const int k2 = (t2 % tk) * 64, n2 = (t2 / tk) * 64 + c4;
              if (n2 < N) { nx0 = __builtin_nontemporal_load((const f32x4*)(W + (size_t)(k2 + r0) * N + n2)); nx1 = __builtin_nontemporal_load((const f32x4*)(W + (size_t)(k2 + r0 + 32) * N + n2)); } } }
        { const int n = tid >> 3, kg = (tid & 7) * 8; u32x4 w;
          w.x = pk2(tile[(kg + 0) * 65 + n], tile[(kg + 1) * 65 + n]); w.y = pk2(tile[(kg + 2) * 65 + n], tile[(kg + 3) * 65 + n]);
          w.z = pk2(tile[(kg + 4) * 65 + n], tile[(kg + 5) * 65 + n]); w.w = pk2(tile[(kg + 6) * 65 + n], tile[(kg + 7) * 65 + n]);
          __builtin_nontemporal_store(w, (u32x4*)(Wt + (size_t)(n0 + n) * K + k0 + kg)); }
        asm volatile("s_waitcnt lgkmcnt(0)" ::: "memory"); __builtin_amdgcn_s_barrier(); asm volatile("" ::: "memory");
        cur0 = nx0; cur1 = nx1;
    }
    __syncthreads();
}

__device__ void row_phase(const float* __restrict__ xin, float* __restrict__ xio, const bf16_t* __restrict__ gout, const float* __restrict__ ssp,
                          const float* __restrict__ gpost, const float* __restrict__ gnext, bf16_t* __restrict__ hb, int mode, int gw, int nw) {
    int tid_l = threadIdx.x; asm volatile("" : "+v"(tid_l));
    const int lane = tid_l & 63;
    for (int row = gw; row < T; row += nw) {
        f32x4 xv[8];
        const size_t rb = (size_t)row * 2048;
        if (mode == 0 || mode == 2) {
#pragma unroll
            for (int i = 0; i < 8; ++i) xv[i] = *(const f32x4*)(xin + rb + (i * 64 + lane) * 4);
        } else {
            float ss = ssp[(size_t)row * 32 + (lane & 31)];
            ss += __shfl_xor(ss, 1); ss += __shfl_xor(ss, 2); ss += __shfl_xor(ss, 4); ss += __shfl_xor(ss, 8); ss += __shfl_xor(ss, 16);
            const float rn = rsqrtf(ss * (1.0f / 2048.0f) + EPS);
#pragma unroll
            for (int i = 0; i < 8; ++i) { const int col = (i * 64 + lane) * 4;
                const f32x4 g = up4(*(const u32x2*)(gout + rb + col)), w = *(const f32x4*)(gpost + col), x0 = *(const f32x4*)(xio + rb + col);
                xv[i] = x0 + g * rn * w; }
        }
        if (mode != 2) {
#pragma unroll
            for (int i = 0; i < 8; ++i) *(f32x4*)(xio + rb + (i * 64 + lane) * 4) = xv[i]; }
        if (gnext) {
            float s2 = 0.f;
#pragma unroll
            for (int i = 0; i < 8; ++i) s2 += (xv[i][0] * xv[i][0] + xv[i][1] * xv[i][1]) + (xv[i][2] * xv[i][2] + xv[i][3] * xv[i][3]);
            s2 += __shfl_xor(s2, 1); s2 += __shfl_xor(s2, 2); s2 += __shfl_xor(s2, 4); s2 += __shfl_xor(s2, 8); s2 += __shfl_xor(s2, 16); s2 += __shfl_xor(s2, 32);
            const float r2 = rsqrtf(s2 * (1.0f / 2048.0f) + EPS);
#pragma unroll
            for (int i = 0; i < 8; ++i) { const int col = (i * 64 + lane) * 4; const f32x4 w = *(const f32x4*)(gnext + col); const f32x4 o = xv[i] * r2 * w;
                *(u32x2*)(hb + rb + col) = pk4(o); }
        }
    }
}

struct Ctx {
    const __attribute__((address_space(4))) Params* P; int layer, bid, nb, tid, wave, lane, r, q, gw, nw;
    unsigned char* ws;
    float* ldsf;
    template <class Tp> __device__ __forceinline__ Tp* W(size_t off) const { return (Tp*)(ws + off); }
    __device__ __forceinline__ const float* in(int i) const { return P->in[i]; }
};
enum { I_X = 0, I_P, I_PREMIX, I_WIN, I_DNCONV, I_DNALOG, I_DNDTB, I_DNNORM, I_SCONVW, I_SCONVB, I_SDTB, I_SALOG, I_SD, I_SNORM, I_GW2, I_GB, I_GNORM, I_WBR, I_WOUT,
       I_POSTMIX, I_PREMLP, I_WUP, I_WDN, I_POSTMLP, I_PLEPRE, I_WPG, I_WPP, I_PLEPOST };

__device__ __forceinline__ void prep_dn_load(const bf16_t* proj, const float* cw, int idx, u32x4 (&raw)[4], int& t, int& ch) {
    if (idx >= 0) { t = idx / 384; const int j = idx - t * 384; ch = j * 8; }
#pragma unroll
    for (int k = 0; k < 4; ++k) { const int tt = t - 3 + k; raw[k] = (u32x4){0u, 0u, 0u, 0u};
        if (tt >= 0) raw[k] = *(const u32x4*)(proj + (size_t)tt * NP + C_DNQ + ch); }
}
__device__ __forceinline__ void prep_dn_finish(const float* cw, bf16_t* dq, bf16_t* dk, bf16_t* dv, const u32x4 (&raw)[4], int t, int ch) {
    float a[8];
#pragma unroll
    for (int e = 0; e < 8; ++e) a[e] = 0.f;
#pragma unroll
    for (int k = 0; k < 4; ++k) {
        const f32x4 w0 = *(const f32x4*)(cw + k * 3072 + ch), w1 = *(const f32x4*)(cw + k * 3072 + ch + 4);
        a[0] += w0[0] * lo16(raw[k].x); a[1] += w0[1] * hi16(raw[k].x); a[2] += w0[2] * lo16(raw[k].y); a[3] += w0[3] * hi16(raw[k].y);
        a[4] += w1[0] * lo16(raw[k].z); a[5] += w1[1] * hi16(raw[k].z); a[6] += w1[2] * lo16(raw[k].w); a[7] += w1[3] * hi16(raw[k].w); }
    float ss = 0.f;
#pragma unroll
    for (int e = 0; e < 8; ++e) { a[e] = siluf_(a[e]); ss += a[e] * a[e]; }
    ss += __shfl_xor(ss, 1); ss += __shfl_xor(ss, 2); ss += __shfl_xor(ss, 4); ss += __shfl_xor(ss, 8);
    float sc = 1.0f;
    if (ch < 2048) { sc = rsqrtf(ss + EPS); if (ch < 1024) sc *= 0.08838834764831845f; }
    u32x4 w; w.x = pk2(a[0] * sc, a[1] * sc); w.y = pk2(a[2] * sc, a[3] * sc); w.z = pk2(a[4] * sc, a[5] * sc); w.w = pk2(a[6] * sc, a[7] * sc);
    bf16_t* dst = (ch < 1024) ? dq : (ch < 2048 ? dk : dv);
    *(u32x4*)(dst + (size_t)t * 1024 + (ch & 1023)) = w;
}
__device__ void prep_dn(const Ctx& c) {
    const bf16_t* proj = c.W<bf16_t>(WS_PROJ);
    const float* cw = c.in(I_DNCONV) + (size_t)c.layer * 4 * 3072;
    bf16_t* dq = c.W<bf16_t>(WS_DQ); bf16_t* dk = c.W<bf16_t>(WS_DK); bf16_t* dv = c.W<bf16_t>(WS_DV);
    const int total = T * 384, stride = c.nw * 64;
    int base = c.gw * 64;
    for (; base + stride < total; base += 2 * stride) {
        u32x4 r0[4], r1[4]; int t0, c0, t1, c1;
        prep_dn_load(proj, cw, base + c.lane, r0, t0, c0);
        prep_dn_load(proj, cw, base + stride + c.lane, r1, t1, c1);
        prep_dn_finish(cw, dq, dk, dv, r0, t0, c0);
        prep_dn_finish(cw, dq, dk, dv, r1, t1, c1);
    }
    if (base < total) { u32x4 r0[4]; int t0, c0; prep_dn_load(proj, cw, base + c.lane, r0, t0, c0); prep_dn_finish(cw, dq, dk, dv, r0, t0, c0); }
}

__device__ void prep_dn_chunk(const Ctx& c, int ck, int half) {
    const bf16_t* proj = c.W<bf16_t>(WS_PROJ);
    const float* cw = c.in(I_DNCONV) + (size_t)c.layer * 4 * 3072;
    bf16_t* dq = c.W<bf16_t>(WS_DQ); bf16_t* dk = c.W<bf16_t>(WS_DK); bf16_t* dv = c.W<bf16_t>(WS_DV);
    for (int it = c.tid; it < 64 * 192; it += 1024) {
        u32x4 r0[4], r1[4]; int t0, c0, t1, c1;
        { const int l = it / 192, j = it - l * 192; t0 = ck * 64 + l; c0 = (j >> 6) * 1024 + half * 512 + (j & 63) * 8; }
        { const int i2 = it + 512, l = i2 / 192, j = i2 - l * 192; t1 = ck * 64 + l; c1 = (j >> 6) * 1024 + half * 512 + (j & 63) * 8; }
        prep_dn_load(proj, cw, -1, r0, t0, c0);
        prep_dn_load(proj, cw, -1, r1, t1, c1);
        prep_dn_finish(cw, dq, dk, dv, r0, t0, c0);
        prep_dn_finish(cw, dq, dk, dv, r1, t1, c1);
    }
}

__device__ void prep_ssd(const Ctx& c, int ck, int blk) {
    const bf16_t* proj = c.W<bf16_t>(WS_PROJ);
    const float* cw = c.in(I_SCONVW) + (size_t)c.layer * 4 * 1536; const float* cb = c.in(I_SCONVB) + (size_t)c.layer * 1536;
    const int tid = c.tid, t0 = ck * 64;
    float* dt_s = c.ldsf; float* acs_s = c.ldsf + 512;
    __syncthreads();
    if (blk < 2) {
        { const int hh = tid >> 6, l = tid & 63, h = blk * 8 + hh;
          const float raw = bf2f(proj[(size_t)(t0 + l) * NP + C_SDT + h]);
          const float dt = softplusf_(raw + c.in(I_SDTB)[c.layer * 16 + h]);
          float a = dt * (-__expf(c.in(I_SALOG)[c.layer * 16 + h]));
#pragma unroll
          for (int d = 1; d < 64; d <<= 1) { const float o = __shfl_up(a, d); if (l >= d) a += o; }
          const float alast = __shfl(a, 63);
          dt_s[tid] = dt; acs_s[tid] = a; c.ldsf[1024 + tid] = dt * __expf(alast - a); }
        __syncthreads();
        { const int h = blk * 8 + (tid >> 6); c.W<float>(WS_SACS)[(size_t)(ck * 16 + h) * 64 + (tid & 63)] = acs_s[tid]; }
        const int ch = blk * 512 + tid, h = ch >> 6, p = ch & 63, hh = tid >> 6;
        const float w0 = cw[ch], w1 = cw[1536 + ch], w2 = cw[2 * 1536 + ch], w3 = cw[3 * 1536 + ch], bb = cb[ch];
        float xm3 = 0.f, xm2 = 0.f, xm1 = 0.f;
        if (t0 > 0) { xm3 = bf2f(proj[(size_t)(t0 - 3) * NP + C_SX + ch]); xm2 = bf2f(proj[(size_t)(t0 - 2) * NP + C_SX + ch]); xm1 = bf2f(proj[(size_t)(t0 - 1) * NP + C_SX + ch]); }
        const float acl = acs_s[hh * 64 + 63];
        bf16_t* sX = c.W<bf16_t>(WS_SX); bf16_t* sXdT = c.W<bf16_t>(WS_SXDT); bf16_t* sXwT = c.W<bf16_t>(WS_SXW);
        bf16_t* sXp = sX + (size_t)t0 * 1024 + ch; asm volatile("" : "+v"(sXp));
        float raw[64];
        { unsigned rw[64];
          const bf16_t* rp0 = proj + (size_t)t0 * NP + C_SX + ch; asm volatile("" : "+v"(rp0));
#pragma unroll
          for (int l = 0; l < 64; ++l) rw[l] = rp0[(size_t)l * NP];
          PIN16(rw, 0); PIN16(rw, 16); PIN16(rw, 32); PIN16(rw, 48);
#pragma unroll
          for (int l = 0; l < 64; ++l) raw[l] = __uint_as_float(rw[l] << 16); }
#pragma unroll
        for (int l0 = 0; l0 < 64; l0 += 8) {
            float xd[8], xw[8];
#pragma unroll
            for (int j = 0; j < 8; ++j) { const int l = l0 + j;
                const float xc = raw[l];
                const float y = w0 * xm3 + w1 * xm2 + w2 * xm1 + w3 * xc + bb; xm3 = xm2; xm2 = xm1; xm1 = xc;
                const float x = siluf_(y);
                sXp[(size_t)l * 1024] = f2bf(x);
                xd[j] = x * dt_s[hh * 64 + l]; xw[j] = x * c.ldsf[1024 + hh * 64 + l]; }
            u32x4 a, b; a.x = pk2(xd[0], xd[1]); a.y = pk2(xd[2], xd[3]); a.z = pk2(xd[4], xd[5]); a.w = pk2(xd[6], xd[7]);
            b.x = pk2(xw[0], xw[1]); b.y = pk2(xw[2], xw[3]); b.z = pk2(xw[4], xw[5]); b.w = pk2(xw[6], xw[7]);
            const size_t o = ((size_t)(ck * 16 + h) * 64 + p) * 64 + l0;
            *(u32x4*)(sXdT + o) = a; *(u32x4*)(sXwT + o) = b;
        }
    } else {
        if (tid >= 256) return;
        const int isC = tid >> 7, cc = (blk - 2) * 128 + (tid & 127), ch = 1024 + isC * 256 + cc;
        const float w0 = cw[ch], w1 = cw[1536 + ch], w2 = cw[2 * 1536 + ch], w3 = cw[3 * 1536 + ch], bb = cb[ch];
        float xm3 = 0.f, xm2 = 0.f, xm1 = 0.f;
        if (t0 > 0) { xm3 = bf2f(proj[(size_t)(t0 - 3) * NP + C_SX + ch]); xm2 = bf2f(proj[(size_t)(t0 - 2) * NP + C_SX + ch]); xm1 = bf2f(proj[(size_t)(t0 - 1) * NP + C_SX + ch]); }
        bf16_t* rowdst = isC ? c.W<bf16_t>(WS_SC) : c.W<bf16_t>(WS_SB);
        bf16_t* sBT = c.W<bf16_t>(WS_SBT);
        const int g = cc >> 7, n = cc & 127;
        float raw[64];
        { unsigned rw[64];
          const bf16_t* rp0 = proj + (size_t)t0 * NP + C_SX + ch; asm volatile("" : "+v"(rp0));
#pragma unroll
          for (int l = 0; l < 64; ++l) rw[l] = rp0[(size_t)l * NP];
          PIN16(rw, 0); PIN16(rw, 16); PIN16(rw, 32); PIN16(rw, 48);
#pragma unroll
          for (int l = 0; l < 64; ++l) raw[l] = __uint_as_float(rw[l] << 16); }
#pragma unroll
        for (int l0 = 0; l0 < 64; l0 += 8) {
            float xv[8];
#pragma unroll
            for (int j = 0; j < 8; ++j) { const int l = l0 + j;
                const float xc = raw[l];
                const float y = w0 * xm3 + w1 * xm2 + w2 * xm1 + w3 * xc + bb; xm3 = xm2; xm2 = xm1; xm1 = xc;
                const float x = siluf_(y); xv[j] = x;
                rowdst[(size_t)(t0 + l) * 256 + cc] = f2bf(x); }
            if (!isC) { u32x4 a; a.x = pk2(xv[0], xv[1]); a.y = pk2(xv[2], xv[3]); a.z = pk2(xv[4], xv[5]); a.w = pk2(xv[6], xv[7]);
                *(u32x4*)(sBT + ((size_t)(ck * 2 + g) * 128 + n) * 64 + l0) = a; }
        }
    }
}

__device__ void prep_gla(const Ctx& c, int ck, int blk) {
    const bf16_t* proj = c.W<bf16_t>(WS_PROJ);
    const int tid = c.tid, t0 = ck * 64;
    float* lr_s = c.ldsf;
    __syncthreads();
    if (blk >= 10) {
        { const int l = tid >> 3, r2 = (tid & 7) * 2; const unsigned u = *(const unsigned*)(proj + (size_t)(t0 + l) * NP + C_GLR + r2); lr_s[l * 16 + r2] = lo16(u); lr_s[l * 16 + r2 + 1] = hi16(u); }
        __syncthreads();
        if (tid >= 256) return;
        const int ch = (blk - 10) * 256 + tid, h = ch >> 7, k = ch & 127;
        const float* w2 = c.in(I_GW2) + (size_t)c.layer * 16 * 512;
        float w2r[16];
#pragma unroll
        for (int r = 0; r < 16; ++r) w2r[r] = w2[r * 512 + ch];
        const float b2 = c.in(I_GB)[c.layer * 512 + ch];
        bf16_t* gQg = c.W<bf16_t>(WS_GQG); bf16_t* gKn = c.W<bf16_t>(WS_GKN); bf16_t* gKnT = c.W<bf16_t>(WS_GKNT);
        float G = 0.f;
        for (int lh = 0; lh < 64; lh += 32) {
            float qr[32], kr[32];
            { unsigned qw[32], kw[32];
              const bf16_t* rq0 = proj + (size_t)(t0 + lh) * NP + C_GQ + ch; asm volatile("" : "+v"(rq0));
#pragma unroll
              for (int l = 0; l < 32; ++l) { qw[l] = rq0[(size_t)l * NP]; kw[l] = rq0[(size_t)l * NP + (C_GK - C_GQ)]; }
              PIN16(qw, 0); PIN16(kw, 0); PIN16(qw, 16); PIN16(kw, 16);
#pragma unroll
              for (int l = 0; l < 32; ++l) { qr[l] = __uint_as_float(qw[l] << 16); kr[l] = __uint_as_float(kw[l] << 16); } }
#pragma unroll
            for (int l0 = 0; l0 < 32; l0 += 8) {
                float kn[8];
#pragma unroll
                for (int j = 0; j < 8; ++j) { const int l = lh + l0 + j;
                    f32x4 xs = (f32x4){b2, 0.f, 0.f, 0.f};
#pragma unroll
                    for (int r4 = 0; r4 < 16; r4 += 4) { const f32x4 lv = *(const f32x4*)(lr_s + l * 16 + r4); const f32x4 wv = (f32x4){w2r[r4], w2r[r4 + 1], w2r[r4 + 2], w2r[r4 + 3]}; xs += lv * wv; }
                    const float x = (xs[0] + xs[1]) + (xs[2] + xs[3]);
                    G += -softplusf_(-x) * (1.0f / 16.0f);
                    const float qv = qr[l0 + j] * 0.08838834764831845f, kv = kr[l0 + j];
                    const size_t o = ((size_t)(ck * 4 + h) * 64 + l) * 128 + k;
                    const float eG = __expf(G); gQg[o] = f2bf(qv * eG); const float kneg = kv * __builtin_amdgcn_rcpf(eG); gKn[o] = f2bf(kneg); kn[j] = kneg; }
                u32x4 a; a.x = pk2(kn[0], kn[1]); a.y = pk2(kn[2], kn[3]); a.z = pk2(kn[4], kn[5]); a.w = pk2(kn[6], kn[7]);
                *(u32x4*)(gKnT + ((size_t)(ck * 4 + h) * 128 + k) * 64 + lh + l0) = a;
            }
        }
        c.W<float>(WS_GDEC)[(size_t)ck * 512 + ch] = __expf(G);
    } else {
        const int ch = (blk - 1) * 512 + tid, h = ch >> 8, v = ch & 255;
        bf16_t* gVT = c.W<bf16_t>(WS_GVT);
        unsigned e[64];
        const bf16_t* rv0 = proj + (size_t)t0 * NP + C_GV + ch; asm volatile("" : "+v"(rv0));
#pragma unroll
        for (int l = 0; l < 64; ++l) e[l] = rv0[(size_t)l * NP];
        PIN16(e, 0); PIN16(e, 16); PIN16(e, 32); PIN16(e, 48);
#pragma unroll
        for (int l0 = 0; l0 < 64; l0 += 8) {
            u32x4 a; a.x = e[l0] | (e[l0 + 1] << 16); a.y = e[l0 + 2] | (e[l0 + 3] << 16); a.z = e[l0 + 4] | (e[l0 + 5] << 16); a.w = e[l0 + 6] | (e[l0 + 7] << 16);
            *(u32x4*)(gVT + ((size_t)(ck * 4 + h) * 256 + v) * 64 + l0) = a;
        }
    }
}

#define SOLVE_ROW_BEGIN(i) { float a0 = x[i], a1 = 0.f, a2 = 0.f, a3 = 0.f; const float* mr = Ms + (i) * 68;
#define SOLVE_ROW_END(i) x[i] = (a0 + a1) + (a2 + a3); }
__device__ void dn_d1(const Ctx& c, int ip) {
    const bf16_t* proj = c.W<bf16_t>(WS_PROJ);
    const bf16_t* dq = c.W<bf16_t>(WS_DQ); const bf16_t* dk = c.W<bf16_t>(WS_DK); const bf16_t* dv = c.W<bf16_t>(WS_DV);
    const int tid = c.tid, half = tid >> 8, lt = tid & 255, lw = c.wave & 3, r = c.r, q = c.q;
    const int item = ip * 2 + half, ck = item >> 3, h = item & 7, t0 = ck * 64;
    float* Ms = c.ldsf + half * (64 * 68 + 256); float* beta_s = Ms + 64 * 68; float* gc_s = beta_s + 64; float* eg_s = gc_s + 64; float* ekd_s = eg_s + 64;
    const size_t ch = (size_t)(ck * 8 + h);
    __syncthreads();
    if (lt < 64) { const size_t rb = (size_t)(t0 + lt) * NP;
        beta_s[lt] = sigmoidf_(bf2f(proj[rb + C_DNB + h]));
        float g = -__expf(c.in(I_DNALOG)[c.layer * 8 + h]) * softplusf_(bf2f(proj[rb + C_DNA + h]) + c.in(I_DNDTB)[c.layer * 8 + h]);
#pragma unroll
        for (int d = 1; d < 64; d <<= 1) { const float o = __shfl_up(g, d); if ((lt & 63) >= d) g += o; }
        gc_s[lt] = g; eg_s[lt] = __expf(g); ekd_s[lt] = __expf(__shfl(g, 63) - g); }
    __syncthreads();
    {
        const int ib = lw;
        bf16_t* dAtt = c.W<bf16_t>(WS_DATT);
        bf16x8 fki[4], fqi[4];
#pragma unroll
        for (int kk = 0; kk < 4; ++kk) { fki[kk] = ldfrag(dk + (size_t)(t0 + ib * 16 + r) * 1024 + h * 128 + kk * 32 + q * 8); fqi[kk] = ldfrag(dq + (size_t)(t0 + ib * 16 + r) * 1024 + h * 128 + kk * 32 + q * 8); }
#pragma unroll
        for (int jb = 0; jb < 4; ++jb) {
            f32x4 aK = (f32x4){0.f, 0.f, 0.f, 0.f}, aA = aK;
            if (jb <= ib) {
#pragma unroll
                for (int kk = 0; kk < 4; ++kk) {
                    const bf16x8 fkj = ldfrag(dk + (size_t)(t0 + jb * 16 + r) * 1024 + h * 128 + kk * 32 + q * 8);
                    aK = mfma16(fki[kk], fkj, aK);
                    aA = mfma16(fkj, fqi[kk], aA);
                }
#pragma unroll
                for (int j = 0; j < 4; ++j) { const int i = ib * 16 + 4 * q + j, jj = jb * 16 + r;
                    Ms[i * 68 + jj] = (i > jj) ? beta_s[i] * aK[j] * __expf(gc_s[i] - gc_s[jj]) : 0.f; }
            }
            { const int i = ib * 16 + r; f32x4 o;
#pragma unroll
              for (int j = 0; j < 4; ++j) { const int jj = jb * 16 + 4 * q + j; o[j] = (i >= jj) ? aA[j] * __expf(gc_s[i] - gc_s[jj]) : 0.f; }
              *(u32x2*)(dAtt + (ch * 64 + i) * 64 + jb * 16 + 4 * q) = pk4(o); }
        }
    }
    float x[64];
    const int col = lt & 127; const bool isw = lt >= 128;
    const float glast = gc_s[63];
    {
        const bf16_t* src = (isw ? dk : dv) + (size_t)t0 * 1024 + h * 128 + col;
        { unsigned rw[64];
#pragma unroll
          for (int i = 0; i < 64; ++i) rw[i] = src[(size_t)i * 1024];
          PIN16(rw, 0); PIN16(rw, 16); PIN16(rw, 32); PIN16(rw, 48);
#pragma unroll
          for (int i = 0; i < 64; ++i) x[i] = __uint_as_float(rw[i] << 16); }
        if (isw) {
            bf16_t* dKdT = c.W<bf16_t>(WS_DKDT);
#pragma unroll
            for (int l0 = 0; l0 < 64; l0 += 8) { u32x4 a;
                a.x = pk2(x[l0 + 0] * ekd_s[l0 + 0], x[l0 + 1] * ekd_s[l0 + 1]); a.y = pk2(x[l0 + 2] * ekd_s[l0 + 2], x[l0 + 3] * ekd_s[l0 + 3]);
                a.z = pk2(x[l0 + 4] * ekd_s[l0 + 4], x[l0 + 5] * ekd_s[l0 + 5]); a.w = pk2(x[l0 + 6] * ekd_s[l0 + 6], x[l0 + 7] * ekd_s[l0 + 7]);
                *(u32x4*)(dKdT + (ch * 128 + col) * 64 + l0) = a; }
#pragma unroll
            for (int i = 0; i < 64; ++i) x[i] *= beta_s[i] * eg_s[i];
        } else {
            bf16_t* dQg = c.W<bf16_t>(WS_DQG); const bf16_t* qs = dq + (size_t)t0 * 1024 + h * 128 + col;
            unsigned qv[64];
#pragma unroll
            for (int i = 0; i < 64; ++i) qv[i] = qs[(size_t)i * 1024];
            PIN16(qv, 0); PIN16(qv, 16); PIN16(qv, 32); PIN16(qv, 48);
#pragma unroll
            for (int i = 0; i < 64; ++i) dQg[(ch * 64 + i) * 128 + col] = f2bf(__uint_as_float(qv[i] << 16) * eg_s[i]);
#pragma unroll
            for (int i = 0; i < 64; ++i) x[i] *= beta_s[i];
        }
    }
    if (lt == 0) c.W<float>(WS_DGL)[ch] = __expf(glast);
    __syncthreads();
    SOLVE_ROW_BEGIN(1)
    { const f32x4 m = *(const f32x4*)(mr + 0);
      a0 -= m[0] * x[0];
    }
    SOLVE_ROW_END(1)
    SOLVE_ROW_BEGIN(2)
    { const f32x4 m = *(const f32x4*)(mr + 0);
      a0 -= m[0] * x[0];
      a1 -= m[1] * x[1];
    }
    SOLVE_ROW_END(2)
    SOLVE_ROW_BEGIN(3)
    { const f32x4 m = *(const f32x4*)(mr + 0);
      a0 -= m[0] * x[0];
      a1 -= m[1] * x[1];
      a2 -= m[2] * x[2];
    }
    SOLVE_ROW_END(3)
    SOLVE_ROW_BEGIN(4)
    { const f32x4 m = *(const f32x4*)(mr + 0);
      a0 -= m[0] * x[0];
      a1 -= m[1] * x[1];
      a2 -= m[2] * x[2];
      a3 -= m[3] * x[3];
    }
    SOLVE_ROW_END(4)
    SOLVE_ROW_BEGIN(5)
    { const f32x4 m = *(const f32x4*)(mr + 0);
      a0 -= m[0] * x[0];
      a1 -= m[1] * x[1];
      a2 -= m[2] * x[2];
      a3 -= m[3] * x[3];
    }
    { const f32x4 m = *(const f32x4*)(mr + 4);
      a0 -= m[0] * x[4];
    }
    SOLVE_ROW_END(5)
    SOLVE_ROW_BEGIN(6)
    { const f32x4 m = *(const f32x4*)(mr + 0);
      a0 -= m[0] * x[0];
      a1 -= m[1] * x[1];
      a2 -= m[2] * x[2];
      a3 -= m[3] * x[3];
    }
    { const f32x4 m = *(const f32x4*)(mr + 4);
      a0 -= m[0] * x[4];
      a1 -= m[1] * x[5];
    }
    SOLVE_ROW_END(6)
    SOLVE_ROW_BEGIN(7)
    { const f32x4 m = *(const f32x4*)(mr + 0);
      a0 -= m[0] * x[0];
      a1 -= m[1] * x[1];
      a2 -= m[2] * x[2];
      a3 -= m[3] * x[3];
    }
    { const f32x4 m = *(const f32x4*)(mr + 4);
      a0 -= m[0] * x[4];
      a1 -= m[1] * x[5];
      a2 -= m[2] * x[6];
    }
    SOLVE_ROW_END(7)
    SOLVE_ROW_BEGIN(8)
    { const f32x4 m = *(const f32x4*)(mr + 0);
      a0 -= m[0] * x[0];
      a1 -= m[1] * x[1];
      a2 -= m[2] * x[2];
      a3 -= m[3] * x[3];
    }
    { const f32x4 m = *(const f32x4*)(mr + 4);
      a0 -= m[0] * x[4];
      a1 -= m[1] * x[5];
      a2 -= m[2] * x[6];
      a3 -= m[3] * x[7];
    }
    SOLVE_ROW_END(8)
    SOLVE_ROW_BEGIN(9)
    { const f32x4 m = *(const f32x4*)(mr + 0);
      a0 -= m[0] * x[0];
      a1 -= m[1] * x[1];
      a2 -= m[2] * x[2];
      a3 -= m[3] * x[3];
    }
    { const f32x4 m = *(const f32x4*)(mr + 4);
      a0 -= m[0] * x[4];
      a1 -= m[1] * x[5];
      a2 -= m[2] * x[6];
      a3 -= m[3] * x[7];
    }
    { const f32x4 m = *(const f32x4*)(mr + 8);
      a0 -= m[0] * x[8];
    }
    SOLVE_ROW_END(9)
    SOLVE_ROW_BEGIN(10)
    { const f32x4 m = *(const f32x4*)(mr + 0);
      a0 -= m[0] * x[0];
      a1 -= m[1] * x[1];
      a2 -= m[2] * x[2];
      a3 -= m[3] * x[3];
    }
    { const f32x4 m = *(const f32x4*)(mr + 4);
      a0 -= m[0] * x[4];
      a1 -= m[1] * x[5];
      a2 -= m[2] * x[6];
      a3 -= m[3] * x[7];
    }
    { const f32x4 m = *(const f32x4*)(mr + 8);
      a0 -= m[0] * x[8];
      a1 -= m[1] * x[9];
    }
    SOLVE_ROW_END(10)
    SOLVE_ROW_BEGIN(11)
    { const f32x4 m = *(const f32x4*)(mr + 0);
      a0 -= m[0] * x[0];
      a1 -= m[1] * x[1];
      a2 -= m[2] * x[2];
      a3 -= m[3] * x[3];
    }
    { const f32x4 m = *(const f32x4*)(mr + 4);
      a0 -= m[0] * x[4];
      a1 -= m[1] * x[5];
      a2 -= m[2] * x[6];
      a3 -= m[3] * x[7];
    }
    { const f32x4 m = *(const f32x4*)(mr + 8);
      a0 -= m[0] * x[8];
      a1 -= m[1] * x[9];
      a2 -= m[2] * x[10];
    }
    SOLVE_ROW_END(11)
    SOLVE_ROW_BEGIN(12)
    { const f32x4 m = *(const f32x4*)(mr + 0);
      a0 -= m[0] * x[0];
      a1 -= m[1] * x[1];
      a2 -= m[2] * x[2];
      a3 -= m[3] * x[3];
    }
    { const f32x4 m = *(const f32x4*)(mr + 4);
      a0 -= m[0] * x[4];
      a1 -= m[1] * x[5];
      a2 -= m[2] * x[6];
      a3 -= m[3] * x[7];
    }
    { const f32x4 m = *(const f32x4*)(mr + 8);
      a0 -= m[0] * x[8];
      a1 -= m[1] * x[9];
      a2 -= m[2] * x[10];
      a3 -= m[3] * x[11];
    }
    SOLVE_ROW_END(12)
    SOLVE_ROW_BEGIN(13)
    { const f32x4 m = *(const f32x4*)(mr + 0);
      a0 -= m[0] * x[0];
      a1 -= m[1] * x[1];
      a2 -= m[2] * x[2];
      a3 -= m[3] * x[3];
    }
    { const f32x4 m = *(const f32x4*)(mr + 4);
      a0 -= m[0] * x[4];
      a1 -= m[1] * x[5];
      a2 -= m[2] * x[6];
      a3 -= m[3] * x[7];
    }
    { const f32x4 m = *(const f32x4*)(mr + 8);
      a0 -= m[0] * x[8];
      a1 -= m[1] * x[9];
      a2 -= m[2] * x[10];
      a3 -= m[3] * x[11];
    }
    { const f32x4 m = *(const f32x4*)(mr + 12);
      a0 -= m[0] * x[12];
    }
    SOLVE_ROW_END(13)
    SOLVE_ROW_BEGIN(14)
    { const f32x4 m = *(const f32x4*)(mr + 0);
      a0 -= m[0] * x[0];
      a1 -= m[1] * x[1];
      a2 -= m[2] * x[2];
      a3 -= m[3] * x[3];
    }
    { const f32x4 m = *(const f32x4*)(mr + 4);
      a0 -= m[0] * x[4];
      a1 -= m[1] * x[5];
      a2 -= m[2] * x[6];
      a3 -= m[3] * x[7];
    }
    { const f32x4 m = *(const f32x4*)(mr + 8);
      a0 -= m[0] * x[8];
      a1 -= m[1] * x[9];
      a2 -= m[2] * x[10];
      a3 -= m[3] * x[11];
    }
    { const f32x4 m = *(const f32x4*)(mr + 12);
      a0 -= m[0] * x[12];
      a1 -= m[1] * x[13];
    }
    SOLVE_ROW_END(14)
    SOLVE_ROW_BEGIN(15)
    { const f32x4 m = *(const f32x4*)(mr + 0);
      a0 -= m[0] * x[0];
      a1 -= m[1] * x[1];
      a2 -= m[2] * x[2];
      a3 -= m[3] * x[3];
    }
    { const f32x4 m = *(const f32x4*)(mr + 4);
      a0 -= m[0] * x[4];
      a1 -= m[1] * x[5];
      a2 -= m[2] * x[6];
      a3 -= m[3] * x[7];
    }
    { const f32x4 m = *(const f32x4*)(mr + 8);
      a0 -= m[0] * x[8];
      a1 -= m[1] * x[9];
      a2 -= m[2] * x[10];
      a3 -= m[3] * x[11];
    }
    { const f32x4 m = *(const f32x4*)(mr + 12);
      a0 -= m[0] * x[12];
      a1 -= m[1] * x[13];
      a2 -= m[2] * x[14];
    }
    SOLVE_ROW_END(15)
    SOLVE_ROW_BEGIN(16)
    { const f32x4 m = *(const f32x4*)(mr + 0);
      a0 -= m[0] * x[0];
      a1 -= m[1] * x[1];
      a2 -= m[2] * x[2];
      a3 -= m[3] * x[3];
    }
    { const f32x4 m = *(const f32x4*)(mr + 4);
      a0 -= m[0] * x[4];
      a1 -= m[1] * x[5];
      a2 -= m[2] * x[6];
      a3 -= m[3] * x[7];
    }
    { const f32x4 m = *(const f32x4*)(mr + 8);
      a0 -= m[0] * x[8];
      a1 -= m[1] * x[9];
      a2 -= m[2] * x[10];
      a3 -= m[3] * x[11];
    }
    { const f32x4 m = *(const f32x4*)(mr + 12);
      a0 -= m[0] * x[12];
      a1 -= m[1] * x[13];
      a2 -= m[2] * x[14];
      a3 -= m[3] * x[15];
    }
    SOLVE_ROW_END(16)
    SOLVE_ROW_BEGIN(17)
    { const f32x4 m = *(const f32x4*)(mr + 0);
      a0 -= m[0] * x[0];
      a1 -= m[1] * x[1];
      a2 -= m[2] * x[2];
      a3 -= m[3] * x[3];
    }
    { const f32x4 m = *(const f32x4*)(mr + 4);
      a0 -= m[0] * x[4];
      a1 -= m[1] * x[5];
      a2 -= m[2] * x[6];
      a3 -= m[3] * x[7];
    }
    { const f32x4 m = *(const f32x4*)(mr + 8);
      a0 -= m[0] * x[8];
      a1 -= m[1] * x[9];
      a2 -= m[2] * x[10];
      a3 -= m[3] * x[11];
    }
    { const f32x4 m = *(const f32x4*)(mr + 12);
      a0 -= m[0] * x[12];
      a1 -= m[1] * x[13];
      a2 -= m[2] * x[14];
      a3 -= m[3] * x[15];
    }
    { const f32x4 m = *(const f32x4*)(mr + 16);
      a0 -= m[0] * x[16];
    }
    SOLVE_ROW_END(17)
    SOLVE_ROW_BEGIN(18)
    { const f32x4 m = *(const f32x4*)(mr + 0);
      a0 -= m[0] * x[0];
      a1 -= m[1] * x[1];
      a2 -= m[2] * x[2];
      a3 -= m[3] * x[3];
    }
    { const f32x4 m = *(const f32x4*)(mr + 4);
      a0 -= m[0] * x[4];
      a1 -= m[1] * x[5];
      a2 -= m[2] * x[6];
      a3 -= m[3] * x[7];
    }
    { const f32x4 m = *(const f32x4*)(mr + 8);
      a0 -= m[0] * x[8];
      a1 -= m[1] * x[9];
      a2 -= m[2] * x[10];
      a3 -= m[3] * x[11];
    }
    { const f32x4 m = *(const f32x4*)(mr + 12);
      a0 -= m[0] * x[12];
      a1 -= m[1] * x[13];
      a2 -= m[2] * x[14];
      a3 -= m[3] * x[15];
    }
    { const f32x4 m = *(const f32x4*)(mr + 16);
      a0 -= m[0] * x[16];
      a1 -= m[1] * x[17];
    }
    SOLVE_ROW_END(18)
    SOLVE_ROW_BEGIN(19)
    { const f32x4 m = *(const f32x4*)(mr + 0);
      a0 -= m[0] * x[0];
      a1 -= m[1] * x[1];
      a2 -= m[2] * x[2];
      a3 -= m[3] * x[3];
    }
    { const f32x4 m = *(const f32x4*)(mr + 4);
      a0 -= m[0] * x[4];
      a1 -= m[1] * x[5];
      a2 -= m[2] * x[6];
      a3 -= m[3] * x[7];
    }
    { const f32x4 m = *(const f32x4*)(mr + 8);
      a0 -= m[0] * x[8];
      a1 -= m[1] * x[9];
      a2 -= m[2] * x[10];
      a3 -= m[3] * x[11];
    }
    { const f32x4 m = *(const f32x4*)(mr + 12);
      a0 -= m[0] * x[12];
      a1 -= m[1] * x[13];
      a2 -= m[2] * x[14];
      a3 -= m[3] * x[15];
    }
    { const f32x4 m = *(const f32x4*)(mr + 16);
      a0 -= m[0] * x[16];
      a1 -= m[1] * x[17];
      a2 -= m[2] * x[18];
    }
    SOLVE_ROW_END(19)
    SOLVE_ROW_BEGIN(20)
    { const f32x4 m = *(const f32x4*)(mr + 0);
      a0 -= m[0] * x[0];
      a1 -= m[1] * x[1];
      a2 -= m[2] * x[2];
      a3 -= m[3] * x[3];
    }
    { const f32x4 m = *(const f32x4*)(mr + 4);
      a0 -= m[0] * x[4];
      a1 -= m[1] * x[5];
      a2 -= m[2] * x[6];
      a3 -= m[3] * x[7];
    }
    { const f32x4 m = *(const f32x4*)(mr + 8);
      a0 -= m[0] * x[8];
      a1 -= m[1] * x[9];
      a2 -= m[2] * x[10];
      a3 -= m[3] * x[11];
    }
    { const f32x4 m = *(const f32x4*)(mr + 12);
      a0 -= m[0] * x[12];
      a1 -= m[1] * x[13];
      a2 -= m[2] * x[14];
      a3 -= m[3] * x[15];
    }
    { const f32x4 m = *(const f32x4*)(mr + 16);
      a0 -= m[0] * x[16];
      a1 -= m[1] * x[17];
      a2 -= m[2] * x[18];
      a3 -= m[3] * x[19];
    }
    SOLVE_ROW_END(20)
    SOLVE_ROW_BEGIN(21)
    { const f32x4 m = *(const f32x4*)(mr + 0);
      a0 -= m[0] * x[0];
      a1 -= m[1] * x[1];
      a2 -= m[2] * x[2];
      a3 -= m[3] * x[3];
    }
    { const f32x4 m = *(const f32x4*)(mr + 4);
      a0 -= m[0] * x[4];
      a1 -= m[1] * x[5];
      a2 -= m[2] * x[6];
      a3 -= m[3] * x[7];
    }
    { const f32x4 m = *(const f32x4*)(mr + 8);
      a0 -= m[0] * x[8];
      a1 -= m[1] * x[9];
      a2 -= m[2] * x[10];
      a3 -= m[3] * x[11];
    }
    { const f32x4 m = *(const f32x4*)(mr + 12);
      a0 -= m[0] * x[12];
      a1 -= m[1] * x[13];
      a2 -= m[2] * x[14];
      a3 -= m[3] * x[15];
    }
    { const f32x4 m = *(const f32x4*)(mr + 16);
      a0 -= m[0] * x[16];
      a1 -= m[1] * x[17];
      a2 -= m[2] * x[18];
      a3 -= m[3] * x[19];
    }
    { const f32x4 m = *(const f32x4*)(mr + 20);
      a0 -= m[0] * x[20];
    }
    SOLVE_ROW_END(21)
    SOLVE_ROW_BEGIN(22)
    { const f32x4 m = *(const f32x4*)(mr + 0);
      a0 -= m[0] * x[0];
      a1 -= m[1] * x[1];
      a2 -= m[2] * x[2];
      a3 -= m[3] * x[3];
    }
    { const f32x4 m = *(const f32x4*)(mr + 4);
      a0 -= m[0] * x[4];
      a1 -= m[1] * x[5];
      a2 -= m[2] * x[6];
      a3 -= m[3] * x[7];
    }
    { const f32x4 m = *(const f32x4*)(mr + 8);
      a0 -= m[0] * x[8];
      a1 -= m[1] * x[9];
      a2 -= m[2] * x[10];
      a3 -= m[3] * x[11];
    }
    { const f32x4 m = *(const f32x4*)(mr + 12);
      a0 -= m[0] * x[12];
      a1 -= m[1] * x[13];
      a2 -= m[2] * x[14];
      a3 -= m[3] * x[15];
    }
    { const f32x4 m = *(const f32x4*)(mr + 16);
      a0 -= m[0] * x[16];
      a1 -= m[1] * x[17];
      a2 -= m[2] * x[18];
      a3 -= m[3] * x[19];
    }
    { const f32x4 m = *(const f32x4*)(mr + 20);
      a0 -= m[0] * x[20];
      a1 -= m[1] * x[21];
    }
    SOLVE_ROW_END(22)
    SOLVE_ROW_BEGIN(23)
    { const f32x4 m = *(const f32x4*)(mr + 0);
      a0 -= m[0] * x[0];
      a1 -= m[1] * x[1];
      a2 -= m[2] * x[2];
      a3 -= m[3] * x[3];
    }
    { const f32x4 m = *(const f32x4*)(mr + 4);
      a0 -= m[0] * x[4];
      a1 -= m[1] * x[5];
      a2 -= m[2] * x[6];
      a3 -= m[3] * x[7];
    }
    { const f32x4 m = *(const f32x4*)(mr + 8);
      a0 -= m[0] * x[8];
      a1 -= m[1] * x[9];
      a2 -= m[2] * x[10];
      a3 -= m[3] * x[11];
    }
    { const f32x4 m = *(const f32x4*)(mr + 12);
      a0 -= m[0] * x[12];
      a1 -= m[1] * x[13];
      a2 -= m[2] * x[14];
      a3 -= m[3] * x[15];
    }
    { const f32x4 m = *(const f32x4*)(mr + 16);
      a0 -= m[0] * x[16];
      a1 -= m[1] * x[17];
      a2 -= m[2] * x[18];
      a3 -= m[3] * x[19];
    }
    { const f32x4 m = *(const f32x4*)(mr + 20);
      a0 -= m[0] * x[20];
      a1 -= m[1] * x[21];
      a2 -= m[2] * x[22];
    }
    SOLVE_ROW_END(23)
    SOLVE_ROW_BEGIN(24)
    { const f32x4 m = *(const f32x4*)(mr + 0);
      a0 -= m[0] * x[0];
      a1 -= m[1] * x[1];
      a2 -= m[2] * x[2];
      a3 -= m[3] * x[3];
    }
    { const f32x4 m = *(const f32x4*)(mr + 4);
      a0 -= m[0] * x[4];
      a1 -= m[1] * x[5];
      a2 -= m[2] * x[6];
      a3 -= m[3] * x[7];
    }
    { const f32x4 m = *(const f32x4*)(mr + 8);
      a0 -= m[0] * x[8];
      a1 -= m[1] * x[9];
      a2 -= m[2] * x[10];
      a3 -= m[3] * x[11];
    }
    { const f32x4 m = *(const f32x4*)(mr + 12);
      a0 -= m[0] * x[12];
      a1 -= m[1] * x[13];
      a2 -= m[2] * x[14];
      a3 -= m[3] * x[15];
    }
    { const f32x4 m = *(const f32x4*)(mr + 16);
      a0 -= m[0] * x[16];
      a1 -= m[1] * x[17];
      a2 -= m[2] * x[18];
      a3 -= m[3] * x[19];
    }
    { const f32x4 m = *(const f32x4*)(mr + 20);
      a0 -= m[0] * x[20];
      a1 -= m[1] * x[21];
      a2 -= m[2] * x[22];
      a3 -= m[3] * x[23];
    }
    SOLVE_ROW_END(24)
    SOLVE_ROW_BEGIN(25)
    { const f32x4 m = *(const f32x4*)(mr + 0);
      a0 -= m[0] * x[0];
      a1 -= m[1] * x[1];
      a2 -= m[2] * x[2];
      a3 -= m[3] * x[3];
    }
    { const f32x4 m = *(const f32x4*)(mr + 4);
      a0 -= m[0] * x[4];
      a1 -= m[1] * x[5];
      a2 -= m[2] * x[6];
      a3 -= m[3] * x[7];
    }
    { const f32x4 m = *(const f32x4*)(mr + 8);
      a0 -= m[0] * x[8];
      a1 -= m[1] * x[9];
      a2 -= m[2] * x[10];
      a3 -= m[3] * x[11];
    }
    { const f32x4 m = *(const f32x4*)(mr + 12);
      a0 -= m[0] * x[12];
      a1 -= m[1] * x[13];
      a2 -= m[2] * x[14];
      a3 -= m[3] * x[15];
    }
    { const f32x4 m = *(const f32x4*)(mr + 16);
      a0 -= m[0] * x[16];
      a1 -= m[1] * x[17];
      a2 -= m[2] * x[18];
      a3 -= m[3] * x[19];
    }
    { const f32x4 m = *(const f32x4*)(mr + 20);
      a0 -= m[0] * x[20];
      a1 -= m[1] * x[21];
      a2 -= m[2] * x[22];
      a3 -= m[3] * x[23];
    }
    { const f32x4 m = *(const f32x4*)(mr + 24);
      a0 -= m[0] * x[24];
    }
    SOLVE_ROW_END(25)
    SOLVE_ROW_BEGIN(26)
    { const f32x4 m = *(const f32x4*)(mr + 0);
      a0 -= m[0] * x[0];
      a1 -= m[1] * x[1];
      a2 -= m[2] * x[2];
      a3 -= m[3] * x[3];
    }
    { const f32x4 m = *(const f32x4*)(mr + 4);
      a0 -= m[0] * x[4];
      a1 -= m[1] * x[5];
      a2 -= m[2] * x[6];
      a3 -= m[3] * x[7];
    }
    { const f32x4 m = *(const f32x4*)(mr + 8);
      a0 -= m[0] * x[8];
      a1 -= m[1] * x[9];
      a2 -= m[2] * x[10];
      a3 -= m[3] * x[11];
    }
    { const f32x4 m = *(const f32x4*)(mr + 12);
      a0 -= m[0] * x[12];
      a1 -= m[1] * x[13];
      a2 -= m[2] * x[14];
      a3 -= m[3] * x[15];
    }
    { const f32x4 m = *(const f32x4*)(mr + 16);
      a0 -= m[0] * x[16];
      a1 -= m[1] * x[17];
      a2 -= m[2] * x[18];
      a3 -= m[3] * x[19];
    }
    { const f32x4 m = *(const f32x4*)(mr + 20);
      a0 -= m[0] * x[20];
      a1 -= m[1] * x[21];
      a2 -= m[2] * x[22];
      a3 -= m[3] * x[23];
    }
    { const f32x4 m = *(const f32x4*)(mr + 24);
      a0 -= m[0] * x[24];
      a1 -= m[1] * x[25];
    }
    SOLVE_ROW_END(26)
    SOLVE_ROW_BEGIN(27)
    { const f32x4 m = *(const f32x4*)(mr + 0);
      a0 -= m[0] * x[0];
      a1 -= m[1] * x[1];
      a2 -= m[2] * x[2];
      a3 -= m[3] * x[3];
    }
    { const f32x4 m = *(const f32x4*)(mr + 4);
      a0 -= m[0] * x[4];
      a1 -= m[1] * x[5];
      a2 -= m[2] * x[6];
      a3 -= m[3] * x[7];
    }
    { const f32x4 m = *(const f32x4*)(mr + 8);
      a0 -= m[0] * x[8];
      a1 -= m[1] * x[9];
      a2 -= m[2] * x[10];
      a3 -= m[3] * x[11];
    }
    { const f32x4 m = *(const f32x4*)(mr + 12);
      a0 -= m[0] * x[12];
      a1 -= m[1] * x[13];
      a2 -= m[2] * x[14];
      a3 -= m[3] * x[15];
    }
    { const f32x4 m = *(const f32x4*)(mr + 16);
      a0 -= m[0] * x[16];
      a1 -= m[1] * x[17];
      a2 -= m[2] * x[18];
      a3 -= m[3] * x[19];
    }
    { const f32x4 m = *(const f32x4*)(mr + 20);
      a0 -= m[0] * x[20];
      a1 -= m[1] * x[21];
      a2 -= m[2] * x[22];
      a3 -= m[3] * x[23];
    }
    { const f32x4 m = *(const f32x4*)(mr + 24);
      a0 -= m[0] * x[24];
      a1 -= m[1] * x[25];
      a2 -= m[2] * x[26];
    }
    SOLVE_ROW_END(27)
    SOLVE_ROW_BEGIN(28)
    { const f32x4 m = *(const f32x4*)(mr + 0);
      a0 -= m[0] * x[0];
      a1 -= m[1] * x[1];
      a2 -= m[2] * x[2];
      a3 -= m[3] * x[3];
    }
    { const f32x4 m = *(const f32x4*)(mr + 4);
      a0 -= m[0] * x[4];
      a1 -= m[1] * x[5];
      a2 -= m[2] * x[6];
      a3 -= m[3] * x[7];
    }
    { const f32x4 m = *(const f32x4*)(mr + 8);
      a0 -= m[0] * x[8];
      a1 -= m[1] * x[9];
      a2 -= m[2] * x[10];
      a3 -= m[3] * x[11];
    }
    { const f32x4 m = *(const f32x4*)(mr + 12);
      a0 -= m[0] * x[12];
      a1 -= m[1] * x[13];
      a2 -= m[2] * x[14];
      a3 -= m[3] * x[15];
    }
    { const f32x4 m = *(const f32x4*)(mr + 16);
      a0 -= m[0] * x[16];
      a1 -= m[1] * x[17];
      a2 -= m[2] * x[18];
      a3 -= m[3] * x[19];
    }
    { const f32x4 m = *(const f32x4*)(mr + 20);
      a0 -= m[0] * x[20];
      a1 -= m[1] * x[21];
      a2 -= m[2] * x[22];
      a3 -= m[3] * x[23];
    }
    { const f32x4 m = *(const f32x4*)(mr + 24);
      a0 -= m[0] * x[24];
      a1 -= m[1] * x[25];
      a2 -= m[2] * x[26];
      a3 -= m[3] * x[27];
    }
    SOLVE_ROW_END(28)
    SOLVE_ROW_BEGIN(29)
    { const f32x4 m = *(const f32x4*)(mr + 0);
      a0 -= m[0] * x[0];
      a1 -= m[1] * x[1];
      a2 -= m[2] * x[2];
      a3 -= m[3] * x[3];
    }
    { const f32x4 m = *(const f32x4*)(mr + 4);
      a0 -= m[0] * x[4];
      a1 -= m[1] * x[5];
      a2 -= m[2] * x[6];
      a3 -= m[3] * x[7];
    }
    { const f32x4 m = *(const f32x4*)(mr + 8);
      a0 -= m[0] * x[8];
      a1 -= m[1] * x[9];
      a2 -= m[2] * x[10];
      a3 -= m[3] * x[11];
    }
    { const f32x4 m = *(const f32x4*)(mr + 12);
      a0 -= m[0] * x[12];
      a1 -= m[1] * x[13];
      a2 -= m[2] * x[14];
      a3 -= m[3] * x[15];
    }
    { const f32x4 m = *(const f32x4*)(mr + 16);
      a0 -= m[0] * x[16];
      a1 -= m[1] * x[17];
      a2 -= m[2] * x[18];
      a3 -= m[3] * x[19];
    }
    { const f32x4 m = *(const f32x4*)(mr + 20);
      a0 -= m[0] * x[20];
      a1 -= m[1] * x[21];
      a2 -= m[2] * x[22];
      a3 -= m[3] * x[23];
    }
    { const f32x4 m = *(const f32x4*)(mr + 24);
      a0 -= m[0] * x[24];
      a1 -= m[1] * x[25];
      a2 -= m[2] * x[26];
      a3 -= m[3] * x[27];
    }
    { const f32x4 m = *(const f32x4*)(mr + 28);
      a0 -= m[0] * x[28];
    }
    SOLVE_ROW_END(29)
    SOLVE_ROW_BEGIN(30)
    { const f32x4 m = *(const f32x4*)(mr + 0);
      a0 -= m[0] * x[0];
      a1 -= m[1] * x[1];
      a2 -= m[2] * x[2];
      a3 -= m[3] * x[3];
    }
    { const f32x4 m = *(const f32x4*)(mr + 4);
      a0 -= m[0] * x[4];
      a1 -= m[1] * x[5];
      a2 -= m[2] * x[6];
      a3 -= m[3] * x[7];
    }
    { const f32x4 m = *(const f32x4*)(mr + 8);
      a0 -= m[0] * x[8];
      a1 -= m[1] * x[9];
      a2 -= m[2] * x[10];
      a3 -= m[3] * x[11];
    }
    { const f32x4 m = *(const f32x4*)(mr + 12);
      a0 -= m[0] * x[12];
      a1 -= m[1] * x[13];
      a2 -= m[2] * x[14];
      a3 -= m[3] * x[15];
    }
    { const f32x4 m = *(const f32x4*)(mr + 16);
      a0 -= m[0] * x[16];
      a1 -= m[1] * x[17];
      a2 -= m[2] * x[18];
      a3 -= m[3] * x[19];
    }
    { const f32x4 m = *(const f32x4*)(mr + 20);
      a0 -= m[0] * x[20];
      a1 -= m[1] * x[21];
      a2 -= m[2] * x[22];
      a3 -= m[3] * x[23];
    }
    { const f32x4 m = *(const f32x4*)(mr + 24);
      a0 -= m[0] * x[24];
      a1 -= m[1] * x[25];
      a2 -= m[2] * x[26];
      a3 -= m[3] * x[27];
    }
    { const f32x4 m = *(const f32x4*)(mr + 28);
      a0 -= m[0] * x[28];
      a1 -= m[1] * x[29];
    }
    SOLVE_ROW_END(30)
    SOLVE_ROW_BEGIN(31)
    { const f32x4 m = *(const f32x4*)(mr + 0);
      a0 -= m[0] * x[0];
      a1 -= m[1] * x[1];
      a2 -= m[2] * x[2];
      a3 -= m[3] * x[3];
    }
    { const f32x4 m = *(const f32x4*)(mr + 4);
      a0 -= m[0] * x[4];
      a1 -= m[1] * x[5];
      a2 -= m[2] * x[6];
      a3 -= m[3] * x[7];
    }
    { const f32x4 m = *(const f32x4*)(mr + 8);
      a0 -= m[0] * x[8];
      a1 -= m[1] * x[9];
      a2 -= m[2] * x[10];
      a3 -= m[3] * x[11];
    }
    { const f32x4 m = *(const f32x4*)(mr + 12);
      a0 -= m[0] * x[12];
      a1 -= m[1] * x[13];
      a2 -= m[2] * x[14];
      a3 -= m[3] * x[15];
    }
    { const f32x4 m = *(const f32x4*)(mr + 16);
      a0 -= m[0] * x[16];
      a1 -= m[1] * x[17];
      a2 -= m[2] * x[18];
      a3 -= m[3] * x[19];
    }
    { const f32x4 m = *(const f32x4*)(mr + 20);
      a0 -= m[0] * x[20];
      a1 -= m[1] * x[21];
      a2 -= m[2] * x[22];
      a3 -= m[3] * x[23];
    }
    { const f32x4 m = *(const f32x4*)(mr + 24);
      a0 -= m[0] * x[24];
      a1 -= m[1] * x[25];
      a2 -= m[2] * x[26];
      a3 -= m[3] * x[27];
    }
    { const f32x4 m = *(const f32x4*)(mr + 28);
      a0 -= m[0] * x[28];
      a1 -= m[1] * x[29];
      a2 -= m[2] * x[30];
    }
    SOLVE_ROW_END(31)
    SOLVE_ROW_BEGIN(32)
    { const f32x4 m = *(const f32x4*)(mr + 0);
      a0 -= m[0] * x[0];
      a1 -= m[1] * x[1];
      a2 -= m[2] * x[2];
      a3 -= m[3] * x[3];
    }
    { const f32x4 m = *(const f32x4*)(mr + 4);
      a0 -= m[0] * x[4];
      a1 -= m[1] * x[5];
      a2 -= m[2] * x[6];
      a3 -= m[3] * x[7];
    }
    { const f32x4 m = *(const f32x4*)(mr + 8);
      a0 -= m[0] * x[8];
      a1 -= m[1] * x[9];
      a2 -= m[2] * x[10];
      a3 -= m[3] * x[11];
    }
    { const f32x4 m = *(const f32x4*)(mr + 12);
      a0 -= m[0] * x[12];
      a1 -= m[1] * x[13];
      a2 -= m[2] * x[14];
      a3 -= m[3] * x[15];
    }
    { const f32x4 m = *(const f32x4*)(mr + 16);
      a0 -= m[0] * x[16];
      a1 -= m[1] * x[17];
      a2 -= m[2] * x[18];
      a3 -= m[3] * x[19];
    }
    { const f32x4 m = *(const f32x4*)(mr + 20);
      a0 -= m[0] * x[20];
      a1 -= m[1] * x[21];
      a2 -= m[2] * x[22];
      a3 -= m[3] * x[23];
    }
    { const f32x4 m = *(const f32x4*)(mr + 24);
      a0 -= m[0] * x[24];
      a1 -= m[1] * x[25];
      a2 -= m[2] * x[26];
      a3 -= m[3] * x[27];
    }
    { const f32x4 m = *(const f32x4*)(mr + 28);
      a0 -= m[0] * x[28];
      a1 -= m[1] * x[29];
      a2 -= m[2] * x[30];
      a3 -= m[3] * x[31];
    }
    SOLVE_ROW_END(32)
    SOLVE_ROW_BEGIN(33)
    { const f32x4 m = *(const f32x4*)(mr + 0);
      a0 -= m[0] * x[0];
      a1 -= m[1] * x[1];
      a2 -= m[2] * x[2];
      a3 -= m[3] * x[3];
    }
    { const f32x4 m = *(const f32x4*)(mr + 4);
      a0 -= m[0] * x[4];
      a1 -= m[1] * x[5];
      a2 -= m[2] * x[6];
      a3 -= m[3] * x[7];
    }
    { const f32x4 m = *(const f32x4*)(mr + 8);
      a0 -= m[0] * x[8];
      a1 -= m[1] * x[9];
      a2 -= m[2] * x[10];
      a3 -= m[3] * x[11];
    }
    { const f32x4 m = *(const f32x4*)(mr + 12);
      a0 -= m[0] * x[12];
      a1 -= m[1] * x[13];
      a2 -= m[2] * x[14];
      a3 -= m[3] * x[15];
    }
    { const f32x4 m = *(const f32x4*)(mr + 16);
      a0 -= m[0] * x[16];
      a1 -= m[1] * x[17];
      a2 -= m[2] * x[18];
      a3 -= m[3] * x[19];
    }
    { const f32x4 m = *(const f32x4*)(mr + 20);
      a0 -= m[0] * x[20];
      a1 -= m[1] * x[21];
      a2 -= m[2] * x[22];
      a3 -= m[3] * x[23];
    }
    { const f32x4 m = *(const f32x4*)(mr + 24);
      a0 -= m[0] * x[24];
      a1 -= m[1] * x[25];
      a2 -= m[2] * x[26];
      a3 -= m[3] * x[27];
    }
    { const f32x4 m = *(const f32x4*)(mr + 28);
      a0 -= m[0] * x[28];
      a1 -= m[1] * x[29];
      a2 -= m[2] * x[30];
      a3 -= m[3] * x[31];
    }
    { const f32x4 m = *(const f32x4*)(mr + 32);
      a0 -= m[0] * x[32];
    }
    SOLVE_ROW_END(33)
    SOLVE_ROW_BEGIN(34)
    { const f32x4 m = *(const f32x4*)(mr + 0);
      a0 -= m[0] * x[0];
      a1 -= m[1] * x[1];
      a2 -= m[2] * x[2];
      a3 -= m[3] * x[3];
    }
    { const f32x4 m = *(const f32x4*)(mr + 4);
      a0 -= m[0] * x[4];
      a1 -= m[1] * x[5];
      a2 -= m[2] * x[6];
      a3 -= m[3] * x[7];
    }
    { const f32x4 m = *(const f32x4*)(mr + 8);
      a0 -= m[0] * x[8];
      a1 -= m[1] * x[9];
      a2 -= m[2] * x[10];
      a3 -= m[3] * x[11];
    }
    { const f32x4 m = *(const f32x4*)(mr + 12);
      a0 -= m[0] * x[12];
      a1 -= m[1] * x[13];
      a2 -= m[2] * x[14];
      a3 -= m[3] * x[15];
    }
    { const f32x4 m = *(const f32x4*)(mr + 16);
      a0 -= m[0] * x[16];
      a1 -= m[1] * x[17];
      a2 -= m[2] * x[18];
      a3 -= m[3] * x[19];
    }
    { const f32x4 m = *(const f32x4*)(mr + 20);
      a0 -= m[0] * x[20];
      a1 -= m[1] * x[21];
      a2 -= m[2] * x[22];
      a3 -= m[3] * x[23];
    }
    { const f32x4 m = *(const f32x4*)(mr + 24);
      a0 -= m[0] * x[24];
      a1 -= m[1] * x[25];
      a2 -= m[2] * x[26];
      a3 -= m[3] * x[27];
    }
    { const f32x4 m = *(const f32x4*)(mr + 28);
      a0 -= m[0] * x[28];
      a1 -= m[1] * x[29];
      a2 -= m[2] * x[30];
      a3 -= m[3] * x[31];
    }
    { const f32x4 m = *(const f32x4*)(mr + 32);
      a0 -= m[0] * x[32];
      a1 -= m[1] * x[33];
    }
    SOLVE_ROW_END(34)
    SOLVE_ROW_BEGIN(35)
    { const f32x4 m = *(const f32x4*)(mr + 0);
      a0 -= m[0] * x[0];
      a1 -= m[1] * x[1];
      a2 -= m[2] * x[2];
      a3 -= m[3] * x[3];
    }
    { const f32x4 m = *(const f32x4*)(mr + 4);
      a0 -= m[0] * x[4];
      a1 -= m[1] * x[5];
      a2 -= m[2] * x[6];
      a3 -= m[3] * x[7];
    }
    { const f32x4 m = *(const f32x4*)(mr + 8);
      a0 -= m[0] * x[8];
      a1 -= m[1] * x[9];
      a2 -= m[2] * x[10];
      a3 -= m[3] * x[11];
    }
    { const f32x4 m = *(const f32x4*)(mr + 12);
      a0 -= m[0] * x[12];
      a1 -= m[1] * x[13];
      a2 -= m[2] * x[14];
      a3 -= m[3] * x[15];
    }
    { const f32x4 m = *(const f32x4*)(mr + 16);
      a0 -= m[0] * x[16];
      a1 -= m[1] * x[17];
      a2 -= m[2] * x[18];
      a3 -= m[3] * x[19];
    }
    { const f32x4 m = *(const f32x4*)(mr + 20);
      a0 -= m[0] * x[20];
      a1 -= m[1] * x[21];
      a2 -= m[2] * x[22];
      a3 -= m[3] * x[23];
    }
    { const f32x4 m = *(const f32x4*)(mr + 24);
      a0 -= m[0] * x[24];
      a1 -= m[1] * x[25];
      a2 -= m[2] * x[26];
      a3 -= m[3] * x[27];
    }
    { const f32x4 m = *(const f32x4*)(mr + 28);
      a0 -= m[0] * x[28];
      a1 -= m[1] * x[29];
      a2 -= m[2] * x[30];
      a3 -= m[3] * x[31];
    }
    { const f32x4 m = *(const f32x4*)(mr + 32);
      a0 -= m[0] * x[32];
      a1 -= m[1] * x[33];
      a2 -= m[2] * x[34];
    }
    SOLVE_ROW_END(35)
    SOLVE_ROW_BEGIN(36)
    { const f32x4 m = *(const f32x4*)(mr + 0);
      a0 -= m[0] * x[0];
      a1 -= m[1] * x[1];
      a2 -= m[2] * x[2];
      a3 -= m[3] * x[3];
    }
    { const f32x4 m = *(const f32x4*)(mr + 4);
      a0 -= m[0] * x[4];
      a1 -= m[1] * x[5];
      a2 -= m[2] * x[6];
      a3 -= m[3] * x[7];
    }
    { const f32x4 m = *(const f32x4*)(mr + 8);
      a0 -= m[0] * x[8];
      a1 -= m[1] * x[9];
      a2 -= m[2] * x[10];
      a3 -= m[3] * x[11];
    }
    { const f32x4 m = *(const f32x4*)(mr + 12);
      a0 -= m[0] * x[12];
      a1 -= m[1] * x[13];
      a2 -= m[2] * x[14];
      a3 -= m[3] * x[15];
    }
    { const f32x4 m = *(const f32x4*)(mr + 16);
      a0 -= m[0] * x[16];
      a1 -= m[1] * x[17];
      a2 -= m[2] * x[18];
      a3 -= m[3] * x[19];
    }
    { const f32x4 m = *(const f32x4*)(mr + 20);
      a0 -= m[0] * x[20];
      a1 -= m[1] * x[21];
      a2 -= m[2] * x[22];
      a3 -= m[3] * x[23];
    }
    { const f32x4 m = *(const f32x4*)(mr + 24);
      a0 -= m[0] * x[24];
      a1 -= m[1] * x[25];
      a2 -= m[2] * x[26];
      a3 -= m[3] * x[27];
    }
    { const f32x4 m = *(const f32x4*)(mr + 28);
      a0 -= m[0] * x[28];
      a1 -= m[1] * x[29];
      a2 -= m[2] * x[30];
      a3 -= m[3] * x[31];
    }
    { const f32x4 m = *(const f32x4*)(mr + 32);
      a0 -= m[0] * x[32];
      a1 -= m[1] * x[33];
      a2 -= m[2] * x[34];
      a3 -= m[3] * x[35];
    }
    SOLVE_ROW_END(36)
    SOLVE_ROW_BEGIN(37)
    { const f32x4 m = *(const f32x4*)(mr + 0);
      a0 -= m[0] * x[0];
      a1 -= m[1] * x[1];
      a2 -= m[2] * x[2];
      a3 -= m[3] * x[3];
    }
    { const f32x4 m = *(const f32x4*)(mr + 4);
      a0 -= m[0] * x[4];
      a1 -= m[1] * x[5];
      a2 -= m[2] * x[6];
      a3 -= m[3] * x[7];
    }
    { const f32x4 m = *(const f32x4*)(mr + 8);
      a0 -= m[0] * x[8];
      a1 -= m[1] * x[9];
      a2 -= m[2] * x[10];
      a3 -= m[3] * x[11];
    }
    { const f32x4 m = *(const f32x4*)(mr + 12);
      a0 -= m[0] * x[12];
      a1 -= m[1] * x[13];
      a2 -= m[2] * x[14];
      a3 -= m[3] * x[15];
    }
    { const f32x4 m = *(const f32x4*)(mr + 16);
      a0 -= m[0] * x[16];
      a1 -= m[1] * x[17];
      a2 -= m[2] * x[18];
      a3 -= m[3] * x[19];
    }
    { const f32x4 m = *(const f32x4*)(mr + 20);
      a0 -= m[0] * x[20];
      a1 -= m[1] * x[21];
      a2 -= m[2] * x[22];
      a3 -= m[3] * x[23];
    }
    { const f32x4 m = *(const f32x4*)(mr + 24);
      a0 -= m[0] * x[24];
      a1 -= m[1] * x[25];
      a2 -= m[2] * x[26];
      a3 -= m[3] * x[27];
    }
    { const f32x4 m = *(const f32x4*)(mr + 28);
      a0 -= m[0] * x[28];
      a1 -= m[1] * x[29];
      a2 -= m[2] * x[30];
      a3 -= m[3] * x[31];
    }
    { const f32x4 m = *(const f32x4*)(mr + 32);
      a0 -= m[0] * x[32];
      a1 -= m[1] * x[33];
      a2 -= m[2] * x[34];
      a3 -= m[3] * x[35];
    }
    { const f32x4 m = *(const f32x4*)(mr + 36);
      a0 -= m[0] * x[36];
    }
    SOLVE_ROW_END(37)
    SOLVE_ROW_BEGIN(38)
    { const f32x4 m = *(const f32x4*)(mr + 0);
      a0 -= m[0] * x[0];
      a1 -= m[1] * x[1];
      a2 -= m[2] * x[2];
      a3 -= m[3] * x[3];
    }
    { const f32x4 m = *(const f32x4*)(mr + 4);
      a0 -= m[0] * x[4];
      a1 -= m[1] * x[5];
      a2 -= m[2] * x[6];
      a3 -= m[3] * x[7];
    }
    { const f32x4 m = *(const f32x4*)(mr + 8);
      a0 -= m[0] * x[8];
      a1 -= m[1] * x[9];
      a2 -= m[2] * x[10];
      a3 -= m[3] * x[11];
    }
    { const f32x4 m = *(const f32x4*)(mr + 12);
      a0 -= m[0] * x[12];
      a1 -= m[1] * x[13];
      a2 -= m[2] * x[14];
      a3 -= m[3] * x[15];
    }
    { const f32x4 m = *(const f32x4*)(mr + 16);
      a0 -= m[0] * x[16];
      a1 -= m[1] * x[17];
      a2 -= m[2] * x[18];
      a3 -= m[3] * x[19];
    }
    { const f32x4 m = *(const f32x4*)(mr + 20);
      a0 -= m[0] * x[20];
      a1 -= m[1] * x[21];
      a2 -= m[2] * x[22];
      a3 -= m[3] * x[23];
    }
    { const f32x4 m = *(const f32x4*)(mr + 24);
      a0 -= m[0] * x[24];
      a1 -= m[1] * x[25];
      a2 -= m[2] * x[26];
      a3 -= m[3] * x[27];
    }
    { const f32x4 m = *(const f32x4*)(mr + 28);
      a0 -= m[0] * x[28];
      a1 -= m[1] * x[29];
      a2 -= m[2] * x[30];
      a3 -= m[3] * x[31];
    }
    { const f32x4 m = *(const f32x4*)(mr + 32);
      a0 -= m[0] * x[32];
      a1 -= m[1] * x[33];
      a2 -= m[2] * x[34];
      a3 -= m[3] * x[35];
    }
    { const f32x4 m = *(const f32x4*)(mr + 36);
      a0 -= m[0] * x[36];
      a1 -= m[1] * x[37];
    }
    SOLVE_ROW_END(38)
    SOLVE_ROW_BEGIN(39)
    { const f32x4 m = *(const f32x4*)(mr + 0);
      a0 -= m[0] * x[0];
      a1 -= m[1] * x[1];
      a2 -= m[2] * x[2];
      a3 -= m[3] * x[3];
    }
    { const f32x4 m = *(const f32x4*)(mr + 4);
      a0 -= m[0] * x[4];
      a1 -= m[1] * x[5];
      a2 -= m[2] * x[6];
      a3 -= m[3] * x[7];
    }
    { const f32x4 m = *(const f32x4*)(mr + 8);
      a0 -= m[0] * x[8];
      a1 -= m[1] * x[9];
      a2 -= m[2] * x[10];
      a3 -= m[3] * x[11];
    }
    { const f32x4 m = *(const f32x4*)(mr + 12);
      a0 -= m[0] * x[12];
      a1 -= m[1] * x[13];
      a2 -= m[2] * x[14];
      a3 -= m[3] * x[15];
    }
    { const f32x4 m = *(const f32x4*)(mr + 16);
      a0 -= m[0] * x[16];
      a1 -= m[1] * x[17];
      a2 -= m[2] * x[18];
      a3 -= m[3] * x[19];
    }
    { const f32x4 m = *(const f32x4*)(mr + 20);
      a0 -= m[0] * x[20];
      a1 -= m[1] * x[21];
      a2 -= m[2] * x[22];
      a3 -= m[3] * x[23];
    }
    { const f32x4 m = *(const f32x4*)(mr + 24);
      a0 -= m[0] * x[24];
      a1 -= m[1] * x[25];
      a2 -= m[2] * x[26];
      a3 -= m[3] * x[27];
    }
    { const f32x4 m = *(const f32x4*)(mr + 28);
      a0 -= m[0] * x[28];
      a1 -= m[1] * x[29];
      a2 -= m[2] * x[30];
      a3 -= m[3] * x[31];
    }
    { const f32x4 m = *(const f32x4*)(mr + 32);
      a0 -= m[0] * x[32];
      a1 -= m[1] * x[33];
      a2 -= m[2] * x[34];
      a3 -= m[3] * x[35];
    }
    { const f32x4 m = *(const f32x4*)(mr + 36);
      a0 -= m[0] * x[36];
      a1 -= m[1] * x[37];
      a2 -= m[2] * x[38];
    }
    SOLVE_ROW_END(39)
    SOLVE_ROW_BEGIN(40)
    { const f32x4 m = *(const f32x4*)(mr + 0);
      a0 -= m[0] * x[0];
      a1 -= m[1] * x[1];
      a2 -= m[2] * x[2];
      a3 -= m[3] * x[3];
    }
    { const f32x4 m = *(const f32x4*)(mr + 4);
      a0 -= m[0] * x[4];
      a1 -= m[1] * x[5];
      a2 -= m[2] * x[6];
      a3 -= m[3] * x[7];
    }
    { const f32x4 m = *(const f32x4*)(mr + 8);
      a0 -= m[0] * x[8];
      a1 -= m[1] * x[9];
      a2 -= m[2] * x[10];
      a3 -= m[3] * x[11];
    }
    { const f32x4 m = *(const f32x4*)(mr + 12);
      a0 -= m[0] * x[12];
      a1 -= m[1] * x[13];
      a2 -= m[2] * x[14];
      a3 -= m[3] * x[15];
    }
    { const f32x4 m = *(const f32x4*)(mr + 16);
      a0 -= m[0] * x[16];
      a1 -= m[1] * x[17];
      a2 -= m[2] * x[18];
      a3 -= m[3] * x[19];
    }
    { const f32x4 m = *(const f32x4*)(mr + 20);
      a0 -= m[0] * x[20];
      a1 -= m[1] * x[21];
      a2 -= m[2] * x[22];
      a3 -= m[3] * x[23];
    }
    { const f32x4 m = *(const f32x4*)(mr + 24);
      a0 -= m[0] * x[24];
      a1 -= m[1] * x[25];
      a2 -= m[2] * x[26];
      a3 -= m[3] * x[27];
    }
    { const f32x4 m = *(const f32x4*)(mr + 28);
      a0 -= m[0] * x[28];
      a1 -= m[1] * x[29];
      a2 -= m[2] * x[30];
      a3 -= m[3] * x[31];
    }
    { const f32x4 m = *(const f32x4*)(mr + 32);
      a0 -= m[0] * x[32];
      a1 -= m[1] * x[33];
      a2 -= m[2] * x[34];
      a3 -= m[3] * x[35];
    }
    { const f32x4 m = *(const f32x4*)(mr + 36);
      a0 -= m[0] * x[36];
      a1 -= m[1] * x[37];
      a2 -= m[2] * x[38];
      a3 -= m[3] * x[39];
    }
    SOLVE_ROW_END(40)
    SOLVE_ROW_BEGIN(41)
    { const f32x4 m = *(const f32x4*)(mr + 0);
      a0 -= m[0] * x[0];
      a1 -= m[1] * x[1];
      a2 -= m[2] * x[2];
      a3 -= m[3] * x[3];
    }
    { const f32x4 m = *(const f32x4*)(mr + 4);
      a0 -= m[0] * x[4];
      a1 -= m[1] * x[5];
      a2 -= m[2] * x[6];
      a3 -= m[3] * x[7];
    }
    { const f32x4 m = *(const f32x4*)(mr + 8);
      a0 -= m[0] * x[8];
      a1 -= m[1] * x[9];
      a2 -= m[2] * x[10];
      a3 -= m[3] * x[11];
    }
    { const f32x4 m = *(const f32x4*)(mr + 12);
      a0 -= m[0] * x[12];
      a1 -= m[1] * x[13];
      a2 -= m[2] * x[14];
      a3 -= m[3] * x[15];
    }
    { const f32x4 m = *(const f32x4*)(mr + 16);
      a0 -= m[0] * x[16];
      a1 -= m[1] * x[17];
      a2 -= m[2] * x[18];
      a3 -= m[3] * x[19];
    }
    { const f32x4 m = *(const f32x4*)(mr + 20);
      a0 -= m[0] * x[20];
      a1 -= m[1] * x[21];
      a2 -= m[2] * x[22];
      a3 -= m[3] * x[23];
    }
    { const f32x4 m = *(const f32x4*)(mr + 24);
      a0 -= m[0] * x[24];
      a1 -= m[1] * x[25];
      a2 -= m[2] * x[26];
      a3 -= m[3] * x[27];
    }
    { const f32x4 m = *(const f32x4*)(mr + 28);
      a0 -= m[0] * x[28];
      a1 -= m[1] * x[29];
      a2 -= m[2] * x[30];
      a3 -= m[3] * x[31];
    }
    { const f32x4 m = *(const f32x4*)(mr + 32);
      a0 -= m[0] * x[32];
      a1 -= m[1] * x[33];
      a2 -= m[2] * x[34];
      a3 -= m[3] * x[35];
    }
    { const f32x4 m = *(const f32x4*)(mr + 36);
      a0 -= m[0] * x[36];
      a1 -= m[1] * x[37];
      a2 -= m[2] * x[38];
      a3 -= m[3] * x[39];
    }
    { const f32x4 m = *(const f32x4*)(mr + 40);
      a0 -= m[0] * x[40];
    }
    SOLVE_ROW_END(41)
    SOLVE_ROW_BEGIN(42)
    { const f32x4 m = *(const f32x4*)(mr + 0);
      a0 -= m[0] * x[0];
      a1 -= m[1] * x[1];
      a2 -= m[2] * x[2];
      a3 -= m[3] * x[3];
    }
    { const f32x4 m = *(const f32x4*)(mr + 4);
      a0 -= m[0] * x[4];
      a1 -= m[1] * x[5];
      a2 -= m[2] * x[6];
      a3 -= m[3] * x[7];
    }
    { const f32x4 m = *(const f32x4*)(mr + 8);
      a0 -= m[0] * x[8];
      a1 -= m[1] * x[9];
      a2 -= m[2] * x[10];
      a3 -= m[3] * x[11];
    }
    { const f32x4 m = *(const f32x4*)(mr + 12);
      a0 -= m[0] * x[12];
      a1 -= m[1] * x[13];
      a2 -= m[2] * x[14];
      a3 -= m[3] * x[15];
    }
    { const f32x4 m = *(const f32x4*)(mr + 16);
      a0 -= m[0] * x[16];
      a1 -= m[1] * x[17];
      a2 -= m[2] * x[18];
      a3 -= m[3] * x[19];
    }
    { const f32x4 m = *(const f32x4*)(mr + 20);
      a0 -= m[0] * x[20];
      a1 -= m[1] * x[21];
      a2 -= m[2] * x[22];
      a3 -= m[3] * x[23];
    }
    { const f32x4 m = *(const f32x4*)(mr + 24);
      a0 -= m[0] * x[24];
      a1 -= m[1] * x[25];
      a2 -= m[2] * x[26];
      a3 -= m[3] * x[27];
    }
    { const f32x4 m = *(const f32x4*)(mr + 28);
      a0 -= m[0] * x[28];
      a1 -= m[1] * x[29];
      a2 -= m[2] * x[30];
      a3 -= m[3] * x[31];
    }
    { const f32x4 m = *(const f32x4*)(mr + 32);
      a0 -= m[0] * x[32];
      a1 -= m[1] * x[33];
      a2 -= m[2] * x[34];
      a3 -= m[3] * x[35];
    }
    { const f32x4 m = *(const f32x4*)(mr + 36);
      a0 -= m[0] * x[36];
      a1 -= m[1] * x[37];
      a2 -= m[2] * x[38];
      a3 -= m[3] * x[39];
    }
    { const f32x4 m = *(const f32x4*)(mr + 40);
      a0 -= m[0] * x[40];
      a1 -= m[1] * x[41];
    }
    SOLVE_ROW_END(42)
    SOLVE_ROW_BEGIN(43)
    { const f32x4 m = *(const f32x4*)(mr + 0);
      a0 -= m[0] * x[0];
      a1 -= m[1] * x[1];
      a2 -= m[2] * x[2];
      a3 -= m[3] * x[3];
    }
    { const f32x4 m = *(const f32x4*)(mr + 4);
      a0 -= m[0] * x[4];
      a1 -= m[1] * x[5];
      a2 -= m[2] * x[6];
      a3 -= m[3] * x[7];
    }
    { const f32x4 m = *(const f32x4*)(mr + 8);
      a0 -= m[0] * x[8];
      a1 -= m[1] * x[9];
      a2 -= m[2] * x[10];
      a3 -= m[3] * x[11];
    }
    { const f32x4 m = *(const f32x4*)(mr + 12);
      a0 -= m[0] * x[12];
      a1 -= m[1] * x[13];
      a2 -= m[2] * x[14];
      a3 -= m[3] * x[15];
    }
    { const f32x4 m = *(const f32x4*)(mr + 16);
      a0 -= m[0] * x[16];
      a1 -= m[1] * x[17];
      a2 -= m[2] * x[18];
      a3 -= m[3] * x[19];
    }
    { const f32x4 m = *(const f32x4*)(mr + 20);
      a0 -= m[0] * x[20];
      a1 -= m[1] * x[21];
      a2 -= m[2] * x[22];
      a3 -= m[3] * x[23];
    }
    { const f32x4 m = *(const f32x4*)(mr + 24);
      a0 -= m[0] * x[24];
      a1 -= m[1] * x[25];
      a2 -= m[2] * x[26];
      a3 -= m[3] * x[27];
    }
    { const f32x4 m = *(const f32x4*)(mr + 28);
      a0 -= m[0] * x[28];
      a1 -= m[1] * x[29];
      a2 -= m[2] * x[30];
      a3 -= m[3] * x[31];
    }
    { const f32x4 m = *(const f32x4*)(mr + 32);
      a0 -= m[0] * x[32];
      a1 -= m[1] * x[33];
      a2 -= m[2] * x[34];
      a3 -= m[3] * x[35];
    }
    { const f32x4 m = *(const f32x4*)(mr + 36);
      a0 -= m[0] * x[36];
      a1 -= m[1] * x[37];
      a2 -= m[2] * x[38];
      a3 -= m[3] * x[39];
    }
    { const f32x4 m = *(const f32x4*)(mr + 40);
      a0 -= m[0] * x[40];
      a1 -= m[1] * x[41];
      a2 -= m[2] * x[42];
    }
    SOLVE_ROW_END(43)
    SOLVE_ROW_BEGIN(44)
    { const f32x4 m = *(const f32x4*)(mr + 0);
      a0 -= m[0] * x[0];
      a1 -= m[1] * x[1];
      a2 -= m[2] * x[2];
      a3 -= m[3] * x[3];
    }
    { const f32x4 m = *(const f32x4*)(mr + 4);
      a0 -= m[0] * x[4];
      a1 -= m[1] * x[5];
      a2 -= m[2] * x[6];
      a3 -= m[3] * x[7];
    }
    { const f32x4 m = *(const f32x4*)(mr + 8);
      a0 -= m[0] * x[8];
      a1 -= m[1] * x[9];
      a2 -= m[2] * x[10];
      a3 -= m[3] * x[11];
    }
    { const f32x4 m = *(const f32x4*)(mr + 12);
      a0 -= m[0] * x[12];
      a1 -= m[1] * x[13];
      a2 -= m[2] * x[14];
      a3 -= m[3] * x[15];
    }
    { const f32x4 m = *(const f32x4*)(mr + 16);
      a0 -= m[0] * x[16];
      a1 -= m[1] * x[17];
      a2 -= m[2] * x[18];
      a3 -= m[3] * x[19];
    }
    { const f32x4 m = *(const f32x4*)(mr + 20);
      a0 -= m[0] * x[20];
      a1 -= m[1] * x[21];
      a2 -= m[2] * x[22];
      a3 -= m[3] * x[23];
    }
    { const f32x4 m = *(const f32x4*)(mr + 24);
      a0 -= m[0] * x[24];
      a1 -= m[1] * x[25];
      a2 -= m[2] * x[26];
      a3 -= m[3] * x[27];
    }
    { const f32x4 m = *(const f32x4*)(mr + 28);
      a0 -= m[0] * x[28];
      a1 -= m[1] * x[29];
      a2 -= m[2] * x[30];
      a3 -= m[3] * x[31];
    }
    { const f32x4 m = *(const f32x4*)(mr + 32);
      a0 -= m[0] * x[32];
      a1 -= m[1] * x[33];
      a2 -= m[2] * x[34];
      a3 -= m[3] * x[35];
    }
    { const f32x4 m = *(const f32x4*)(mr + 36);
      a0 -= m[0] * x[36];
      a1 -= m[1] * x[37];
      a2 -= m[2] * x[38];
      a3 -= m[3] * x[39];
    }
    { const f32x4 m = *(const f32x4*)(mr + 40);
      a0 -= m[0] * x[40];
      a1 -= m[1] * x[41];
      a2 -= m[2] * x[42];
      a3 -= m[3] * x[43];
    }
    SOLVE_ROW_END(44)
    SOLVE_ROW_BEGIN(45)
    { const f32x4 m = *(const f32x4*)(mr + 0);
      a0 -= m[0] * x[0];
      a1 -= m[1] * x[1];
      a2 -= m[2] * x[2];
      a3 -= m[3] * x[3];
    }
    { const f32x4 m = *(const f32x4*)(mr + 4);
      a0 -= m[0] * x[4];
      a1 -= m[1] * x[5];
      a2 -= m[2] * x[6];
      a3 -= m[3] * x[7];
    }
    { const f32x4 m = *(const f32x4*)(mr + 8);
      a0 -= m[0] * x[8];
      a1 -= m[1] * x[9];
      a2 -= m[2] * x[10];
      a3 -= m[3] * x[11];
    }
    { const f32x4 m = *(const f32x4*)(mr + 12);
      a0 -= m[0] * x[12];
      a1 -= m[1] * x[13];
      a2 -= m[2] * x[14];
      a3 -= m[3] * x[15];
    }
    { const f32x4 m = *(const f32x4*)(mr + 16);
      a0 -= m[0] * x[16];
      a1 -= m[1] * x[17];
      a2 -= m[2] * x[18];
      a3 -= m[3] * x[19];
    }
    { const f32x4 m = *(const f32x4*)(mr + 20);
      a0 -= m[0] * x[20];
      a1 -= m[1] * x[21];
      a2 -= m[2] * x[22];
      a3 -= m[3] * x[23];
    }
    { const f32x4 m = *(const f32x4*)(mr + 24);
      a0 -= m[0] * x[24];
      a1 -= m[1] * x[25];
      a2 -= m[2] * x[26];
      a3 -= m[3] * x[27];
    }
    { const f32x4 m = *(const f32x4*)(mr + 28);
      a0 -= m[0] * x[28];
      a1 -= m[1] * x[29];
      a2 -= m[2] * x[30];
      a3 -= m[3] * x[31];
    }
    { const f32x4 m = *(const f32x4*)(mr + 32);
      a0 -= m[0] * x[32];
      a1 -= m[1] * x[33];
      a2 -= m[2] * x[34];
      a3 -= m[3] * x[35];
    }
    { const f32x4 m = *(const f32x4*)(mr + 36);
      a0 -= m[0] * x[36];
      a1 -= m[1] * x[37];
      a2 -= m[2] * x[38];
      a3 -= m[3] * x[39];
    }
    { const f32x4 m = *(const f32x4*)(mr + 40);
      a0 -= m[0] * x[40];
      a1 -= m[1] * x[41];
      a2 -= m[2] * x[42];
      a3 -= m[3] * x[43];
    }
    { const f32x4 m = *(const f32x4*)(mr + 44);
      a0 -= m[0] * x[44];
    }
    SOLVE_ROW_END(45)
    SOLVE_ROW_BEGIN(46)
    { const f32x4 m = *(const f32x4*)(mr + 0);
      a0 -= m[0] * x[0];
      a1 -= m[1] * x[1];
      a2 -= m[2] * x[2];
      a3 -= m[3] * x[3];
    }
    { const f32x4 m = *(const f32x4*)(mr + 4);
      a0 -= m[0] * x[4];
      a1 -= m[1] * x[5];
      a2 -= m[2] * x[6];
      a3 -= m[3] * x[7];
    }
    { const f32x4 m = *(const f32x4*)(mr + 8);
      a0 -= m[0] * x[8];
      a1 -= m[1] * x[9];
      a2 -= m[2] * x[10];
      a3 -= m[3] * x[11];
    }
    { const f32x4 m = *(const f32x4*)(mr + 12);
      a0 -= m[0] * x[12];
      a1 -= m[1] * x[13];
      a2 -= m[2] * x[14];
      a3 -= m[3] * x[15];
    }
    { const f32x4 m = *(const f32x4*)(mr + 16);
      a0 -= m[0] * x[16];
      a1 -= m[1] * x[17];
      a2 -= m[2] * x[18];
      a3 -= m[3] * x[19];
    }
    { const f32x4 m = *(const f32x4*)(mr + 20);
      a0 -= m[0] * x[20];
      a1 -= m[1] * x[21];
      a2 -= m[2] * x[22];
      a3 -= m[3] * x[23];
    }
    { const f32x4 m = *(const f32x4*)(mr + 24);
      a0 -= m[0] * x[24];
      a1 -= m[1] * x[25];
      a2 -= m[2] * x[26];
      a3 -= m[3] * x[27];
    }
    { const f32x4 m = *(const f32x4*)(mr + 28);
      a0 -= m[0] * x[28];
      a1 -= m[1] * x[29];
      a2 -= m[2] * x[30];
      a3 -= m[3] * x[31];
    }
    { const f32x4 m = *(const f32x4*)(mr + 32);
      a0 -= m[0] * x[32];
      a1 -= m[1] * x[33];
      a2 -= m[2] * x[34];
      a3 -= m[3] * x[35];
    }
    { const f32x4 m = *(const f32x4*)(mr + 36);
      a0 -= m[0] * x[36];
      a1 -= m[1] * x[37];
      a2 -= m[2] * x[38];
      a3 -= m[3] * x[39];
    }
    { const f32x4 m = *(const f32x4*)(mr + 40);
      a0 -= m[0] * x[40];
      a1 -= m[1] * x[41];
      a2 -= m[2] * x[42];
      a3 -= m[3] * x[43];
    }
    { const f32x4 m = *(const f32x4*)(mr + 44);
      a0 -= m[0] * x[44];
      a1 -= m[1] * x[45];
    }
    SOLVE_ROW_END(46)
    SOLVE_ROW_BEGIN(47)
    { const f32x4 m = *(const f32x4*)(mr + 0);
      a0 -= m[0] * x[0];
      a1 -= m[1] * x[1];
      a2 -= m[2] * x[2];
      a3 -= m[3] * x[3];
    }
    { const f32x4 m = *(const f32x4*)(mr + 4);
      a0 -= m[0] * x[4];
      a1 -= m[1] * x[5];
      a2 -= m[2] * x[6];
      a3 -= m[3] * x[7];
    }
    { const f32x4 m = *(const f32x4*)(mr + 8);
      a0 -= m[0] * x[8];
      a1 -= m[1] * x[9];
      a2 -= m[2] * x[10];
      a3 -= m[3] * x[11];
    }
    { const f32x4 m = *(const f32x4*)(mr + 12);
      a0 -= m[0] * x[12];
      a1 -= m[1] * x[13];
      a2 -= m[2] * x[14];
      a3 -= m[3] * x[15];
    }
    { const f32x4 m = *(const f32x4*)(mr + 16);
      a0 -= m[0] * x[16];
      a1 -= m[1] * x[17];
      a2 -= m[2] * x[18];
      a3 -= m[3] * x[19];
    }
    { const f32x4 m = *(const f32x4*)(mr + 20);
      a0 -= m[0] * x[20];
      a1 -= m[1] * x[21];
      a2 -= m[2] * x[22];
      a3 -= m[3] * x[23];
    }
    { const f32x4 m = *(const f32x4*)(mr + 24);
      a0 -= m[0] * x[24];
      a1 -= m[1] * x[25];
      a2 -= m[2] * x[26];
      a3 -= m[3] * x[27];
    }
    { const f32x4 m = *(const f32x4*)(mr + 28);
      a0 -= m[0] * x[28];
      a1 -= m[1] * x[29];
      a2 -= m[2] * x[30];
      a3 -= m[3] * x[31];
    }
    { const f32x4 m = *(const f32x4*)(mr + 32);
      a0 -= m[0] * x[32];
      a1 -= m[1] * x[33];
      a2 -= m[2] * x[34];
      a3 -= m[3] * x[35];
    }
    { const f32x4 m = *(const f32x4*)(mr + 36);
      a0 -= m[0] * x[36];
      a1 -= m[1] * x[37];
      a2 -= m[2] * x[38];
      a3 -= m[3] * x[39];
    }
    { const f32x4 m = *(const f32x4*)(mr + 40);
      a0 -= m[0] * x[40];
      a1 -= m[1] * x[41];
      a2 -= m[2] * x[42];
      a3 -= m[3] * x[43];
    }
    { const f32x4 m = *(const f32x4*)(mr + 44);
      a0 -= m[0] * x[44];
      a1 -= m[1] * x[45];
      a2 -= m[2] * x[46];
    }
    SOLVE_ROW_END(47)
    SOLVE_ROW_BEGIN(48)
    { const f32x4 m = *(const f32x4*)(mr + 0);
      a0 -= m[0] * x[0];
      a1 -= m[1] * x[1];
      a2 -= m[2] * x[2];
      a3 -= m[3] * x[3];
    }
    { const f32x4 m = *(const f32x4*)(mr + 4);
      a0 -= m[0] * x[4];
      a1 -= m[1] * x[5];
      a2 -= m[2] * x[6];
      a3 -= m[3] * x[7];
    }
    { const f32x4 m = *(const f32x4*)(mr + 8);
      a0 -= m[0] * x[8];
      a1 -= m[1] * x[9];
      a2 -= m[2] * x[10];
      a3 -= m[3] * x[11];
    }
    { const f32x4 m = *(const f32x4*)(mr + 12);
      a0 -= m[0] * x[12];
      a1 -= m[1] * x[13];
      a2 -= m[2] * x[14];
      a3 -= m[3] * x[15];
    }
    { const f32x4 m = *(const f32x4*)(mr + 16);
      a0 -= m[0] * x[16];
      a1 -= m[1] * x[17];
      a2 -= m[2] * x[18];
      a3 -= m[3] * x[19];
    }
    { const f32x4 m = *(const f32x4*)(mr + 20);
      a0 -= m[0] * x[20];
      a1 -= m[1] * x[21];
      a2 -= m[2] * x[22];
      a3 -= m[3] * x[23];
    }
    { const f32x4 m = *(const f32x4*)(mr + 24);
      a0 -= m[0] * x[24];
      a1 -= m[1] * x[25];
      a2 -= m[2] * x[26];
      a3 -= m[3] * x[27];
    }
    { const f32x4 m = *(const f32x4*)(mr + 28);
      a0 -= m[0] * x[28];
      a1 -= m[1] * x[29];
      a2 -= m[2] * x[30];
      a3 -= m[3] * x[31];
    }
    { const f32x4 m = *(const f32x4*)(mr + 32);
      a0 -= m[0] * x[32];
      a1 -= m[1] * x[33];
      a2 -= m[2] * x[34];
      a3 -= m[3] * x[35];
    }
    { const f32x4 m = *(const f32x4*)(mr + 36);
      a0 -= m[0] * x[36];
      a1 -= m[1] * x[37];
      a2 -= m[2] * x[38];
      a3 -= m[3] * x[39];
    }
    { const f32x4 m = *(const f32x4*)(mr + 40);
      a0 -= m[0] * x[40];
      a1 -= m[1] * x[41];
      a2 -= m[2] * x[42];
      a3 -= m[3] * x[43];
    }
    { const f32x4 m = *(const f32x4*)(mr + 44);
      a0 -= m[0] * x[44];
      a1 -= m[1] * x[45];
      a2 -= m[2] * x[46];
      a3 -= m[3] * x[47];
    }
    SOLVE_ROW_END(48)
    SOLVE_ROW_BEGIN(49)
    { const f32x4 m = *(const f32x4*)(mr + 0);
      a0 -= m[0] * x[0];
      a1 -= m[1] * x[1];
      a2 -= m[2] * x[2];
      a3 -= m[3] * x[3];
    }
    { const f32x4 m = *(const f32x4*)(mr + 4);
      a0 -= m[0] * x[4];
      a1 -= m[1] * x[5];
      a2 -= m[2] * x[6];
      a3 -= m[3] * x[7];
    }
    { const f32x4 m = *(const f32x4*)(mr + 8);
      a0 -= m[0] * x[8];
      a1 -= m[1] * x[9];
      a2 -= m[2] * x[10];
      a3 -= m[3] * x[11];
    }
    { const f32x4 m = *(const f32x4*)(mr + 12);
      a0 -= m[0] * x[12];
      a1 -= m[1] * x[13];
      a2 -= m[2] * x[14];
      a3 -= m[3] * x[15];
    }
    { const f32x4 m = *(const f32x4*)(mr + 16);
      a0 -= m[0] * x[16];
      a1 -= m[1] * x[17];
      a2 -= m[2] * x[18];
      a3 -= m[3] * x[19];
    }
    { const f32x4 m = *(const f32x4*)(mr + 20);
      a0 -= m[0] * x[20];
      a1 -= m[1] * x[21];
      a2 -= m[2] * x[22];
      a3 -= m[3] * x[23];
    }
    { const f32x4 m = *(const f32x4*)(mr + 24);
      a0 -= m[0] * x[24];
      a1 -= m[1] * x[25];
      a2 -= m[2] * x[26];
      a3 -= m[3] * x[27];
    }
    { const f32x4 m = *(const f32x4*)(mr + 28);
      a0 -= m[0] * x[28];
      a1 -= m[1] * x[29];
      a2 -= m[2] * x[30];
      a3 -= m[3] * x[31];
    }
    { const f32x4 m = *(const f32x4*)(mr + 32);
      a0 -= m[0] * x[32];
      a1 -= m[1] * x[33];
      a2 -= m[2] * x[34];
      a3 -= m[3] * x[35];
    }
    { const f32x4 m = *(const f32x4*)(mr + 36);
      a0 -= m[0] * x[36];
      a1 -= m[1] * x[37];
      a2 -= m[2] * x[38];
      a3 -= m[3] * x[39];
    }
    { const f32x4 m = *(const f32x4*)(mr + 40);
      a0 -= m[0] * x[40];
      a1 -= m[1] * x[41];
      a2 -= m[2] * x[42];
      a3 -= m[3] * x[43];
    }
    { const f32x4 m = *(const f32x4*)(mr + 44);
      a0 -= m[0] * x[44];
      a1 -= m[1] * x[45];
      a2 -= m[2] * x[46];
      a3 -= m[3] * x[47];
    }
    { const f32x4 m = *(const f32x4*)(mr + 48);
      a0 -= m[0] * x[48];
    }
    SOLVE_ROW_END(49)
    SOLVE_ROW_BEGIN(50)
    { const f32x4 m = *(const f32x4*)(mr + 0);
      a0 -= m[0] * x[0];
      a1 -= m[1] * x[1];
      a2 -= m[2] * x[2];
      a3 -= m[3] * x[3];
    }
    { const f32x4 m = *(const f32x4*)(mr + 4);
      a0 -= m[0] * x[4];
      a1 -= m[1] * x[5];
      a2 -= m[2] * x[6];
      a3 -= m[3] * x[7];
    }
    { const f32x4 m = *(const f32x4*)(mr + 8);
      a0 -= m[0] * x[8];
      a1 -= m[1] * x[9];
      a2 -= m[2] * x[10];
      a3 -= m[3] * x[11];
    }
    { const f32x4 m = *(const f32x4*)(mr + 12);
      a0 -= m[0] * x[12];
      a1 -= m[1] * x[13];
      a2 -= m[2] * x[14];
      a3 -= m[3] * x[15];
    }
    { const f32x4 m = *(const f32x4*)(mr + 16);
      a0 -= m[0] * x[16];
      a1 -= m[1] * x[17];
      a2 -= m[2] * x[18];
      a3 -= m[3] * x[19];
    }
    { const f32x4 m = *(const f32x4*)(mr + 20);
      a0 -= m[0] * x[20];
      a1 -= m[1] * x[21];
      a2 -= m[2] * x[22];
      a3 -= m[3] * x[23];
    }
    { const f32x4 m = *(const f32x4*)(mr + 24);
      a0 -= m[0] * x[24];
      a1 -= m[1] * x[25];
      a2 -= m[2] * x[26];
      a3 -= m[3] * x[27];
    }
    { const f32x4 m = *(const f32x4*)(mr + 28);
      a0 -= m[0] * x[28];
      a1 -= m[1] * x[29];
      a2 -= m[2] * x[30];
      a3 -= m[3] * x[31];
    }
    { const f32x4 m = *(const f32x4*)(mr + 32);
      a0 -= m[0] * x[32];
      a1 -= m[1] * x[33];
      a2 -= m[2] * x[34];
      a3 -= m[3] * x[35];
    }
    { const f32x4 m = *(const f32x4*)(mr + 36);
      a0 -= m[0] * x[36];
      a1 -= m[1] * x[37];
      a2 -= m[2] * x[38];
      a3 -= m[3] * x[39];
    }
    { const f32x4 m = *(const f32x4*)(mr + 40);
      a0 -= m[0] * x[40];
      a1 -= m[1] * x[41];
      a2 -= m[2] * x[42];
      a3 -= m[3] * x[43];
    }
    { const f32x4 m = *(const f32x4*)(mr + 44);
      a0 -= m[0] * x[44];
      a1 -= m[1] * x[45];
      a2 -= m[2] * x[46];
      a3 -= m[3] * x[47];
    }
    { const f32x4 m = *(const f32x4*)(mr + 48);
      a0 -= m[0] * x[48];
      a1 -= m[1] * x[49];
    }
    SOLVE_ROW_END(50)
    SOLVE_ROW_BEGIN(51)
    { const f32x4 m = *(const f32x4*)(mr + 0);
      a0 -= m[0] * x[0];
      a1 -= m[1] * x[1];
      a2 -= m[2] * x[2];
      a3 -= m[3] * x[3];
    }
    { const f32x4 m = *(const f32x4*)(mr + 4);
      a0 -= m[0] * x[4];
      a1 -= m[1] * x[5];
      a2 -= m[2] * x[6];
      a3 -= m[3] * x[7];
    }
    { const f32x4 m = *(const f32x4*)(mr + 8);
      a0 -= m[0] * x[8];
      a1 -= m[1] * x[9];
      a2 -= m[2] * x[10];
      a3 -= m[3] * x[11];
    }
    { const f32x4 m = *(const f32x4*)(mr + 12);
      a0 -= m[0] * x[12];
      a1 -= m[1] * x[13];
      a2 -= m[2] * x[14];
      a3 -= m[3] * x[15];
    }
    { const f32x4 m = *(const f32x4*)(mr + 16);
      a0 -= m[0] * x[16];
      a1 -= m[1] * x[17];
      a2 -= m[2] * x[18];
      a3 -= m[3] * x[19];
    }
    { const f32x4 m = *(const f32x4*)(mr + 20);
      a0 -= m[0] * x[20];
      a1 -= m[1] * x[21];
      a2 -= m[2] * x[22];
      a3 -= m[3] * x[23];
    }
    { const f32x4 m = *(const f32x4*)(mr + 24);
      a0 -= m[0] * x[24];
      a1 -= m[1] * x[25];
      a2 -= m[2] * x[26];
      a3 -= m[3] * x[27];
    }
    { const f32x4 m = *(const f32x4*)(mr + 28);
      a0 -= m[0] * x[28];
      a1 -= m[1] * x[29];
      a2 -= m[2] * x[30];
      a3 -= m[3] * x[31];
    }
    { const f32x4 m = *(const f32x4*)(mr + 32);
      a0 -= m[0] * x[32];
      a1 -= m[1] * x[33];
      a2 -= m[2] * x[34];
      a3 -= m[3] * x[35];
    }
    { const f32x4 m = *(const f32x4*)(mr + 36);
      a0 -= m[0] * x[36];
      a1 -= m[1] * x[37];
      a2 -= m[2] * x[38];
      a3 -= m[3] * x[39];
    }
    { const f32x4 m = *(const f32x4*)(mr + 40);
      a0 -= m[0] * x[40];
      a1 -= m[1] * x[41];
      a2 -= m[2] * x[42];
      a3 -= m[3] * x[43];
    }
    { const f32x4 m = *(const f32x4*)(mr + 44);
      a0 -= m[0] * x[44];
      a1 -= m[1] * x[45];
      a2 -= m[2] * x[46];
      a3 -= m[3] * x[47];
    }
    { const f32x4 m = *(const f32x4*)(mr + 48);
      a0 -= m[0] * x[48];
      a1 -= m[1] * x[49];
      a2 -= m[2] * x[50];
    }
    SOLVE_ROW_END(51)
    SOLVE_ROW_BEGIN(52)
    { const f32x4 m = *(const f32x4*)(mr + 0);
      a0 -= m[0] * x[0];
      a1 -= m[1] * x[1];
      a2 -= m[2] * x[2];
      a3 -= m[3] * x[3];
    }
    { const f32x4 m = *(const f32x4*)(mr + 4);
      a0 -= m[0] * x[4];
      a1 -= m[1] * x[5];
      a2 -= m[2] * x[6];
      a3 -= m[3] * x[7];
    }
    { const f32x4 m = *(const f32x4*)(mr + 8);
      a0 -= m[0] * x[8];
      a1 -= m[1] * x[9];
      a2 -= m[2] * x[10];
      a3 -= m[3] * x[11];
    }
    { const f32x4 m = *(const f32x4*)(mr + 12);
      a0 -= m[0] * x[12];
      a1 -= m[1] * x[13];
      a2 -= m[2] * x[14];
      a3 -= m[3] * x[15];
    }
    { const f32x4 m = *(const f32x4*)(mr + 16);
      a0 -= m[0] * x[16];
      a1 -= m[1] * x[17];
      a2 -= m[2] * x[18];
      a3 -= m[3] * x[19];
    }
    { const f32x4 m = *(const f32x4*)(mr + 20);
      a0 -= m[0] * x[20];
      a1 -= m[1] * x[21];
      a2 -= m[2] * x[22];
      a3 -= m[3] * x[23];
    }
    { const f32x4 m = *(const f32x4*)(mr + 24);
      a0 -= m[0] * x[24];
      a1 -= m[1] * x[25];
      a2 -= m[2] * x[26];
      a3 -= m[3] * x[27];
    }
    { const f32x4 m = *(const f32x4*)(mr + 28);
      a0 -= m[0] * x[28];
      a1 -= m[1] * x[29];
      a2 -= m[2] * x[30];
      a3 -= m[3] * x[31];
    }
    { const f32x4 m = *(const f32x4*)(mr + 32);
      a0 -= m[0] * x[32];
      a1 -= m[1] * x[33];
      a2 -= m[2] * x[34];
      a3 -= m[3] * x[35];
    }
    { const f32x4 m = *(const f32x4*)(mr + 36);
      a0 -= m[0] * x[36];
      a1 -= m[1] * x[37];
      a2 -= m[2] * x[38];
      a3 -= m[3] * x[39];
    }
    { const f32x4 m = *(const f32x4*)(mr + 40);
      a0 -= m[0] * x[40];
      a1 -= m[1] * x[41];
      a2 -= m[2] * x[42];
      a3 -= m[3] * x[43];
    }
    { const f32x4 m = *(const f32x4*)(mr + 44);
      a0 -= m[0] * x[44];
      a1 -= m[1] * x[45];
      a2 -= m[2] * x[46];
      a3 -= m[3] * x[47];
    }
    { const f32x4 m = *(const f32x4*)(mr + 48);
      a0 -= m[0] * x[48];
      a1 -= m[1] * x[49];
      a2 -= m[2] * x[50];
      a3 -= m[3] * x[51];
    }
    SOLVE_ROW_END(52)
    SOLVE_ROW_BEGIN(53)
    { const f32x4 m = *(const f32x4*)(mr + 0);
      a0 -= m[0] * x[0];
      a1 -= m[1] * x[1];
      a2 -= m[2] * x[2];
      a3 -= m[3] * x[3];
    }
    { const f32x4 m = *(const f32x4*)(mr + 4);
      a0 -= m[0] * x[4];
      a1 -= m[1] * x[5];
      a2 -= m[2] * x[6];
      a3 -= m[3] * x[7];
    }
    { const f32x4 m = *(const f32x4*)(mr + 8);
      a0 -= m[0] * x[8];
      a1 -= m[1] * x[9];
      a2 -= m[2] * x[10];
      a3 -= m[3] * x[11];
    }
    { const f32x4 m = *(const f32x4*)(mr + 12);
      a0 -= m[0] * x[12];
      a1 -= m[1] * x[13];
      a2 -= m[2] * x[14];
      a3 -= m[3] * x[15];
    }
    { const f32x4 m = *(const f32x4*)(mr + 16);
      a0 -= m[0] * x[16];
      a1 -= m[1] * x[17];
      a2 -= m[2] * x[18];
      a3 -= m[3] * x[19];
    }
    { const f32x4 m = *(const f32x4*)(mr + 20);
      a0 -= m[0] * x[20];
      a1 -= m[1] * x[21];
      a2 -= m[2] * x[22];
      a3 -= m[3] * x[23];
    }
    { const f32x4 m = *(const f32x4*)(mr + 24);
      a0 -= m[0] * x[24];
      a1 -= m[1] * x[25];
      a2 -= m[2] * x[26];
      a3 -= m[3] * x[27];
    }
    { const f32x4 m = *(const f32x4*)(mr + 28);
      a0 -= m[0] * x[28];
      a1 -= m[1] * x[29];
      a2 -= m[2] * x[30];
      a3 -= m[3] * x[31];
    }
    { const f32x4 m = *(const f32x4*)(mr + 32);
      a0 -= m[0] * x[32];
      a1 -= m[1] * x[33];
      a2 -= m[2] * x[34];
      a3 -= m[3] * x[35];
    }
    { const f32x4 m = *(const f32x4*)(mr + 36);
      a0 -= m[0] * x[36];
      a1 -= m[1] * x[37];
      a2 -= m[2] * x[38];
      a3 -= m[3] * x[39];
    }
    { const f32x4 m = *(const f32x4*)(mr + 40);
      a0 -= m[0] * x[40];
      a1 -= m[1] * x[41];
      a2 -= m[2] * x[42];
      a3 -= m[3] * x[43];
    }
    { const f32x4 m = *(const f32x4*)(mr + 44);
      a0 -= m[0] * x[44];
      a1 -= m[1] * x[45];
      a2 -= m[2] * x[46];
      a3 -= m[3] * x[47];
    }
    { const f32x4 m = *(const f32x4*)(mr + 48);
      a0 -= m[0] * x[48];
      a1 -= m[1] * x[49];
      a2 -= m[2] * x[50];
      a3 -= m[3] * x[51];
    }
    { const f32x4 m = *(const f32x4*)(mr + 52);
      a0 -= m[0] * x[52];
    }
    SOLVE_ROW_END(53)
    SOLVE_ROW_BEGIN(54)
    { const f32x4 m = *(const f32x4*)(mr + 0);
      a0 -= m[0] * x[0];
      a1 -= m[1] * x[1];
      a2 -= m[2] * x[2];
      a3 -= m[3] * x[3];
    }
    { const f32x4 m = *(const f32x4*)(mr + 4);
      a0 -= m[0] * x[4];
      a1 -= m[1] * x[5];
      a2 -= m[2] * x[6];
      a3 -= m[3] * x[7];
    }
    { const f32x4 m = *(const f32x4*)(mr + 8);
      a0 -= m[0] * x[8];
      a1 -= m[1] * x[9];
      a2 -= m[2] * x[10];
      a3 -= m[3] * x[11];
    }
    { const f32x4 m = *(const f32x4*)(mr + 12);
      a0 -= m[0] * x[12];
      a1 -= m[1] * x[13];
      a2 -= m[2] * x[14];
      a3 -= m[3] * x[15];
    }
    { const f32x4 m = *(const f32x4*)(mr + 16);
      a0 -= m[0] * x[16];
      a1 -= m[1] * x[17];
      a2 -= m[2] * x[18];
      a3 -= m[3] * x[19];
    }
    { const f32x4 m = *(const f32x4*)(mr + 20);
      a0 -= m[0] * x[20];
      a1 -= m[1] * x[21];
      a2 -= m[2] * x[22];
      a3 -= m[3] * x[23];
    }
    { const f32x4 m = *(const f32x4*)(mr + 24);
      a0 -= m[0] * x[24];
      a1 -= m[1] * x[25];
      a2 -= m[2] * x[26];
      a3 -= m[3] * x[27];
    }
    { const f32x4 m = *(const f32x4*)(mr + 28);
      a0 -= m[0] * x[28];
      a1 -= m[1] * x[29];
      a2 -= m[2] * x[30];
      a3 -= m[3] * x[31];
    }
    { const f32x4 m = *(const f32x4*)(mr + 32);
      a0 -= m[0] * x[32];
      a1 -= m[1] * x[33];
      a2 -= m[2] * x[34];
      a3 -= m[3] * x[35];
    }
    { const f32x4 m = *(const f32x4*)(mr + 36);
      a0 -= m[0] * x[36];
      a1 -= m[1] * x[37];
      a2 -= m[2] * x[38];
      a3 -= m[3] * x[39];
    }
    { const f32x4 m = *(const f32x4*)(mr + 40);
      a0 -= m[0] * x[40];
      a1 -= m[1] * x[41];
      a2 -= m[2] * x[42];
      a3 -= m[3] * x[43];
    }
    { const f32x4 m = *(const f32x4*)(mr + 44);
      a0 -= m[0] * x[44];
      a1 -= m[1] * x[45];
      a2 -= m[2] * x[46];
      a3 -= m[3] * x[47];
    }
    { const f32x4 m = *(const f32x4*)(mr + 48);
      a0 -= m[0] * x[48];
      a1 -= m[1] * x[49];
      a2 -= m[2] * x[50];
      a3 -= m[3] * x[51];
    }
    { const f32x4 m = *(const f32x4*)(mr + 52);
      a0 -= m[0] * x[52];
      a1 -= m[1] * x[53];
    }
    SOLVE_ROW_END(54)
    SOLVE_ROW_BEGIN(55)
    { const f32x4 m = *(const f32x4*)(mr + 0);
      a0 -= m[0] * x[0];
      a1 -= m[1] * x[1];
      a2 -= m[2] * x[2];
      a3 -= m[3] * x[3];
    }
    { const f32x4 m = *(const f32x4*)(mr + 4);
      a0 -= m[0] * x[4];
      a1 -= m[1] * x[5];
      a2 -= m[2] * x[6];
      a3 -= m[3] * x[7];
    }
    { const f32x4 m = *(const f32x4*)(mr + 8);
      a0 -= m[0] * x[8];
      a1 -= m[1] * x[9];
      a2 -= m[2] * x[10];
      a3 -= m[3] * x[11];
    }
    { const f32x4 m = *(const f32x4*)(mr + 12);
      a0 -= m[0] * x[12];
      a1 -= m[1] * x[13];
      a2 -= m[2] * x[14];
      a3 -= m[3] * x[15];
    }
    { const f32x4 m = *(const f32x4*)(mr + 16);
      a0 -= m[0] * x[16];
      a1 -= m[1] * x[17];
      a2 -= m[2] * x[18];
      a3 -= m[3] * x[19];
    }
    { const f32x4 m = *(const f32x4*)(mr + 20);
      a0 -= m[0] * x[20];
      a1 -= m[1] * x[21];
      a2 -= m[2] * x[22];
      a3 -= m[3] * x[23];
    }
    { const f32x4 m = *(const f32x4*)(mr + 24);
      a0 -= m[0] * x[24];
      a1 -= m[1] * x[25];
      a2 -= m[2] * x[26];
      a3 -= m[3] * x[27];
    }
    { const f32x4 m = *(const f32x4*)(mr + 28);
      a0 -= m[0] * x[28];
      a1 -= m[1] * x[29];
      a2 -= m[2] * x[30];
      a3 -= m[3] * x[31];
    }
    { const f32x4 m = *(const f32x4*)(mr + 32);
      a0 -= m[0] * x[32];
      a1 -= m[1] * x[33];
      a2 -= m[2] * x[34];
      a3 -= m[3] * x[35];
    }
    { const f32x4 m = *(const f32x4*)(mr + 36);
      a0 -= m[0] * x[36];
      a1 -= m[1] * x[37];
      a2 -= m[2] * x[38];
      a3 -= m[3] * x[39];
    }
    { const f32x4 m = *(const f32x4*)(mr + 40);
      a0 -= m[0] * x[40];
      a1 -= m[1] * x[41];
      a2 -= m[2] * x[42];
      a3 -= m[3] * x[43];
    }
    { const f32x4 m = *(const f32x4*)(mr + 44);
      a0 -= m[0] * x[44];
      a1 -= m[1] * x[45];
      a2 -= m[2] * x[46];
      a3 -= m[3] * x[47];
    }
    { const f32x4 m = *(const f32x4*)(mr + 48);
      a0 -= m[0] * x[48];
      a1 -= m[1] * x[49];
      a2 -= m[2] * x[50];
      a3 -= m[3] * x[51];
    }
    { const f32x4 m = *(const f32x4*)(mr + 52);
      a0 -= m[0] * x[52];
      a1 -= m[1] * x[53];
      a2 -= m[2] * x[54];
    }
    SOLVE_ROW_END(55)
    SOLVE_ROW_BEGIN(56)
    { const f32x4 m = *(const f32x4*)(mr + 0);
      a0 -= m[0] * x[0];
      a1 -= m[1] * x[1];
      a2 -= m[2] * x[2];
      a3 -= m[3] * x[3];
    }
    { const f32x4 m = *(const f32x4*)(mr + 4);
      a0 -= m[0] * x[4];
      a1 -= m[1] * x[5];
      a2 -= m[2] * x[6];
      a3 -= m[3] * x[7];
    }
    { const f32x4 m = *(const f32x4*)(mr + 8);
      a0 -= m[0] * x[8];
      a1 -= m[1] * x[9];
      a2 -= m[2] * x[10];
      a3 -= m[3] * x[11];
    }
    { const f32x4 m = *(const f32x4*)(mr + 12);
      a0 -= m[0] * x[12];
      a1 -= m[1] * x[13];
      a2 -= m[2] * x[14];
      a3 -= m[3] * x[15];
    }
    { const f32x4 m = *(const f32x4*)(mr + 16);
      a0 -= m[0] * x[16];
      a1 -= m[1] * x[17];
      a2 -= m[2] * x[18];
      a3 -= m[3] * x[19];
    }
    { const f32x4 m = *(const f32x4*)(mr + 20);
      a0 -= m[0] * x[20];
      a1 -= m[1] * x[21];
      a2 -= m[2] * x[22];
      a3 -= m[3] * x[23];
    }
    { const f32x4 m = *(const f32x4*)(mr + 24);
      a0 -= m[0] * x[24];
      a1 -= m[1] * x[25];
      a2 -= m[2] * x[26];
      a3 -= m[3] * x[27];
    }
    { const f32x4 m = *(const f32x4*)(mr + 28);
      a0 -= m[0] * x[28];
      a1 -= m[1] * x[29];
      a2 -= m[2] * x[30];
      a3 -= m[3] * x[31];
    }
    { const f32x4 m = *(const f32x4*)(mr + 32);
      a0 -= m[0] * x[32];
      a1 -= m[1] * x[33];
      a2 -= m[2] * x[34];
      a3 -= m[3] * x[35];
    }
    { const f32x4 m = *(const f32x4*)(mr + 36);
      a0 -= m[0] * x[36];
      a1 -= m[1] * x[37];
      a2 -= m[2] * x[38];
      a3 -= m[3] * x[39];
    }
    { const f32x4 m = *(const f32x4*)(mr + 40);
      a0 -= m[0] * x[40];
      a1 -= m[1] * x[41];
      a2 -= m[2] * x[42];
      a3 -= m[3] * x[43];
    }
    { const f32x4 m = *(const f32x4*)(mr + 44);
      a0 -= m[0] * x[44];
      a1 -= m[1] * x[45];
      a2 -= m[2] * x[46];
      a3 -= m[3] * x[47];
    }
    { const f32x4 m = *(const f32x4*)(mr + 48);
      a0 -= m[0] * x[48];
      a1 -= m[1] * x[49];
      a2 -= m[2] * x[50];
      a3 -= m[3] * x[51];
    }
    { const f32x4 m = *(const f32x4*)(mr + 52);
      a0 -= m[0] * x[52];
      a1 -= m[1] * x[53];
      a2 -= m[2] * x[54];
      a3 -= m[3] * x[55];
    }
    SOLVE_ROW_END(56)
    SOLVE_ROW_BEGIN(57)
    { const f32x4 m = *(const f32x4*)(mr + 0);
      a0 -= m[0] * x[0];
      a1 -= m[1] * x[1];
      a2 -= m[2] * x[2];
      a3 -= m[3] * x[3];
    }
    { const f32x4 m = *(const f32x4*)(mr + 4);
      a0 -= m[0] * x[4];
      a1 -= m[1] * x[5];
      a2 -= m[2] * x[6];
      a3 -= m[3] * x[7];
    }
    { const f32x4 m = *(const f32x4*)(mr + 8);
      a0 -= m[0] * x[8];
      a1 -= m[1] * x[9];
      a2 -= m[2] * x[10];
      a3 -= m[3] * x[11];
    }
    { const f32x4 m = *(const f32x4*)(mr + 12);
      a0 -= m[0] * x[12];
      a1 -= m[1] * x[13];
      a2 -= m[2] * x[14];
      a3 -= m[3] * x[15];
    }
    { const f32x4 m = *(const f32x4*)(mr + 16);
      a0 -= m[0] * x[16];
      a1 -= m[1] * x[17];
      a2 -= m[2] * x[18];
      a3 -= m[3] * x[19];
    }
    { const f32x4 m = *(const f32x4*)(mr + 20);
      a0 -= m[0] * x[20];
      a1 -= m[1] * x[21];
      a2 -= m[2] * x[22];
      a3 -= m[3] * x[23];
    }
    { const f32x4 m = *(const f32x4*)(mr + 24);
      a0 -= m[0] * x[24];
      a1 -= m[1] * x[25];
      a2 -= m[2] * x[26];
      a3 -= m[3] * x[27];
    }
    { const f32x4 m = *(const f32x4*)(mr + 28);
      a0 -= m[0] * x[28];
      a1 -= m[1] * x[29];
      a2 -= m[2] * x[30];
      a3 -= m[3] * x[31];
    }
    { const f32x4 m = *(const f32x4*)(mr + 32);
      a0 -= m[0] * x[32];
      a1 -= m[1] * x[33];
      a2 -= m[2] * x[34];
      a3 -= m[3] * x[35];
    }
    { const f32x4 m = *(const f32x4*)(mr + 36);
      a0 -= m[0] * x[36];
      a1 -= m[1] * x[37];
      a2 -= m[2] * x[38];
      a3 -= m[3] * x[39];
    }
    { const f32x4 m = *(const f32x4*)(mr + 40);
      a0 -= m[0] * x[40];
      a1 -= m[1] * x[41];
      a2 -= m[2] * x[42];
      a3 -= m[3] * x[43];
    }
    { const f32x4 m = *(const f32x4*)(mr + 44);
      a0 -= m[0] * x[44];
      a1 -= m[1] * x[45];
      a2 -= m[2] * x[46];
      a3 -= m[3] * x[47];
    }
    { const f32x4 m = *(const f32x4*)(mr + 48);
      a0 -= m[0] * x[48];
      a1 -= m[1] * x[49];
      a2 -= m[2] * x[50];
      a3 -= m[3] * x[51];
    }
    { const f32x4 m = *(const f32x4*)(mr + 52);
      a0 -= m[0] * x[52];
      a1 -= m[1] * x[53];
      a2 -= m[2] * x[54];
      a3 -= m[3] * x[55];
    }
    { const f32x4 m = *(const f32x4*)(mr + 56);
      a0 -= m[0] * x[56];
    }
    SOLVE_ROW_END(57)
    SOLVE_ROW_BEGIN(58)
    { const f32x4 m = *(const f32x4*)(mr + 0);
      a0 -= m[0] * x[0];
      a1 -= m[1] * x[1];
      a2 -= m[2] * x[2];
      a3 -= m[3] * x[3];
    }
    { const f32x4 m = *(const f32x4*)(mr + 4);
      a0 -= m[0] * x[4];
      a1 -= m[1] * x[5];
      a2 -= m[2] * x[6];
      a3 -= m[3] * x[7];
    }
    { const f32x4 m = *(const f32x4*)(mr + 8);
      a0 -= m[0] * x[8];
      a1 -= m[1] * x[9];
      a2 -= m[2] * x[10];
      a3 -= m[3] * x[11];
    }
    { const f32x4 m = *(const f32x4*)(mr + 12);
      a0 -= m[0] * x[12];
      a1 -= m[1] * x[13];
      a2 -= m[2] * x[14];
      a3 -= m[3] * x[15];
    }
    { const f32x4 m = *(const f32x4*)(mr + 16);
      a0 -= m[0] * x[16];
      a1 -= m[1] * x[17];
      a2 -= m[2] * x[18];
      a3 -= m[3] * x[19];
    }
    { const f32x4 m = *(const f32x4*)(mr + 20);
      a0 -= m[0] * x[20];
      a1 -= m[1] * x[21];
      a2 -= m[2] * x[22];
      a3 -= m[3] * x[23];
    }
    { const f32x4 m = *(const f32x4*)(mr + 24);
      a0 -= m[0] * x[24];
      a1 -= m[1] * x[25];
      a2 -= m[2] * x[26];
      a3 -= m[3] * x[27];
    }
    { const f32x4 m = *(const f32x4*)(mr + 28);
      a0 -= m[0] * x[28];
      a1 -= m[1] * x[29];
      a2 -= m[2] * x[30];
      a3 -= m[3] * x[31];
    }
    { const f32x4 m = *(const f32x4*)(mr + 32);
      a0 -= m[0] * x[32];
      a1 -= m[1] * x[33];
      a2 -= m[2] * x[34];
      a3 -= m[3] * x[35];
    }
    { const f32x4 m = *(const f32x4*)(mr + 36);
      a0 -= m[0] * x[36];
      a1 -= m[1] * x[37];
      a2 -= m[2] * x[38];
      a3 -= m[3] * x[39];
    }
    { const f32x4 m = *(const f32x4*)(mr + 40);
      a0 -= m[0] * x[40];
      a1 -= m[1] * x[41];
      a2 -= m[2] * x[42];
      a3 -= m[3] * x[43];
    }
    { const f32x4 m = *(const f32x4*)(mr + 44);
      a0 -= m[0] * x[44];
      a1 -= m[1] * x[45];
      a2 -= m[2] * x[46];
      a3 -= m[3] * x[47];
    }
    { const f32x4 m = *(const f32x4*)(mr + 48);
      a0 -= m[0] * x[48];
      a1 -= m[1] * x[49];
      a2 -= m[2] * x[50];
      a3 -= m[3] * x[51];
    }
    { const f32x4 m = *(const f32x4*)(mr + 52);
      a0 -= m[0] * x[52];
      a1 -= m[1] * x[53];
      a2 -= m[2] * x[54];
      a3 -= m[3] * x[55];
    }
    { const f32x4 m = *(const f32x4*)(mr + 56);
      a0 -= m[0] * x[56];
      a1 -= m[1] * x[57];
    }
    SOLVE_ROW_END(58)
    SOLVE_ROW_BEGIN(59)
    { const f32x4 m = *(const f32x4*)(mr + 0);
      a0 -= m[0] * x[0];
      a1 -= m[1] * x[1];
      a2 -= m[2] * x[2];
      a3 -= m[3] * x[3];
    }
    { const f32x4 m = *(const f32x4*)(mr + 4);
      a0 -= m[0] * x[4];
      a1 -= m[1] * x[5];
      a2 -= m[2] * x[6];
      a3 -= m[3] * x[7];
    }
    { const f32x4 m = *(const f32x4*)(mr + 8);
      a0 -= m[0] * x[8];
      a1 -= m[1] * x[9];
      a2 -= m[2] * x[10];
      a3 -= m[3] * x[11];
    }
    { const f32x4 m = *(const f32x4*)(mr + 12);
      a0 -= m[0] * x[12];
      a1 -= m[1] * x[13];
      a2 -= m[2] * x[14];
      a3 -= m[3] * x[15];
    }
    { const f32x4 m = *(const f32x4*)(mr + 16);
      a0 -= m[0] * x[16];
      a1 -= m[1] * x[17];
      a2 -= m[2] * x[18];
      a3 -= m[3] * x[19];
    }
    { const f32x4 m = *(const f32x4*)(mr + 20);
      a0 -= m[0] * x[20];
      a1 -= m[1] * x[21];
      a2 -= m[2] * x[22];
      a3 -= m[3] * x[23];
    }
    { const f32x4 m = *(const f32x4*)(mr + 24);
      a0 -= m[0] * x[24];
      a1 -= m[1] * x[25];
      a2 -= m[2] * x[26];
      a3 -= m[3] * x[27];
    }
    { const f32x4 m = *(const f32x4*)(mr + 28);
      a0 -= m[0] * x[28];
      a1 -= m[1] * x[29];
      a2 -= m[2] * x[30];
      a3 -= m[3] * x[31];
    }
    { const f32x4 m = *(const f32x4*)(mr + 32);
      a0 -= m[0] * x[32];
      a1 -= m[1] * x[33];
      a2 -= m[2] * x[34];
      a3 -= m[3] * x[35];
    }
    { const f32x4 m = *(const f32x4*)(mr + 36);
      a0 -= m[0] * x[36];
      a1 -= m[1] * x[37];
      a2 -= m[2] * x[38];
      a3 -= m[3] * x[39];
    }
    { const f32x4 m = *(const f32x4*)(mr + 40);
      a0 -= m[0] * x[40];
      a1 -= m[1] * x[41];
      a2 -= m[2] * x[42];
      a3 -= m[3] * x[43];
    }
    { const f32x4 m = *(const f32x4*)(mr + 44);
      a0 -= m[0] * x[44];
      a1 -= m[1] * x[45];
      a2 -= m[2] * x[46];
      a3 -= m[3] * x[47];
    }
    { const f32x4 m = *(const f32x4*)(mr + 48);
      a0 -= m[0] * x[48];
      a1 -= m[1] * x[49];
      a2 -= m[2] * x[50];
      a3 -= m[3] * x[51];
    }
    { const f32x4 m = *(const f32x4*)(mr + 52);
      a0 -= m[0] * x[52];
      a1 -= m[1] * x[53];
      a2 -= m[2] * x[54];
      a3 -= m[3] * x[55];
    }
    { const f32x4 m = *(const f32x4*)(mr + 56);
      a0 -= m[0] * x[56];
      a1 -= m[1] * x[57];
      a2 -= m[2] * x[58];
    }
    SOLVE_ROW_END(59)
    SOLVE_ROW_BEGIN(60)
    { const f32x4 m = *(const f32x4*)(mr + 0);
      a0 -= m[0] * x[0];
      a1 -= m[1] * x[1];
      a2 -= m[2] * x[2];
      a3 -= m[3] * x[3];
    }
    { const f32x4 m = *(const f32x4*)(mr + 4);
      a0 -= m[0] * x[4];
      a1 -= m[1] * x[5];
      a2 -= m[2] * x[6];
      a3 -= m[3] * x[7];
    }
    { const f32x4 m = *(const f32x4*)(mr + 8);
      a0 -= m[0] * x[8];
      a1 -= m[1] * x[9];
      a2 -= m[2] * x[10];
      a3 -= m[3] * x[11];
    }
    { const f32x4 m = *(const f32x4*)(mr + 12);
      a0 -= m[0] * x[12];
      a1 -= m[1] * x[13];
      a2 -= m[2] * x[14];
      a3 -= m[3] * x[15];
    }
    { const f32x4 m = *(const f32x4*)(mr + 16);
      a0 -= m[0] * x[16];
      a1 -= m[1] * x[17];
      a2 -= m[2] * x[18];
      a3 -= m[3] * x[19];
    }
    { const f32x4 m = *(const f32x4*)(mr + 20);
      a0 -= m[0] * x[20];
      a1 -= m[1] * x[21];
      a2 -= m[2] * x[22];
      a3 -= m[3] * x[23];
    }
    { const f32x4 m = *(const f32x4*)(mr + 24);
      a0 -= m[0] * x[24];
      a1 -= m[1] * x[25];
      a2 -= m[2] * x[26];
      a3 -= m[3] * x[27];
    }
    { const f32x4 m = *(const f32x4*)(mr + 28);
      a0 -= m[0] * x[28];
      a1 -= m[1] * x[29];
      a2 -= m[2] * x[30];
      a3 -= m[3] * x[31];
    }
    { const f32x4 m = *(const f32x4*)(mr + 32);
      a0 -= m[0] * x[32];
      a1 -= m[1] * x[33];
      a2 -= m[2] * x[34];
      a3 -= m[3] * x[35];
    }
    { const f32x4 m = *(const f32x4*)(mr + 36);
      a0 -= m[0] * x[36];
      a1 -= m[1] * x[37];
      a2 -= m[2] * x[38];
      a3 -= m[3] * x[39];
    }
    { const f32x4 m = *(const f32x4*)(mr + 40);
      a0 -= m[0] * x[40];
      a1 -= m[1] * x[41];
      a2 -= m[2] * x[42];
      a3 -= m[3] * x[43];
    }
    { const f32x4 m = *(const f32x4*)(mr + 44);
      a0 -= m[0] * x[44];
      a1 -= m[1] * x[45];
      a2 -= m[2] * x[46];
      a3 -= m[3] * x[47];
    }
    { const f32x4 m = *(const f32x4*)(mr + 48);
      a0 -= m[0] * x[48];
      a1 -= m[1] * x[49];
      a2 -= m[2] * x[50];
      a3 -= m[3] * x[51];
    }
    { const f32x4 m = *(const f32x4*)(mr + 52);
      a0 -= m[0] * x[52];
      a1 -= m[1] * x[53];
      a2 -= m[2] * x[54];
      a3 -= m[3] * x[55];
    }
    { const f32x4 m = *(const f32x4*)(mr + 56);
      a0 -= m[0] * x[56];
      a1 -= m[1] * x[57];
      a2 -= m[2] * x[58];
      a3 -= m[3] * x[59];
    }
    SOLVE_ROW_END(60)
    SOLVE_ROW_BEGIN(61)
    { const f32x4 m = *(const f32x4*)(mr + 0);
      a0 -= m[0] * x[0];
      a1 -= m[1] * x[1];
      a2 -= m[2] * x[2];
      a3 -= m[3] * x[3];
    }
    { const f32x4 m = *(const f32x4*)(mr + 4);
      a0 -= m[0] * x[4];
      a1 -= m[1] * x[5];
      a2 -= m[2] * x[6];
      a3 -= m[3] * x[7];
    }
    { const f32x4 m = *(const f32x4*)(mr + 8);
      a0 -= m[0] * x[8];
      a1 -= m[1] * x[9];
      a2 -= m[2] * x[10];
      a3 -= m[3] * x[11];
    }
    { const f32x4 m = *(const f32x4*)(mr + 12);
      a0 -= m[0] * x[12];
      a1 -= m[1] * x[13];
      a2 -= m[2] * x[14];
      a3 -= m[3] * x[15];
    }
    { const f32x4 m = *(const f32x4*)(mr + 16);
      a0 -= m[0] * x[16];
      a1 -= m[1] * x[17];
      a2 -= m[2] * x[18];
      a3 -= m[3] * x[19];
    }
    { const f32x4 m = *(const f32x4*)(mr + 20);
      a0 -= m[0] * x[20];
      a1 -= m[1] * x[21];
      a2 -= m[2] * x[22];
      a3 -= m[3] * x[23];
    }
    { const f32x4 m = *(const f32x4*)(mr + 24);
      a0 -= m[0] * x[24];
      a1 -= m[1] * x[25];
      a2 -= m[2] * x[26];
      a3 -= m[3] * x[27];
    }
    { const f32x4 m = *(const f32x4*)(mr + 28);
      a0 -= m[0] * x[28];
      a1 -= m[1] * x[29];
      a2 -= m[2] * x[30];
      a3 -= m[3] * x[31];
    }
    { const f32x4 m = *(const f32x4*)(mr + 32);
      a0 -= m[0] * x[32];
      a1 -= m[1] * x[33];
      a2 -= m[2] * x[34];
      a3 -= m[3] * x[35];
    }
    { const f32x4 m = *(const f32x4*)(mr + 36);
      a0 -= m[0] * x[36];
      a1 -= m[1] * x[37];
      a2 -= m[2] * x[38];
      a3 -= m[3] * x[39];
    }
    { const f32x4 m = *(const f32x4*)(mr + 40);
      a0 -= m[0] * x[40];
      a1 -= m[1] * x[41];
      a2 -= m[2] * x[42];
      a3 -= m[3] * x[43];
    }
    { const f32x4 m = *(const f32x4*)(mr + 44);
      a0 -= m[0] * x[44];
      a1 -= m[1] * x[45];
      a2 -= m[2] * x[46];
      a3 -= m[3] * x[47];
    }
    { const f32x4 m = *(const f32x4*)(mr + 48);
      a0 -= m[0] * x[48];
      a1 -= m[1] * x[49];
      a2 -= m[2] * x[50];
      a3 -= m[3] * x[51];
    }
    { const f32x4 m = *(const f32x4*)(mr + 52);
      a0 -= m[0] * x[52];
      a1 -= m[1] * x[53];
      a2 -= m[2] * x[54];
      a3 -= m[3] * x[55];
    }
    { const f32x4 m = *(const f32x4*)(mr + 56);
      a0 -= m[0] * x[56];
      a1 -= m[1] * x[57];
      a2 -= m[2] * x[58];
      a3 -= m[3] * x[59];
    }
    { const f32x4 m = *(const f32x4*)(mr + 60);
      a0 -= m[0] * x[60];
    }
    SOLVE_ROW_END(61)
    SOLVE_ROW_BEGIN(62)
    { const f32x4 m = *(const f32x4*)(mr + 0);
      a0 -= m[0] * x[0];
      a1 -= m[1] * x[1];
      a2 -= m[2] * x[2];
      a3 -= m[3] * x[3];
    }
    { const f32x4 m = *(const f32x4*)(mr + 4);
      a0 -= m[0] * x[4];
      a1 -= m[1] * x[5];
      a2 -= m[2] * x[6];
      a3 -= m[3] * x[7];
    }
    { const f32x4 m = *(const f32x4*)(mr + 8);
      a0 -= m[0] * x[8];
      a1 -= m[1] * x[9];
      a2 -= m[2] * x[10];
      a3 -= m[3] * x[11];
    }
    { const f32x4 m = *(const f32x4*)(mr + 12);
      a0 -= m[0] * x[12];
      a1 -= m[1] * x[13];
      a2 -= m[2] * x[14];
      a3 -= m[3] * x[15];
    }
    { const f32x4 m = *(const f32x4*)(mr + 16);
      a0 -= m[0] * x[16];
      a1 -= m[1] * x[17];
      a2 -= m[2] * x[18];
      a3 -= m[3] * x[19];
    }
    { const f32x4 m = *(const f32x4*)(mr + 20);
      a0 -= m[0] * x[20];
      a1 -= m[1] * x[21];
      a2 -= m[2] * x[22];
      a3 -= m[3] * x[23];
    }
    { const f32x4 m = *(const f32x4*)(mr + 24);
      a0 -= m[0] * x[24];
      a1 -= m[1] * x[25];
      a2 -= m[2] * x[26];
      a3 -= m[3] * x[27];
    }
    { const f32x4 m = *(const f32x4*)(mr + 28);
      a0 -= m[0] * x[28];
      a1 -= m[1] * x[29];
      a2 -= m[2] * x[30];
      a3 -= m[3] * x[31];
    }
    { const f32x4 m = *(const f32x4*)(mr + 32);
      a0 -= m[0] * x[32];
      a1 -= m[1] * x[33];
      a2 -= m[2] * x[34];
      a3 -= m[3] * x[35];
    }
    { const f32x4 m = *(const f32x4*)(mr + 36);
      a0 -= m[0] * x[36];
      a1 -= m[1] * x[37];
      a2 -= m[2] * x[38];
      a3 -= m[3] * x[39];
    }
    { const f32x4 m = *(const f32x4*)(mr + 40);
      a0 -= m[0] * x[40];
      a1 -= m[1] * x[41];
      a2 -= m[2] * x[42];
      a3 -= m[3] * x[43];
    }
    { const f32x4 m = *(const f32x4*)(mr + 44);
      a0 -= m[0] * x[44];
      a1 -= m[1] * x[45];
      a2 -= m[2] * x[46];
      a3 -= m[3] * x[47];
    }
    { const f32x4 m = *(const f32x4*)(mr + 48);
      a0 -= m[0] * x[48];
      a1 -= m[1] * x[49];
      a2 -= m[2] * x[50];
      a3 -= m[3] * x[51];
    }
    { const f32x4 m = *(const f32x4*)(mr + 52);
      a0 -= m[0] * x[52];
      a1 -= m[1] * x[53];
      a2 -= m[2] * x[54];
      a3 -= m[3] * x[55];
    }
    { const f32x4 m = *(const f32x4*)(mr + 56);
      a0 -= m[0] * x[56];
      a1 -= m[1] * x[57];
      a2 -= m[2] * x[58];
      a3 -= m[3] * x[59];
    }
    { const f32x4 m = *(const f32x4*)(mr + 60);
      a0 -= m[0] * x[60];
      a1 -= m[1] * x[61];
    }
    SOLVE_ROW_END(62)
    SOLVE_ROW_BEGIN(63)
    { const f32x4 m = *(const f32x4*)(mr + 0);
      a0 -= m[0] * x[0];
      a1 -= m[1] * x[1];
      a2 -= m[2] * x[2];
      a3 -= m[3] * x[3];
    }
    { const f32x4 m = *(const f32x4*)(mr + 4);
      a0 -= m[0] * x[4];
      a1 -= m[1] * x[5];
      a2 -= m[2] * x[6];
      a3 -= m[3] * x[7];
    }
    { const f32x4 m = *(const f32x4*)(mr + 8);
      a0 -= m[0] * x[8];
      a1 -= m[1] * x[9];
      a2 -= m[2] * x[10];
      a3 -= m[3] * x[11];
    }
    { const f32x4 m = *(const f32x4*)(mr + 12);
      a0 -= m[0] * x[12];
      a1 -= m[1] * x[13];
      a2 -= m[2] * x[14];
      a3 -= m[3] * x[15];
    }
    { const f32x4 m = *(const f32x4*)(mr + 16);
      a0 -= m[0] * x[16];
      a1 -= m[1] * x[17];
      a2 -= m[2] * x[18];
      a3 -= m[3] * x[19];
    }
    { const f32x4 m = *(const f32x4*)(mr + 20);
      a0 -= m[0] * x[20];
      a1 -= m[1] * x[21];
      a2 -= m[2] * x[22];
      a3 -= m[3] * x[23];
    }
    { const f32x4 m = *(const f32x4*)(mr + 24);
      a0 -= m[0] * x[24];
      a1 -= m[1] * x[25];
      a2 -= m[2] * x[26];
      a3 -= m[3] * x[27];
    }
    { const f32x4 m = *(const f32x4*)(mr + 28);
      a0 -= m[0] * x[28];
      a1 -= m[1] * x[29];
      a2 -= m[2] * x[30];
      a3 -= m[3] * x[31];
    }
    { const f32x4 m = *(const f32x4*)(mr + 32);
      a0 -= m[0] * x[32];
      a1 -= m[1] * x[33];
      a2 -= m[2] * x[34];
      a3 -= m[3] * x[35];
    }
    { const f32x4 m = *(const f32x4*)(mr + 36);
      a0 -= m[0] * x[36];
      a1 -= m[1] * x[37];
      a2 -= m[2] * x[38];
      a3 -= m[3] * x[39];
    }
    { const f32x4 m = *(const f32x4*)(mr + 40);
      a0 -= m[0] * x[40];
      a1 -= m[1] * x[41];
      a2 -= m[2] * x[42];
      a3 -= m[3] * x[43];
    }
    { const f32x4 m = *(const f32x4*)(mr + 44);
      a0 -= m[0] * x[44];
      a1 -= m[1] * x[45];
      a2 -= m[2] * x[46];
      a3 -= m[3] * x[47];
    }
    { const f32x4 m = *(const f32x4*)(mr + 48);
      a0 -= m[0] * x[48];
      a1 -= m[1] * x[49];
      a2 -= m[2] * x[50];
      a3 -= m[3] * x[51];
    }
    { const f32x4 m = *(const f32x4*)(mr + 52);
      a0 -= m[0] * x[52];
      a1 -= m[1] * x[53];
      a2 -= m[2] * x[54];
      a3 -= m[3] * x[55];
    }
    { const f32x4 m = *(const f32x4*)(mr + 56);
      a0 -= m[0] * x[56];
      a1 -= m[1] * x[57];
      a2 -= m[2] * x[58];
      a3 -= m[3] * x[59];
    }
    { const f32x4 m = *(const f32x4*)(mr + 60);
      a0 -= m[0] * x[60];
      a1 -= m[1] * x[61];
      a2 -= m[2] * x[62];
    }
    SOLVE_ROW_END(63)
    if (isw) { bf16_t* dW = c.W<bf16_t>(WS_DW);
#pragma unroll
        for (int i = 0; i < 64; ++i) dW[(ch * 64 + i) * 128 + col] = f2bf(x[i]);
    } else { bf16_t* dUT = c.W<bf16_t>(WS_DUT);
#pragma unroll
        for (int l0 = 0; l0 < 64; l0 += 8) { u32x4 a; a.x = pk2(x[l0], x[l0 + 1]); a.y = pk2(x[l0 + 2], x[l0 + 3]); a.z = pk2(x[l0 + 4], x[l0 + 5]); a.w = pk2(x[l0 + 6], x[l0 + 7]);
            *(u32x4*)(dUT + (ch * 128 + col) * 64 + l0) = a; } }
}

__device__ void ssd_mm(const Ctx& c, int ck, int g, int lb) {
    const bf16_t* sB = c.W<bf16_t>(WS_SB); const bf16_t* sC = c.W<bf16_t>(WS_SC); const float* sAcs = c.W<float>(WS_SACS); bf16_t* sMm = c.W<bf16_t>(WS_SMM);
    const int r = c.r, q = c.q, t0 = ck * 64;
    f32x4 cb[4];
#pragma unroll
    for (int sb = 0; sb < 4; ++sb) { f32x4 a = (f32x4){0.f, 0.f, 0.f, 0.f};
#pragma unroll
        for (int k0 = 0; k0 < 128; k0 += 32)
            a = mfma16(ldfrag(sB + (size_t)(t0 + sb * 16 + r) * 256 + g * 128 + k0 + q * 8), ldfrag(sC + (size_t)(t0 + lb * 16 + r) * 256 + g * 128 + k0 + q * 8), a);
        cb[sb] = a; }
    const int l = lb * 16 + r;
    for (int hh = 0; hh < 8; ++hh) { const int h = g * 8 + hh; const float* ac = sAcs + (size_t)(ck * 16 + h) * 64; const float al = ac[l];
#pragma unroll
        for (int sb = 0; sb < 4; ++sb) { const f32x4 as = *(const f32x4*)(ac + sb * 16 + 4 * q); f32x4 o;
#pragma unroll
            for (int j = 0; j < 4; ++j) { const int s = sb * 16 + 4 * q + j; o[j] = (s <= l) ? cb[sb][j] * __expf(al - as[j]) : 0.f; }
            *(u32x2*)(sMm + ((size_t)(ck * 16 + h) * 64 + l) * 64 + sb * 16 + 4 * q) = pk4(o); } }
}
__device__ void ssd_s1(const Ctx& c, int ck, int h) {
    const bf16_t* sXw = c.W<bf16_t>(WS_SXW); const bf16_t* sBT = c.W<bf16_t>(WS_SBT); bf16_t* sSt = c.W<bf16_t>(WS_SST);
    const int r = c.r, q = c.q, g = h >> 3; const size_t chh = (size_t)(ck * 16 + h);
    bf16x8 xw[4][2];
#pragma unroll
    for (int pb = 0; pb < 4; ++pb)
#pragma unroll
        for (int kk = 0; kk < 2; ++kk) xw[pb][kk] = ldfrag(sXw + (chh * 64 + pb * 16 + r) * 64 + kk * 32 + q * 8);
#pragma unroll
    for (int nb = 0; nb < 8; ++nb) { bf16x8 bt[2];
#pragma unroll
        for (int kk = 0; kk < 2; ++kk) bt[kk] = ldfrag(sBT + ((size_t)(ck * 2 + g) * 128 + nb * 16 + r) * 64 + kk * 32 + q * 8);
#pragma unroll
        for (int pb = 0; pb < 4; ++pb) { f32x4 a = (f32x4){0.f, 0.f, 0.f, 0.f};
#pragma unroll
            for (int kk = 0; kk < 2; ++kk) a = mfma16(bt[kk], xw[pb][kk], a);
            *(u32x2*)(sSt + (chh * 64 + pb * 16 + r) * 128 + nb * 16 + 4 * q) = pk4(a); } }
}
__device__ void gla_attn(const Ctx& c, int ck, int h, int ib) {
    const bf16_t* gQg = c.W<bf16_t>(WS_GQG); const bf16_t* gKn = c.W<bf16_t>(WS_GKN); bf16_t* gAtt = c.W<bf16_t>(WS_GATT);
    const int r = c.r, q = c.q; const size_t chh = (size_t)(ck * 4 + h); const int i = ib * 16 + r;
#pragma unroll
    for (int jb = 0; jb < 4; ++jb) { f32x4 a = (f32x4){0.f, 0.f, 0.f, 0.f};
        if (jb <= ib) {
#pragma unroll
            for (int k0 = 0; k0 < 128; k0 += 32)
                a = mfma16(ldfrag(gKn + (chh * 64 + jb * 16 + r) * 128 + k0 + q * 8), ldfrag(gQg + (chh * 64 + i) * 128 + k0 + q * 8), a);
        }
#pragma unroll
        for (int j = 0; j < 4; ++j) { const int jj = jb * 16 + 4 * q + j; if (jj > i) a[j] = 0.f; }
        *(u32x2*)(gAtt + (chh * 64 + i) * 64 + jb * 16 + 4 * q) = pk4(a); }
}
__device__ void gla_g1(const Ctx& c, int ck, int h, int vq) {
    const bf16_t* gVT = c.W<bf16_t>(WS_GVT); const bf16_t* gKnT = c.W<bf16_t>(WS_GKNT); bf16_t* gSt = c.W<bf16_t>(WS_GST); const float* gDec = c.W<float>(WS_GDEC);
    const int r = c.r, q = c.q; const size_t chh = (size_t)(ck * 4 + h);
    bf16x8 vt[4][2];
#pragma unroll
    for (int vb = 0; vb < 4; ++vb)
#pragma unroll
        for (int kk = 0; kk < 2; ++kk) vt[vb][kk] = ldfrag(gVT + (chh * 256 + (vq * 4 + vb) * 16 + r) * 64 + kk * 32 + q * 8);
#pragma unroll
    for (int kb = 0; kb < 8; ++kb) { bf16x8 kt[2];
#pragma unroll
        for (int kk = 0; kk < 2; ++kk) kt[kk] = ldfrag(gKnT + (chh * 128 + kb * 16 + r) * 64 + kk * 32 + q * 8);
        const f32x4 d = *(const f32x4*)(gDec + (size_t)ck * 512 + h * 128 + kb * 16 + 4 * q);
#pragma unroll
        for (int vb = 0; vb < 4; ++vb) { f32x4 a = (f32x4){0.f, 0.f, 0.f, 0.f};
#pragma unroll
            for (int kk = 0; kk < 2; ++kk) a = mfma16(kt[kk], vt[vb][kk], a);
            a = a * d;
            *(u32x2*)(gSt + (chh * 256 + (vq * 4 + vb) * 16 + r) * 128 + kb * 16 + 4 * q) = pk4(a); } }
}

__device__ void scan_ssd(const Ctx& c, int idx) {
    bf16_t* sSt = c.W<bf16_t>(WS_SST); const float* sAcs = c.W<float>(WS_SACS);
    const size_t e4 = (size_t)idx * 4; const int h = (int)(e4 >> 13);
    f32x4 S = (f32x4){0.f, 0.f, 0.f, 0.f};
#pragma unroll 4
    for (int ck = 0; ck < NCH; ++ck) { u32x2* ad = (u32x2*)(sSt + (size_t)ck * 131072 + e4);
        const f32x4 st = up4(__builtin_nontemporal_load(ad)); const float d = __expf(sAcs[(size_t)(ck * 16 + h) * 64 + 63]);
        __builtin_nontemporal_store(pk4(S), ad); S = S * d + st; }
}
__device__ void scan_gla(const Ctx& c, int idx) {
    bf16_t* gSt = c.W<bf16_t>(WS_GST); const float* gDec = c.W<float>(WS_GDEC);
    const size_t e4 = (size_t)idx * 4; const int h = (int)(e4 >> 15), k4 = (int)(e4 & 127);
    f32x4 S = (f32x4){0.f, 0.f, 0.f, 0.f};
#pragma unroll 4
    for (int ck = 0; ck < NCH; ++ck) { u32x2* ad = (u32x2*)(gSt + (size_t)ck * 131072 + e4);
        const f32x4 st = up4(__builtin_nontemporal_load(ad)); const f32x4 d = *(const f32x4*)(gDec + (size_t)ck * 512 + h * 128 + k4);
        __builtin_nontemporal_store(pk4(S), ad); S = S * d + st; }
}
struct DnStage { bf16x8 f[4]; u32x2 u; float gl; };
__device__ __forceinline__ void dn_stage_load(DnStage& S, const bf16_t* dW, const bf16_t* dUT, const bf16_t* dKdT, const float* dGl, int ck, int h, int vs, int wave, int r, int q) {
    const int cc = ck < NCH ? ck : NCH - 1; const size_t ch = (size_t)(cc * 8 + h);
    if (wave < 4) {
#pragma unroll
        for (int kk = 0; kk < 4; ++kk) S.f[kk] = ldfrag(dW + (ch * 64 + wave * 16 + r) * 128 + kk * 32 + q * 8);
        S.u = *(const u32x2*)(dUT + (ch * 128 + vs * 16 + r) * 64 + wave * 16 + 4 * q);
    } else {
#pragma unroll
        for (int t = 0; t < 2; ++t)
#pragma unroll
            for (int kk = 0; kk < 2; ++kk) S.f[t * 2 + kk] = ldfrag(dKdT + (ch * 128 + ((wave - 4) * 2 + t) * 16 + r) * 64 + kk * 32 + q * 8);
        S.gl = dGl[ch];
    }
}
__device__ __forceinline__ void dn_step(const DnStage& S, f32x4 (&Sacc)[2], bf16_t* ST, bf16_t* VN, bf16_t* dVnT, bf16_t* dST, int ck, int h, int vs, int wave, int r, int q) {
    const size_t ch = (size_t)(ck * 8 + h);
    if (wave < 4) {
        bf16x8 sf[4];
#pragma unroll
        for (int kk = 0; kk < 4; ++kk) sf[kk] = *(const bf16x8*)(ST + r * 136 + kk * 32 + q * 8);
        f32x4 a = (f32x4){0.f, 0.f, 0.f, 0.f};
#pragma unroll
        for (int kk = 0; kk < 4; ++kk) a = mfma16(S.f[kk], sf[kk], a);
        const f32x4 vn = up4(S.u) - a; const u32x2 pv = pk4(vn);
        *(u32x2*)(VN + r * 72 + wave * 16 + 4 * q) = pv;
        *(u32x2*)(dVnT + (ch * 128 + vs * 16 + r) * 64 + wave * 16 + 4 * q) = pv;
    }
    asm volatile("s_waitcnt lgkmcnt(0)" ::: "memory"); __builtin_amdgcn_s_barrier(); asm volatile("" ::: "memory");
    if (wave >= 4) {
        bf16x8 vf[2];
#pragma unroll
        for (int kk = 0; kk < 2; ++kk) vf[kk] = *(const bf16x8*)(VN + r * 72 + kk * 32 + q * 8);
#pragma unroll
        for (int t = 0; t < 2; ++t) { const int kb = (wave - 4) * 2 + t;
            f32x4 a = Sacc[t] * S.gl;
#pragma unroll
            for (int kk = 0; kk < 2; ++kk) a = mfma16(S.f[t * 2 + kk], vf[kk], a);
            Sacc[t] = a; const u32x2 ps = pk4(a);
            *(u32x2*)(ST + r * 136 + kb * 16 + 4 * q) = ps;
            if (ck + 1 < NCH) *(u32x2*)(dST + (((size_t)(ck + 1) * 8 + h) * 128 + vs * 16 + r) * 128 + kb * 16 + 4 * q) = ps; }
    }
    asm volatile("s_waitcnt lgkmcnt(0)" ::: "memory"); __builtin_amdgcn_s_barrier(); asm volatile("" ::: "memory");
}
__device__ void dn_seq(const Ctx& c, int h, int vs) {
    const bf16_t* dW = c.W<bf16_t>(WS_DW); const bf16_t* dUT = c.W<bf16_t>(WS_DUT); const bf16_t* dKdT = c.W<bf16_t>(WS_DKDT); const float* dGl = c.W<float>(WS_DGL);
    bf16_t* dVnT = c.W<bf16_t>(WS_DVNT); bf16_t* dST = c.W<bf16_t>(WS_DST);
    bf16_t* ST = (bf16_t*)c.ldsf; bf16_t* VN = ST + 16 * 136;
    const int wave = c.wave, r = c.r, q = c.q;
    f32x4 Sacc[2]; Sacc[0] = (f32x4){0.f, 0.f, 0.f, 0.f}; Sacc[1] = Sacc[0];
    __syncthreads();
    { u32x2 z; z.x = 0u; z.y = 0u; *(u32x2*)(ST + r * 136 + wave * 16 + 4 * q) = z;
      *(u32x2*)(dST + ((size_t)h * 128 + vs * 16 + r) * 128 + wave * 16 + 4 * q) = z; }
    __syncthreads();
    DnStage s0, s1, s2, s3, s4, s5;
#define DL(S, cc) dn_stage_load(S, dW, dUT, dKdT, dGl, cc, h, vs, wave, r, q)
#define DS(S, cc) dn_step(S, Sacc, ST, VN, dVnT, dST, cc, h, vs, wave, r, q)
    DL(s0, 0); DL(s1, 1); DL(s2, 2); DL(s3, 3); DL(s4, 4);
    for (int ck = 0; ck < 126; ck += 6) {
        DL(s5, ck + 5);  DS(s0, ck);
        DL(s0, ck + 6);  DS(s1, ck + 1);
        DL(s1, ck + 7);  DS(s2, ck + 2);
        DL(s2, ck + 8);  DS(s3, ck + 3);
        DL(s3, ck + 9);  DS(s4, ck + 4);
        DL(s4, ck + 10); DS(s5, ck + 5);
    }
    DS(s0, 126); DS(s1, 127);
#undef DL
#undef DS
}

__device__ void dn_d3(const Ctx& c, int ck, int h, int ib) {
    const bf16_t* proj = c.W<bf16_t>(WS_PROJ);
    const bf16_t* dQg = c.W<bf16_t>(WS_DQG); const bf16_t* dAtt = c.W<bf16_t>(WS_DATT); const bf16_t* dST = c.W<bf16_t>(WS_DST); const bf16_t* dVnT = c.W<bf16_t>(WS_DVNT);
    bf16_t* y = c.W<bf16_t>(WS_YBR);
    const int r = c.r, q = c.q, i = ib * 16 + r, t = ck * 64 + i; const size_t ch = (size_t)(ck * 8 + h);
    bf16x8 bq[4], ba[2];
#pragma unroll
    for (int kk = 0; kk < 4; ++kk) bq[kk] = ldfrag(dQg + (ch * 64 + i) * 128 + kk * 32 + q * 8);
#pragma unroll
    for (int kk = 0; kk < 2; ++kk) ba[kk] = ldfrag(dAtt + (ch * 64 + i) * 64 + kk * 32 + q * 8);
    f32x4 acc[8]; float ss = 0.f;
    bf16x8 fa[2][6];
#pragma unroll
    for (int kk = 0; kk < 4; ++kk) fa[0][kk] = ldfrag(dST + (ch * 128 + r) * 128 + kk * 32 + q * 8);
#pragma unroll
    for (int kk = 0; kk < 2; ++kk) fa[0][4 + kk] = ldfrag(dVnT + (ch * 128 + r) * 64 + kk * 32 + q * 8);
#pragma unroll
    for (int vb = 0; vb < 8; ++vb) { f32x4 a = (f32x4){0.f, 0.f, 0.f, 0.f};
        if (vb + 1 < 8) {
#pragma unroll
            for (int kk = 0; kk < 4; ++kk) fa[(vb + 1) & 1][kk] = ldfrag(dST + (ch * 128 + (vb + 1) * 16 + r) * 128 + kk * 32 + q * 8);
#pragma unroll
            for (int kk = 0; kk < 2; ++kk) fa[(vb + 1) & 1][4 + kk] = ldfrag(dVnT + (ch * 128 + (vb + 1) * 16 + r) * 64 + kk * 32 + q * 8); }
#pragma unroll
        for (int kk = 0; kk < 4; ++kk) a = mfma16(fa[vb & 1][kk], bq[kk], a);
#pragma unroll
        for (int kk = 0; kk < 2; ++kk) a = mfma16(fa[vb & 1][4 + kk], ba[kk], a);
        acc[vb] = a; ss += (a[0] * a[0] + a[1] * a[1]) + (a[2] * a[2] + a[3] * a[3]); }
    ss += __shfl_xor(ss, 16); ss += __shfl_xor(ss, 32);
    const float rn = rsqrtf(ss * (1.0f / 128.0f) + EPS);
    const float* nw = c.in(I_DNNORM) + c.layer * 128;
#pragma unroll
    for (int vb = 0; vb < 8; ++vb) { const int v0 = vb * 16 + 4 * q;
        const f32x4 g = up4(*(const u32x2*)(proj + (size_t)t * NP + C_DNG + h * 128 + v0)); const f32x4 w = *(const f32x4*)(nw + v0); f32x4 o;
#pragma unroll
        for (int j = 0; j < 4; ++j) o[j] = acc[vb][j] * rn * w[j] * siluf_(g[j]);
        *(u32x2*)(y + (size_t)t * 1024 + h * 128 + v0) = pk4(o); }
}
__device__ void ssd_s3(const Ctx& c, int ck, int g) {
    const bf16_t* proj = c.W<bf16_t>(WS_PROJ);
    const bf16_t* sC = c.W<bf16_t>(WS_SC); const bf16_t* sMm = c.W<bf16_t>(WS_SMM); const bf16_t* sSt = c.W<bf16_t>(WS_SST); const bf16_t* sXdT = c.W<bf16_t>(WS_SXDT);
    const bf16_t* sX = c.W<bf16_t>(WS_SX); const float* sAcs = c.W<float>(WS_SACS);
    bf16_t* y = c.W<bf16_t>(WS_YBR) + (size_t)T * 1024;
    const int r = c.r, q = c.q, lb = c.wave & 3, hq = c.wave >> 2, l = lb * 16 + r, t = ck * 64 + l;
    float* ssx = c.ldsf;
    bf16x8 bc[4];
#pragma unroll
    for (int kk = 0; kk < 4; ++kk) bc[kk] = ldfrag(sC + (size_t)t * 256 + g * 128 + kk * 32 + q * 8);
    f32x4 acc[4][4]; float ss = 0.f;
#pragma unroll
    for (int hh = 0; hh < 4; ++hh) { const int h = g * 8 + hq * 4 + hh; const size_t chh = (size_t)(ck * 16 + h);
        const float el = __expf(sAcs[chh * 64 + l]); const float dsk = c.in(I_SD)[c.layer * 16 + h];
        bf16x8 bm[2];
#pragma unroll
        for (int kk = 0; kk < 2; ++kk) bm[kk] = ldfrag(sMm + (chh * 64 + l) * 64 + kk * 32 + q * 8);
#pragma unroll
        for (int p2 = 0; p2 < 4; p2 += 2) {
            bf16x8 fs[2][4], fx[2][2]; u32x2 xr[2], zr[2];
#pragma unroll
            for (int t = 0; t < 2; ++t) { const int pb = p2 + t;
#pragma unroll
                for (int kk = 0; kk < 4; ++kk) fs[t][kk] = ldfrag(sSt + (chh * 64 + pb * 16 + r) * 128 + kk * 32 + q * 8);
#pragma unroll
                for (int kk = 0; kk < 2; ++kk) fx[t][kk] = ldfrag(sXdT + (chh * 64 + pb * 16 + r) * 64 + kk * 32 + q * 8);
                xr[t] = *(const u32x2*)(sX + (size_t)t * 0 + (size_t)(ck * 64 + l) * 1024 + h * 64 + pb * 16 + 4 * q);
                zr[t] = *(const u32x2*)(proj + (size_t)(ck * 64 + l) * NP + C_SZ + h * 64 + pb * 16 + 4 * q); }
            asm volatile("" ::: "memory");
#pragma unroll
            for (int t = 0; t < 2; ++t) { const int pb = p2 + t; f32x4 a = (f32x4){0.f, 0.f, 0.f, 0.f};
#pragma unroll
                for (int kk = 0; kk < 4; ++kk) a = mfma16(fs[t][kk], bc[kk], a);
                a = a * el;
#pragma unroll
                for (int kk = 0; kk < 2; ++kk) a = mfma16(fx[t][kk], bm[kk], a);
                const f32x4 xv = up4(xr[t]), zv = up4(zr[t]);
#pragma unroll
                for (int j = 0; j < 4; ++j) { a[j] = (a[j] + dsk * xv[j]) * siluf_(zv[j]); ss += a[j] * a[j]; }
                acc[hh][pb] = a; } } }
    ss += __shfl_xor(ss, 16); ss += __shfl_xor(ss, 32);
    __syncthreads();
    if (q == 0) ssx[l * 2 + hq] = ss;
    __syncthreads();
    const float rn = rsqrtf((ssx[l * 2] + ssx[l * 2 + 1]) * (1.0f / 512.0f) + EPS);
    const float* nw = c.in(I_SNORM) + c.layer * 1024 + g * 512;
    f32x4 wn[4][4];
#pragma unroll
    for (int hh = 0; hh < 4; ++hh)
#pragma unroll
        for (int pb = 0; pb < 4; ++pb) wn[hh][pb] = *(const f32x4*)(nw + (hq * 4 + hh) * 64 + pb * 16 + 4 * q);
    asm volatile("" ::: "memory");
#pragma unroll
    for (int hh = 0; hh < 4; ++hh)
#pragma unroll
        for (int pb = 0; pb < 4; ++pb) { const int p0 = pb * 16 + 4 * q, hl = hq * 4 + hh;
            const f32x4 o = acc[hh][pb] * rn * wn[hh][pb];
            *(u32x2*)(y + (size_t)t * 1024 + (g * 8 + hl) * 64 + p0) = pk4(o); }
}
__device__ void gla_g3(const Ctx& c, int ck, int h, int ib) {
    const bf16_t* proj = c.W<bf16_t>(WS_PROJ);
    const bf16_t* gQg = c.W<bf16_t>(WS_GQG); const bf16_t* gAtt = c.W<bf16_t>(WS_GATT); const bf16_t* gSt = c.W<bf16_t>(WS_GST); const bf16_t* gVT = c.W<bf16_t>(WS_GVT);
    bf16_t* y = c.W<bf16_t>(WS_YBR) + (size_t)2 * T * 1024;
    const int r = c.r, q = c.q, i = ib * 16 + r, t = ck * 64 + i; const size_t chh = (size_t)(ck * 4 + h);
    bf16x8 bq[4], ba[2];
#pragma unroll
    for (int kk = 0; kk < 4; ++kk) bq[kk] = ldfrag(gQg + (chh * 64 + i) * 128 + kk * 32 + q * 8);
#pragma unroll
    for (int kk = 0; kk < 2; ++kk) ba[kk] = ldfrag(gAtt + (chh * 64 + i) * 64 + kk * 32 + q * 8);
    f32x4 acc[16]; float ss = 0.f;
    bf16x8 fa[2][6];
#pragma unroll
    for (int kk = 0; kk < 4; ++kk) fa[0][kk] = ldfrag(gSt + (chh * 256 + r) * 128 + kk * 32 + q * 8);
#pragma unroll
    for (int kk = 0; kk < 2; ++kk) fa[0][4 + kk] = ldfrag(gVT + (chh * 256 + r) * 64 + kk * 32 + q * 8);
#pragma unroll
    for (int vb = 0; vb < 16; ++vb) { f32x4 a = (f32x4){0.f, 0.f, 0.f, 0.f};
        if (vb + 1 < 16) {
#pragma unroll
            for (int kk = 0; kk < 4; ++kk) fa[(vb + 1) & 1][kk] = ldfrag(gSt + (chh * 256 + (vb + 1) * 16 + r) * 128 + kk * 32 + q * 8);
#pragma unroll
            for (int kk = 0; kk < 2; ++kk) fa[(vb + 1) & 1][4 + kk] = ldfrag(gVT + (chh * 256 + (vb + 1) * 16 + r) * 64 + kk * 32 + q * 8); }
#pragma unroll
        for (int kk = 0; kk < 4; ++kk) a = mfma16(fa[vb & 1][kk], bq[kk], a);
#pragma unroll
        for (int kk = 0; kk < 2; ++kk) a = mfma16(fa[vb & 1][4 + kk], ba[kk], a);
        acc[vb] = a; ss += (a[0] * a[0] + a[1] * a[1]) + (a[2] * a[2] + a[3] * a[3]); }
    ss += __shfl_xor(ss, 16); ss += __shfl_xor(ss, 32);
    const float rn = rsqrtf(ss * (1.0f / 256.0f) + EPS);
    const float* nw = c.in(I_GNORM) + c.layer * 256;
#pragma unroll
    for (int vb = 0; vb < 16; ++vb) { const int v0 = vb * 16 + 4 * q;
        const f32x4 g = up4(*(const u32x2*)(proj + (size_t)t * NP + C_GO + h * 256 + v0)); const f32x4 w = *(const f32x4*)(nw + v0); f32x4 o;
#pragma unroll
        for (int j = 0; j < 4; ++j) o[j] = acc[vb][j] * rn * w[j] * siluf_(g[j]);
        *(u32x2*)(y + (size_t)t * 1024 + h * 256 + v0) = pk4(o); }
}

constexpr int PH_PER_LAYER = 10, N_PHASES = 2 * PH_PER_LAYER + 1;

__device__ __forceinline__ void run_phase(int ph, unsigned char* ldsraw) {
    const __attribute__((address_space(4))) Params* Pk = (const __attribute__((address_space(4))) Params*)__builtin_amdgcn_kernarg_segment_ptr();
    asm volatile("" : "+s"(Pk));
    int bid_ = blockIdx.x, nb_ = gridDim.x, tid_ = threadIdx.x; asm volatile("" : "+s"(bid_), "+s"(nb_), "+v"(tid_));
    Ctx c; c.P = Pk; c.layer = ph == 0 ? 0 : (ph - 1) / PH_PER_LAYER; c.bid = bid_; c.nb = nb_; c.tid = tid_; c.wave = __builtin_amdgcn_readfirstlane(c.tid >> 6); c.lane = c.tid & 63;
    c.r = c.lane & 15; c.q = c.lane >> 4; c.gw = c.bid * 8 + c.wave; c.nw = c.nb * 8; c.ws = Pk->ws; c.ldsf = (float*)ldsraw;
    LAS unsigned char* lds3 = (LAS unsigned char*)ldsraw;
    const int L = c.layer;
    const int lp = ph == 0 ? -1 : (ph - 1) % PH_PER_LAYER;
    float* xio = Pk->out; float* gout = c.W<float>(WS_GOUT); bf16_t* hb = c.W<bf16_t>(WS_HB);
    pg8::RowStats stA{c.W<float>(WS_SLOTA), c.W<unsigned>(WS_CNTA), 0u}, stB{c.W<float>(WS_SLOTB), c.W<unsigned>(WS_CNTB), 0u};
    switch (lp) {
    case -1: {
        row_phase(c.in(I_X), xio, nullptr, nullptr, nullptr, c.in(I_PREMIX), hb, 2, c.gw, c.nw);
        const float* p = c.in(I_P); bf16_t* pb = c.W<bf16_t>(WS_PB); const size_t n4 = (size_t)2 * T * 256 / 4;
        for (size_t i = (size_t)c.bid * 512 + c.tid; i < n4; i += (size_t)c.nb * 512) { const f32x4 v = __builtin_nontemporal_load((const f32x4*)(p + i * 4)); *(u32x2*)(pb + i * 4) = pk4(v); }
        convT(c.in(I_WIN), 2048, INT, c.W<bf16_t>(WS_WIN), NP, c.ldsf, c.bid, c.nb);
    } break;
    case 0: {
        pg8::Gemm g{hb, c.W<bf16_t>(L == 0 ? WS_WIN : WS_WIN1), T, NP, 2048, 0, 0}; pg8::StaticOrder S; S.init(T, NP, c.nb, c.bid);
        pg8::EpiBf16<0> E{c.W<bf16_t>(WS_PROJ), NP};
        pg8::gemm_phase(lds3, g, S, E);
    } break;
    case 1: {
        for (int cb0 = c.bid; cb0 < 256; cb0 += c.nb) { int cb = cb0; asm volatile("" : "+s"(cb));
            { int t2 = c.tid; asm volatile("" : "+v"(t2)); c.tid = t2; c.wave = __builtin_amdgcn_readfirstlane(t2 >> 6); c.lane = t2 & 63; c.r = c.lane & 15; c.q = c.lane >> 4; }
            const int ck = cb >> 1, half = cb & 1;
            prep_dn_chunk(c, ck, half);
            prep_ssd(c, ck, half);
            prep_ssd(c, ck, 2 + half);
            prep_gla(c, ck, 10 + half);
            prep_gla(c, ck, 1 + half);
            __syncthreads();
            dn_d1(c, ck * 4 + half * 2); dn_d1(c, ck * 4 + half * 2 + 1);
            if (c.wave < 4) ssd_mm(c, ck, half, c.wave);
            ssd_s1(c, ck, half * 8 + c.wave);
            gla_attn(c, ck, half * 2 + (c.wave >> 2), c.wave & 3);
            gla_g1(c, ck, half * 2 + (c.wave >> 2), c.wave & 3);
            __syncthreads();
        }
    } break;
    case 2: break;
    case 3: {
        if (c.bid < 64) { dn_seq(c, c.bid & 7, c.bid >> 3);
#if PROBE == 2
            dn_seq(c, c.bid & 7, c.bid >> 3);
#endif
        }
        else { const int nbs = c.nb - 64, b2 = c.bid - 64;
            for (int idx = b2 * 512 + c.tid; idx < 65536; idx += nbs * 512) { if (idx < 32768) scan_ssd(c, idx); else scan_gla(c, idx - 32768); }
            float* tile = c.ldsf;
            for (int b = 0; b < 3; ++b) convT(c.in(I_WBR) + ((size_t)L * 3 + b) * 1024 * 2048, 1024, 2048, c.W<bf16_t>(WS_WBR) + (size_t)b * 2048 * 1024, 2048, tile, b2, nbs);
            convT(c.in(I_WOUT) + (size_t)L * 2048 * 2048, 2048, 2048, c.W<bf16_t>(WS_WOUT), 2048, tile, b2, nbs);
            convT(c.in(I_WUP) + (size_t)L * 2048 * 8192, 2048, 8192, c.W<bf16_t>(WS_WUP), 8192, tile, b2, nbs);
            convT(c.in(I_WDN) + (size_t)L * 8192 * 2048, 8192, 2048, c.W<bf16_t>(WS_WDN), 2048, tile, b2, nbs);
            convT(c.in(I_WPG) + (size_t)L * 2048 * 2048, 2048, 2048, c.W<bf16_t>(WS_WPG), 2048, tile, b2, nbs);
            convT(c.in(I_WPP) + (size_t)L * 256 * 2048, 256, 2048, c.W<bf16_t>(WS_WPP), 2048, tile, b2, nbs);
            if (L == 0) convT(c.in(I_WIN) + (size_t)2048 * INT, 2048, INT, c.W<bf16_t>(WS_WIN1), NP, tile, b2, nbs);
        }
    } break;
    case 4: {
        for (int it = c.bid; it < 256; it += c.nb) ssd_s3(c, it >> 1, it & 1);
        for (int it = c.gw; it < 4096; it += c.nw) dn_d3(c, it >> 5, (it >> 2) & 7, it & 3);
        for (int it = c.gw; it < 2048; it += c.nw) gla_g3(c, it >> 4, (it >> 2) & 3, it & 3);
    } break;
    case 5: {
        pg8::StackOrder<3> S; S.init(T, 2048, c.nb, c.bid);
        pg8::Gemm g{c.W<bf16_t>(WS_YBR), c.W<bf16_t>(WS_WBR), T, 2048, 1024, (size_t)T * 1024 * 2, (size_t)2048 * 1024 * 2};
        pg8::EpiBranch E{gout, c.W<bf16_t>(WS_MIXB), c.W<bf16_t>(WS_PROJ)}; pg8::gemm_phase(lds3, g, S, E);
    } break;
    case 6: {
        pg8::Gemm g{c.W<bf16_t>(WS_MIXB), c.W<bf16_t>(WS_WOUT), T, 2048, 2048, 0, 0}; pg8::StaticOrder S; S.init(T, 2048, c.nb, c.bid);
        stA.want = 64u * (unsigned)(3 * L + 1); stB.want = stA.want;
        pg8::EpiRowFused<0, 1> E{L == 0 ? c.in(I_X) : (const float*)xio, xio, hb, nullptr, c.in(I_POSTMIX) + L * 2048, c.in(I_PREMLP) + L * 2048, stA, stB}; pg8::gemm_phase(lds3, g, S, E);
    } break;
    case 7: {
        pg8::Gemm g{hb, c.W<bf16_t>(WS_WUP), T, DFF, 2048, 0, 0}; pg8::StaticOrder S; S.init(T, DFF, c.nb, c.bid);
        pg8::EpiBf16<1> E{c.W<bf16_t>(WS_PROJ), DFF}; pg8::gemm_phase(lds3, g, S, E);
    } break;
    case 8: {
        { pg8::Gemm g{c.W<bf16_t>(WS_PROJ), c.W<bf16_t>(WS_WDN), T, 2048, DFF, 0, 0}; pg8::StaticOrder S; S.init(T, 2048, c.nb, c.bid);
          stA.want = 64u * (unsigned)(3 * L + 2); stB.want = stA.want;
          pg8::EpiRowFused<0, 1> E{xio, xio, hb, nullptr, c.in(I_POSTMLP) + L * 2048, c.in(I_PLEPRE) + L * 2048, stA, stB}; pg8::gemm_phase(lds3, g, S, E); }
        { pg8::Gemm g{c.W<bf16_t>(WS_PB) + (size_t)L * T * 256, c.W<bf16_t>(WS_WPP), T, 2048, 256, 0, 0}; pg8::StaticOrder S; S.init(T, 2048, c.nb, c.bid);
          pg8::EpiBf16<0> E{c.W<bf16_t>(WS_PP), 2048}; pg8::gemm_phase(lds3, g, S, E); }
    } break;
    case 9: {
        pg8::Gemm g{hb, c.W<bf16_t>(WS_WPG), T, 2048, 2048, 0, 0}; pg8::StaticOrder S; S.init(T, 2048, c.nb, c.bid);
        stA.want = 64u * (unsigned)(3 * L + 3); stB.want = stA.want;
        if (L == 0) { pg8::EpiRowFused<1, 1> E{xio, xio, hb, c.W<bf16_t>(WS_PP), c.in(I_PLEPOST), c.in(I_PREMIX) + 2048, stA, stB}; pg8::gemm_phase(lds3, g, S, E); }
        else { pg8::EpiRowFused<1, 0> E{xio, xio, hb, c.W<bf16_t>(WS_PP), c.in(I_PLEPOST) + 2048, nullptr, stA, stB}; pg8::gemm_phase(lds3, g, S, E); }
    } break;
    }
}

__global__ void __launch_bounds__(512, 2) mega(Params P, int ph_lo, int ph_hi) {
    extern __shared__ __attribute__((aligned(16))) unsigned char lds[];
    cg::grid_group grid = cg::this_grid();
    if (ph_lo < 0) grid.sync();
    volatile LAS unsigned* st = (volatile LAS unsigned*)((LAS unsigned char*)lds + 131072);
    if (threadIdx.x < 4) st[threadIdx.x] = 0u;
    __syncthreads();
    XcdBarrier bar = xcd_barrier_post((unsigned*)(P.ws + WS_BAR), st);
    for (int ph = ph_lo; ph < ph_hi; ++ph) {
        run_phase(ph, lds);
#if PROBE >= 20
        if (ph >= 1 && (ph - 1) % PH_PER_LAYER == PROBE - 20) { xcd_barrier(bar); run_phase(ph, lds); }
#endif
        if (ph + 1 < ph_hi && !(ph >= 1 && (ph - 1) % PH_PER_LAYER == 2)) xcd_barrier(bar);
    }
}

extern "C" void kernel_launch(void* const* d_in, const int* in_sizes, int n_in, void* d_out, int out_size, void* d_ws, size_t ws_size, hipStream_t stream) {
    static int grid = 0;
    constexpr int LDS_BYTES = 131072 + 64;
    if (grid == 0) {
        if (ws_size < WS_TOTAL) { fprintf(stderr, "kernel_launch: workspace too small: %zu < %zu\n", ws_size, (size_t)WS_TOTAL); grid = -1; return; }
        int dev = 0, cus = 0, per_cu = 0;
        hipGetDevice(&dev); hipDeviceGetAttribute(&cus, hipDeviceAttributeMultiprocessorCount, dev);
        if (hipFuncSetAttribute((const void*)mega, hipFuncAttributeMaxDynamicSharedMemorySize, LDS_BYTES) != hipSuccess) { fprintf(stderr, "hipFuncSetAttribute failed\n"); grid = -1; return; }
        hipOccupancyMaxActiveBlocksPerMultiprocessor(&per_cu, (const void*)mega, 512, LDS_BYTES);
        if (per_cu < 1) { fprintf(stderr, "occupancy query says %d blocks per CU\n", per_cu); per_cu = 1; }
        (void)hipGetLastError();
        grid = cus;
    }
    if (grid < 0) return;
    Params P{};
    for (int i = 0; i < 28; ++i) P.in[i] = (const float*)d_in[i];
    P.out = (float*)d_out; P.ws = (unsigned char*)d_ws;
    (void)hipMemsetAsync((unsigned char*)d_ws + WS_BAR, 0, 32768, stream);
#if SINGLE_LAUNCH
    { int lo = 0, hi = N_PHASES; void* args[] = {&P, &lo, &hi};
      hipError_t e = hipLaunchCooperativeKernel((const void*)mega, dim3(grid), dim3(512), args, LDS_BYTES, stream);
      if (e != hipSuccess) fprintf(stderr, "cooperative launch failed: %s\n", hipGetErrorString(e)); }
#else
    for (int ph = 0; ph < N_PHASES; ++ph) { int lo = ph, hi = ph + 1; void* args[] = {&P, &lo, &hi};
        hipError_t e = hipLaunchCooperativeKernel((const void*)mega, dim3(grid), dim3(512), args, LDS_BYTES, stream);
        if (e != hipSuccess) { fprintf(stderr, "cooperative launch failed: %s\n", hipGetErrorString(e)); break; } }
#endif
}
```
